# Optimizing an MI355X kernel written in HIP

```python
import math
import jax, jax.numpy as jnp
from jax import lax
import numpy as np

D_MODEL = 1024
BATCH = 4
SEQ = 4096
DEPTH = 2
DEC_BATCH = 128
DEC_SEQ = 4
PAST_LEN = 2048
PAGE_SIZE = 128

HEAD_DIM = 64
ATT_GROUPS = ((128, 1), (512, 4), (2048, 16))
HEADS_PER_GROUP = 4
N_ATT_HEADS = HEADS_PER_GROUP * len(ATT_GROUPS)
ATT_WIDTH = N_ATT_HEADS * HEAD_DIM
SSM_HEAD_DIM = 64
SSM_WIDTH = D_MODEL
SSM_HEADS = SSM_WIDTH // SSM_HEAD_DIM
SSM_STATE = 128
SSM_GROUPS = 2
SSM_HPG = SSM_HEADS // SSM_GROUPS
SSM_CONV = 4
SSM_CHUNK = 128
XBC_WIDTH = SSM_WIDTH + 2 * SSM_GROUPS * SSM_STATE
MIX_WIDTH = ATT_WIDTH + SSM_WIDTH
IN_SPLITS = (ATT_WIDTH, 2 * ATT_WIDTH, 3 * ATT_WIDTH, 3 * ATT_WIDTH + SSM_WIDTH, 3 * ATT_WIDTH + SSM_WIDTH + XBC_WIDTH)
IN_WIDTH = IN_SPLITS[-1] + SSM_HEADS
D_FF = 128 * int(math.ceil(8 * D_MODEL / 3 / 128))
FFN_CONV = 3
EPS = 1e-6

kernel_name = 'hymba_ssd_dilated_convffn_step'


def rmsnorm(x, g):
    xf = x.astype(jnp.float32)
    y = xf * lax.rsqrt(jnp.mean(xf * xf, axis=-1, keepdims=True) + EPS)
    return (y * g.astype(jnp.float32)).astype(x.dtype)


def alibi_slopes():
    h = jnp.arange(1, N_ATT_HEADS + 1, dtype=jnp.float32)
    return jnp.exp2(-8.0 * h / N_ATT_HEADS)


def softmax_lse(s):
    mx = jnp.max(s, axis=-1, keepdims=True)
    e = jnp.exp(s - mx)
    den = jnp.sum(e, axis=-1, keepdims=True)
    return e / den, (mx + jnp.log(den))[..., 0]


def causal_dwconv(x, prev, w, b):
    width = w.shape[0]
    L = x.shape[1]
    xp = jnp.concatenate([prev.astype(x.dtype), x], axis=1)
    y = xp[:, 0:L] * w[0]
    for i in range(1, width):
        y = y + xp[:, i:i + L] * w[i]
    return y + b, xp[:, L:]


def dilated_attn_prompt(q, k, v, slopes, window, dil):
    bsz, S, H, hd = q.shape
    band = window // dil
    span = band * dil
    lp = -(-S // span) * span
    m = lp // dil
    nb = m // band

    def to_blocks(t):
        t = jnp.pad(t, ((0, 0), (0, lp - S), (0, 0), (0, 0)))
        t = t.reshape(bsz, m, dil, H, hd).transpose(0, 2, 1, 3, 4)
        return t.reshape(bsz, dil, nb, band, H, hd)

    def with_prev(t):
        prev = jnp.pad(t, ((0, 0), (0, 0), (1, 0), (0, 0), (0, 0), (0, 0)))[:, :, :-1]
        return jnp.concatenate([prev, t], axis=3)

    qb = to_blocks(q)
    kb = with_prev(to_blocks(k))
    vb = with_prev(to_blocks(v))
    s = jnp.einsum('brnihd,brnjhd->brnhij', qb, kb).astype(jnp.float32) * (hd ** -0.5)
    step = (jnp.arange(band)[:, None] + band) - jnp.arange(2 * band)[None, :]
    valid = (step >= 0) & (step <= band)
    valid = valid[None] & ((jnp.arange(nb)[:, None, None] > 0) | (jnp.arange(2 * band)[None, None, :] >= band))
    bias = -slopes.astype(jnp.float32)[:, None, None] * (step * dil).astype(jnp.float32)
    s = jnp.where(valid[:, None], s + bias, -jnp.inf)
    p, lse = softmax_lse(s)
    o = jnp.einsum('brnhij,brnjhd->brnihd', p.astype(v.dtype), vb)
    o = o.reshape(bsz, dil, m, H, hd).transpose(0, 2, 1, 3, 4).reshape(bsz, lp, H, hd)[:, :S]
    lse = lse.transpose(0, 1, 2, 4, 3).reshape(bsz, dil, m, H).transpose(0, 2, 1, 3).reshape(bsz, lp, H)[:, :S]
    return o, lse


def dilated_attn_sample(q, k, v, kv_cache, slopes, window, dil):
    T, hd = q.shape[1], q.shape[-1]
    lc = kv_cache.shape[1]
    band = window // dil
    keys = jnp.concatenate([kv_cache[:, :, 0].astype(k.dtype), k], axis=1)
    vals = jnp.concatenate([kv_cache[:, :, 1].astype(v.dtype), v], axis=1)
    steps = jnp.arange(band + 1)
    idx = lc + jnp.arange(T)[:, None] - steps[None, :] * dil
    valid = idx >= 0
    idx = jnp.maximum(idx, 0)
    kg = keys[:, idx]
    vg = vals[:, idx]
    s = jnp.einsum('bthd,btjhd->bthj', q, kg).astype(jnp.float32) * (hd ** -0.5)
    bias = -slopes.astype(jnp.float32)[:, None] * (steps * dil).astype(jnp.float32)[None, :]
    s = jnp.where(valid[:, None, :], s + bias, -jnp.inf)
    p, lse = softmax_lse(s)
    o = jnp.einsum('bthj,btjhd->bthd', p.astype(v.dtype), vg)
    return o, lse


def ssd_scan(x, dt, a, bm, cm, h0):
    bsz, L, H, P = x.shape
    G, N = bm.shape[2], bm.shape[3]
    hpg = H // G
    f32 = jnp.float32
    q = min(SSM_CHUNK, L)
    lp = -(-L // q) * q
    nc = lp // q

    def padl(t):
        return jnp.pad(t, [(0, 0), (0, lp - L)] + [(0, 0)] * (t.ndim - 2))

    xc = padl(x.astype(f32)).reshape(bsz, nc, q, G, hpg, P)
    dtc = padl(dt).reshape(bsz, nc, q, G, hpg)
    bc = padl(bm.astype(f32)).reshape(bsz, nc, q, G, N)
    cc = padl(cm.astype(f32)).reshape(bsz, nc, q, G, N)
    acum = jnp.cumsum(dtc * a.reshape(G, hpg), axis=2)
    causal = jnp.tril(jnp.ones((q, q), bool))[:, :, None, None]
    seg = acum[:, :, :, None] - acum[:, :, None, :]
    decay = jnp.exp(jnp.where(causal, seg, -jnp.inf))
    xdt = xc * dtc[..., None]
    cb = jnp.einsum('bcign,bcjgn->bcijg', cc, bc)
    y_intra = jnp.einsum('bcijg,bcijgh,bcjghp->bcighp', cb, decay, xdt)
    decay_end = jnp.exp(acum[:, :, -1:] - acum)
    states = jnp.einsum('bcjgn,bcjgh,bcjghp->bcghpn', bc, decay_end, xdt)
    chunk_decay = jnp.exp(acum[:, :, -1])

    def step(h, inp):
        s_c, d_c = inp
        return h * d_c[..., None, None] + s_c, h

    h_last, h_prev = lax.scan(step, h0.reshape(bsz, G, hpg, P, N),
                              (jnp.moveaxis(states, 1, 0), jnp.moveaxis(chunk_decay, 1, 0)))
    h_prev = jnp.moveaxis(h_prev, 0, 1)
    y_inter = jnp.einsum('bcign,bcigh,bcghpn->bcighp', cc, jnp.exp(acum), h_prev)
    y = (y_intra + y_inter).reshape(bsz, lp, H, P)[:, :L]
    return y, h_last.reshape(bsz, H, P, N)


def hybrid_layer(x, lw, kv_caches, h0, conv_prev, ffn_prev):
    (norm_mix, w_in, q_norm, k_norm, conv_w, conv_b, dt_bias, a_log, d_skip, ssm_norm, w_out,
     norm_ffn, w_up, ffn_conv_w, ffn_conv_b, w_down) = lw
    bsz, L, _ = x.shape
    h = rmsnorm(x, norm_mix)
    proj = h @ w_in
    q, k, v, z, xbc, dt_raw = jnp.split(proj, IN_SPLITS, axis=-1)

    q = rmsnorm(q.reshape(bsz, L, N_ATT_HEADS, HEAD_DIM), q_norm)
    k = rmsnorm(k.reshape(bsz, L, N_ATT_HEADS, HEAD_DIM), k_norm)
    v = v.reshape(bsz, L, N_ATT_HEADS, HEAD_DIM)
    slopes = alibi_slopes().reshape(len(ATT_GROUPS), HEADS_PER_GROUP)
    outs, lses, new_kv = [], [], []
    for g, (win, dil) in enumerate(ATT_GROUPS):
        hs = slice(g * HEADS_PER_GROUP, (g + 1) * HEADS_PER_GROUP)
        qg, kg, vg = q[:, :, hs], k[:, :, hs], v[:, :, hs]
        if kv_caches is None:
            o, lse = dilated_attn_prompt(qg, kg, vg, slopes[g], win, dil)
            keep = min(win, L)
            new_kv.append(jnp.stack([kg[:, L - keep:], vg[:, L - keep:]], axis=2))
        else:
            o, lse = dilated_attn_sample(qg, kg, vg, kv_caches[g], slopes[g], win, dil)
            new_kv.append(jnp.stack([kg, vg], axis=2))
        outs.append(o)
        lses.append(lse)
    alpha = jax.nn.softmax(jnp.stack(lses, axis=0), axis=0)
    att = jnp.concatenate([o * alpha[g][..., None].astype(o.dtype) for g, o in enumerate(outs)], axis=2)
    att = att.reshape(bsz, L, ATT_WIDTH)

    xbc_c, conv_new = causal_dwconv(xbc, conv_prev, conv_w, conv_b)
    xbc_c = jax.nn.silu(xbc_c)
    xs, bm, cm = jnp.split(xbc_c, (SSM_WIDTH, SSM_WIDTH + SSM_GROUPS * SSM_STATE), axis=-1)
    dt = jax.nn.softplus(dt_raw.astype(jnp.float32) + dt_bias.astype(jnp.float32))
    a = -jnp.exp(a_log.astype(jnp.float32))
    xs = xs.reshape(bsz, L, SSM_HEADS, SSM_HEAD_DIM)
    y, h_last = ssd_scan(xs, dt, a, bm.reshape(bsz, L, SSM_GROUPS, SSM_STATE),
                         cm.reshape(bsz, L, SSM_GROUPS, SSM_STATE), h0)
    y = y + d_skip.astype(jnp.float32)[:, None] * xs.astype(jnp.float32)
    y = y.reshape(bsz, L, SSM_WIDTH) * jax.nn.silu(z.astype(jnp.float32))
    y = rmsnorm(y.astype(x.dtype), ssm_norm)

    x = x + jnp.concatenate([att, y], axis=-1) @ w_out

    u = rmsnorm(x, norm_ffn) @ w_up
    u, ffn_new = causal_dwconv(u, ffn_prev, ffn_conv_w, ffn_conv_b)
    gate, up = jnp.split(u, 2, axis=-1)
    x = x + (jax.nn.silu(gate) * up) @ w_down
    return x, new_kv, h_last, conv_new, ffn_new


def setup_inputs(seed: int = 0) -> dict:
    key = jax.random.key(seed)
    ks = jax.random.split(key, 24)
    f32 = jnp.float32

    def nrm(k, shape, scale):
        return jax.random.normal(k, shape, f32) * scale

    kv_shape = lambda win: (DEPTH, DEC_BATCH, min(win, PAST_LEN), 2, HEADS_PER_GROUP, HEAD_DIM)
    dt0 = jnp.exp(jax.random.uniform(ks[14], (DEPTH, SSM_HEADS), f32, math.log(1e-3), math.log(1e-1)))
    return {
        'x_prompt': nrm(ks[0], (BATCH, SEQ, D_MODEL), 1.0),
        'x_sample': nrm(ks[1], (DEC_BATCH, DEC_SEQ, D_MODEL), 1.0),
        'cache_kv0': nrm(ks[2], kv_shape(ATT_GROUPS[0][0]), 1.0),
        'cache_kv1': nrm(ks[3], kv_shape(ATT_GROUPS[1][0]), 1.0),
        'cache_kv2': nrm(ks[4], kv_shape(ATT_GROUPS[2][0]), 1.0),
        'state_ssm': nrm(ks[5], (DEPTH, DEC_BATCH, SSM_HEADS, SSM_HEAD_DIM, SSM_STATE), 0.1),
        'state_conv': nrm(ks[6], (DEPTH, DEC_BATCH, SSM_CONV - 1, XBC_WIDTH), 1.0),
        'state_ffn_conv': nrm(ks[7], (DEPTH, DEC_BATCH, FFN_CONV - 1, 2 * D_FF), 1.0),
        'norm_mix': 1.0 + nrm(ks[8], (DEPTH, D_MODEL), 0.02),
        'w_in': nrm(ks[9], (DEPTH, D_MODEL, IN_WIDTH), D_MODEL ** -0.5),
        'q_norm': 1.0 + nrm(ks[10], (DEPTH, HEAD_DIM), 0.02),
        'k_norm': 1.0 + nrm(ks[11], (DEPTH, HEAD_DIM), 0.02),
        'conv_w': nrm(ks[12], (DEPTH, SSM_CONV, XBC_WIDTH), SSM_CONV ** -0.5),
        'conv_b': nrm(ks[13], (DEPTH, XBC_WIDTH), 0.02),
        'dt_bias': dt0 + jnp.log(-jnp.expm1(-dt0)),
        'a_log': jnp.log(jax.random.uniform(ks[15], (DEPTH, SSM_HEADS), f32, 1.0, 16.0)),
        'd_skip': 1.0 + nrm(ks[16], (DEPTH, SSM_HEADS), 0.1),
        'ssm_norm': 1.0 + nrm(ks[17], (DEPTH, SSM_WIDTH), 0.02),
        'w_out': nrm(ks[18], (DEPTH, MIX_WIDTH, D_MODEL), MIX_WIDTH ** -0.5),
        'norm_ffn': 1.0 + nrm(ks[19], (DEPTH, D_MODEL), 0.02),
        'w_up': nrm(ks[20], (DEPTH, D_MODEL, 2 * D_FF), D_MODEL ** -0.5),
        'ffn_conv_w': nrm(ks[21], (DEPTH, FFN_CONV, 2 * D_FF), FFN_CONV ** -0.5),
        'ffn_conv_b': nrm(ks[22], (DEPTH, 2 * D_FF), 0.02),
        'w_down': nrm(ks[23], (DEPTH, D_FF, D_MODEL), D_FF ** -0.5),
    }


def reference(x_prompt, x_sample, cache_kv0, cache_kv1, cache_kv2, state_ssm, state_conv, state_ffn_conv,
              norm_mix, w_in, q_norm, k_norm, conv_w, conv_b, dt_bias, a_log, d_skip, ssm_norm, w_out,
              norm_ffn, w_up, ffn_conv_w, ffn_conv_b, w_down):
    stacked = (norm_mix, w_in, q_norm, k_norm, conv_w, conv_b, dt_bias, a_log, d_skip, ssm_norm, w_out,
               norm_ffn, w_up, ffn_conv_w, ffn_conv_b, w_down)
    y_prompt, y_sample = x_prompt, x_sample
    nbp = x_prompt.shape[0]
    kv_p, kv_s = ([], [], []), ([], [], [])
    ssm_p, conv_p, ffn_p, ssm_s, conv_s, ffn_s = [], [], [], [], [], []
    for layer in range(DEPTH):
        lw = tuple(w[layer] for w in stacked)
        h0 = jnp.zeros((nbp, SSM_HEADS, SSM_HEAD_DIM, SSM_STATE), jnp.float32)
        conv0 = jnp.zeros((nbp, SSM_CONV - 1, XBC_WIDTH), x_prompt.dtype)
        ffn0 = jnp.zeros((nbp, FFN_CONV - 1, 2 * D_FF), x_prompt.dtype)
        y_prompt, kv, h, c, f = hybrid_layer(y_prompt, lw, None, h0, conv0, ffn0)
        for g in range(len(ATT_GROUPS)):
            kv_p[g].append(kv[g])
        ssm_p.append(h)
        conv_p.append(c)
        ffn_p.append(f)
        y_sample, kv, h, c, f = hybrid_layer(
            y_sample, lw, (cache_kv0[layer], cache_kv1[layer], cache_kv2[layer]),
            state_ssm[layer].astype(jnp.float32), state_conv[layer], state_ffn_conv[layer])
        for g in range(len(ATT_GROUPS)):
            kv_s[g].append(kv[g])
        ssm_s.append(h)
        conv_s.append(c)
        ffn_s.append(f)
    new_kv0_prompt = jnp.stack(kv_p[0])
    new_kv1_prompt = jnp.stack(kv_p[1])
    new_kv2_prompt = jnp.stack(kv_p[2])
    new_ssm_prompt = jnp.stack(ssm_p)
    new_conv_prompt = jnp.stack(conv_p)
    new_ffn_conv_prompt = jnp.stack(ffn_p)
    new_kv0_sample = jnp.stack(kv_s[0])
    new_kv1_sample = jnp.stack(kv_s[1])
    new_kv2_sample = jnp.stack(kv_s[2])
    new_ssm_sample = jnp.stack(ssm_s)
    new_conv_sample = jnp.stack(conv_s)
    new_ffn_conv_sample = jnp.stack(ffn_s)
    return (y_prompt, y_sample,
            new_kv0_prompt, new_kv1_prompt, new_kv2_prompt, new_ssm_prompt, new_conv_prompt, new_ffn_conv_prompt,
            new_kv0_sample, new_kv1_sample, new_kv2_sample, new_ssm_sample, new_conv_sample, new_ffn_conv_sample)
```

```cpp
#include <hip/hip_runtime.h>
#include <cstdio>
#include <cstdint>

#ifndef MK_ONE_LAUNCH
#define MK_ONE_LAUNCH 0
#endif

namespace pg8 {
#define PG8_LAS __attribute__((address_space(3)))
typedef unsigned short bf16_t;
typedef short bf16x8 __attribute__((ext_vector_type(8)));
typedef float f32x4 __attribute__((ext_vector_type(4)));
typedef unsigned u32x4 __attribute__((ext_vector_type(4)));
constexpr int BM = 256, BK = 64, HALF = 128, HTB = HALF * BK * 2  , STAGE_BYTES = 8 * HTB, NXCD = 8, WGM = 8;

__host__ __device__ __forceinline__ int lds_byte(int r, int c) { const int st = (r >> 4) * 2 + (c >> 5), rr = r & 15, cc = c & 31, ob = rr * 64 + cc * 2; return st * 1024 + (ob ^ (((ob >> 9) & 1) << 5)); }
__host__ __device__ __forceinline__ void stage_rc(int b, int& R, int& C) { const int st = b / 1024, sb = b % 1024, swz = sb ^ (((sb >> 9) & 1) << 5); R = (st >> 1) * 16 + swz / 64; C = (st & 1) * 32 + (swz % 64) / 2; }
__host__ __device__ __forceinline__ int perm32(int rho) { const int n = rho >> 4, i = rho & 15; return 8 * (i >> 2) + 4 * n + (i & 3); }

struct Unit { int pm, pn; };
struct Gemm { const bf16_t* A; const bf16_t* Bt; int M, N, K; };

struct StaticOrder {
    int nM, nN, nwg, G, c;
    __host__ __device__ void init(int M, int N, int G_, int c_) { nM = M / BM; nN = N / BM; nwg = nM * nN; G = G_; c = c_; }
    __host__ __device__ bool next(int i, Unit& u) const {
        const long L = (long)i * G + c; if (L >= nwg) return false;
        int wgid = (int)L; { const int q = nwg / NXCD, r = nwg % NXCD, xcd = wgid % NXCD, off = wgid / NXCD; wgid = (xcd < r ? xcd * (q + 1) : r * (q + 1) + (xcd - r) * q) + off; }
        const int nig = WGM * nN, gid = wgid / nig, fm = gid * WGM, gsz = (nM - fm) < WGM ? (nM - fm) : WGM;
        u.pm = fm + ((wgid % nig) % gsz); u.pn = (wgid % nig) / gsz; return true;
    }
    __device__ __forceinline__ void a_ready(const Unit&) const {}
    __device__ __forceinline__ void done(const Unit&) const {}
};
typedef float f32x2_t __attribute__((ext_vector_type(2))); typedef __bf16 bf16x2_t __attribute__((ext_vector_type(2)));
__device__ __forceinline__ unsigned cvt_pk_bf16(float lo, float hi) { f32x2_t v = {lo, hi}; bf16x2_t b = __builtin_convertvector(v, bf16x2_t); return __builtin_bit_cast(unsigned, b); }

template <class Epi, class Sched, bool ALIGN_EPI = false, bool SP2 = false>
__device__ __forceinline__ void gemm_phase(PG8_LAS unsigned char* lds, const Gemm g, const Sched& S, const Epi& E, const int tid) {
    const int wid = __builtin_amdgcn_readfirstlane(tid >> 6), lane = tid & 63, wr = wid >> 2, wc = wid & 3, fr = lane & 15, fq = lane >> 4;
    const int K = g.K, nt = K / BK;
    unsigned voffA[2], voffB[2];
#pragma unroll
    for (int i = 0; i < 2; ++i) { int R, C; stage_rc(tid * 16 + i * 8192, R, C); const int Rb = Epi::PERM ? ((R & ~31) + perm32(R & 31)) : R;
        voffA[i] = (unsigned)(R * K + C) * 2u; voffB[i] = (unsigned)(Rb * K + C) * 2u; }
    const size_t kstep = (size_t)(BK * 2);
    const size_t hstep = (size_t)HALF * K * 2;
    const size_t tstep = 2 * hstep;
    const unsigned ldsw = (unsigned)wid * 1024u;
    const int aoff = lds_byte(wr * 64 + fr, fq * 8), boff = lds_byte(wc * 32 + fr, fq * 8);
#define PG8_SA(b, h) (((b) * 2 + (h)) * HTB)
#define PG8_SB(b, h) ((4 + (b) * 2 + (h)) * HTB)
#define PG8_STAGE(bufoff, gbase, voff) do { _Pragma("unroll") for (int _i = 0; _i < 2; ++_i) \
        __builtin_amdgcn_global_load_lds((const unsigned*)((const char*)(gbase) + (voff)[_i]), (PG8_LAS unsigned*)(lds + (bufoff) + ldsw + _i * 8192), 16, 0, 0); } while (0)
#define PG8_LDA(dst, b, h) do { _Pragma("unroll") for (int m = 0; m < 4; ++m) _Pragma("unroll") for (int k = 0; k < 2; ++k) dst[m][k] = *(const PG8_LAS bf16x8*)(lds + PG8_SA(b, h) + aoff + m * 2048 + k * 1024); } while (0)
#define PG8_LDB(dst, b, h) do { _Pragma("unroll") for (int n = 0; n < 2; ++n) _Pragma("unroll") for (int k = 0; k < 2; ++k) dst[n][k] = *(const PG8_LAS bf16x8*)(lds + PG8_SB(b, h) + boff + n * 2048 + k * 1024); } while (0)
#define PG8_MMA(ai, bj, At, Bt) do { __builtin_amdgcn_s_setprio(1); _Pragma("unroll") for (int m = 0; m < 4; ++m) _Pragma("unroll") for (int n = 0; n < 2; ++n) _Pragma("unroll") for (int k = 0; k < 2; ++k) \
        acc[ai][bj][m][n] = __builtin_amdgcn_mfma_f32_16x16x32_bf16(Bt[n][k], At[m][k], acc[ai][bj][m][n], 0, 0, 0); __builtin_amdgcn_s_setprio(0); } while (0)
#define PG8_WAIT_V(n) asm volatile("s_waitcnt vmcnt(" #n ")" ::: "memory")
#define PG8_WAIT_L(n) asm volatile("s_waitcnt lgkmcnt(" #n ")" ::: "memory")
#define PG8_BAR __builtin_amdgcn_s_barrier()
#define PG8_SCHED __builtin_amdgcn_sched_barrier(0)
    Unit cur, nxt; int ui = 0;
    if (!S.next(0, cur)) return;
    f32x4 acc[2][2][4][2];
#pragma unroll
    for (int a = 0; a < 2; ++a)
#pragma unroll
        for (int b = 0; b < 2; ++b)
#pragma unroll
            for (int m = 0; m < 4; ++m)
#pragma unroll
                for (int n = 0; n < 2; ++n) acc[a][b][m][n] = (f32x4){0.f, 0.f, 0.f, 0.f};
    bf16x8 At[4][2], B0[2][2], B1[2][2];
    const char* cA = (const char*)g.A + (size_t)cur.pm * tstep; const char* cB = (const char*)g.Bt + (size_t)cur.pn * tstep;
    S.a_ready(cur);
    if constexpr (SP2) {
        PG8_STAGE(PG8_SB(0, 0), cB, voffB); PG8_STAGE(PG8_SB(0, 1), cB + hstep, voffB); PG8_STAGE(PG8_SA(0, 0), cA, voffA); PG8_STAGE(PG8_SA(0, 1), cA + hstep, voffA);
        if (wr == 1) PG8_BAR;
        PG8_WAIT_V(2); PG8_BAR;
        PG8_STAGE(PG8_SB(1, 0), cB + kstep, voffB); PG8_STAGE(PG8_SA(1, 0), cA + kstep, voffA); PG8_STAGE(PG8_SB(1, 1), cB + hstep + kstep, voffB);
        PG8_WAIT_V(6); PG8_BAR;
    } else {
        PG8_STAGE(PG8_SB(0, 0), cB, voffB); PG8_STAGE(PG8_SA(0, 0), cA, voffA); PG8_STAGE(PG8_SB(0, 1), cB + hstep, voffB); PG8_STAGE(PG8_SA(0, 1), cA + hstep, voffA);
        if (wr == 1) PG8_BAR;
        PG8_WAIT_V(4); PG8_BAR;
        PG8_STAGE(PG8_SB(1, 0), cB + kstep, voffB); PG8_STAGE(PG8_SA(1, 0), cA + kstep, voffA); PG8_STAGE(PG8_SB(1, 1), cB + hstep + kstep, voffB);
        PG8_WAIT_V(6); PG8_BAR;
    }
    for (;;) {
        const bool has_next = S.next(ui + 1, nxt);
        const char* nA = has_next ? (const char*)g.A + (size_t)nxt.pm * tstep : cA; const char* nB = has_next ? (const char*)g.Bt + (size_t)nxt.pn * tstep : cB;
        for (int t = 0; t < nt; t += 2) {
            const bool last = (t == nt - 2);
            if constexpr (Epi::HOOK_T >= 0) { if (t == Epi::HOOK_T) E.hook(acc, cur, wr, wc, fr, fq); }
            const char* a1 = cA + (size_t)(t + 1) * kstep;
            const char* a2 = last ? nA : cA + (size_t)(t + 2) * kstep; const char* b2 = last ? nB : cB + (size_t)(t + 2) * kstep;
            const char* a3 = a2 + kstep; const char* b3 = b2 + kstep;
            if (last && has_next) S.a_ready(nxt);
            if constexpr (SP2) {
            PG8_LDB(B0, 0, 0); PG8_LDB(B1, 0, 1); PG8_SCHED; PG8_LDA(At, 0, 0); PG8_STAGE(PG8_SA(1, 1), a1 + hstep, voffA);
            PG8_WAIT_V(8); PG8_WAIT_L(0); PG8_BAR; PG8_MMA(0, 0, At, B0); PG8_MMA(0, 1, At, B1); PG8_BAR; PG8_SCHED;
            PG8_LDA(At, 0, 1); PG8_STAGE(PG8_SB(0, 0), b2, voffB); PG8_STAGE(PG8_SB(0, 1), b2 + hstep, voffB); PG8_STAGE(PG8_SA(0, 0), a2, voffA);
            PG8_WAIT_V(8); PG8_WAIT_L(0); PG8_BAR; PG8_MMA(1, 0, At, B0); PG8_MMA(1, 1, At, B1); PG8_BAR; PG8_SCHED;
            PG8_LDB(B0, 1, 0); PG8_LDB(B1, 1, 1); PG8_SCHED; PG8_LDA(At, 1, 0); PG8_STAGE(PG8_SA(0, 1), a2 + hstep, voffA);
            PG8_WAIT_V(8); PG8_WAIT_L(0); PG8_BAR; PG8_MMA(0, 0, At, B0); PG8_MMA(0, 1, At, B1); PG8_BAR; PG8_SCHED;
            PG8_LDA(At, 1, 1); PG8_STAGE(PG8_SB(1, 0), b3, voffB); PG8_STAGE(PG8_SB(1, 1), b3 + hstep, voffB); PG8_STAGE(PG8_SA(1, 0), a3, voffA);
            PG8_WAIT_V(8); PG8_WAIT_L(0); PG8_BAR; PG8_MMA(1, 0, At, B0); PG8_MMA(1, 1, At, B1); PG8_BAR; PG8_SCHED;
            } else {
            PG8_LDB(B0, 0, 0); PG8_SCHED; PG8_LDA(At, 0, 0); PG8_STAGE(PG8_SA(1, 1), a1 + hstep, voffA);
            PG8_WAIT_L(8); PG8_BAR; PG8_WAIT_L(0); PG8_MMA(0, 0, At, B0); PG8_BAR; PG8_SCHED;
            PG8_LDB(B1, 0, 1); PG8_STAGE(PG8_SB(0, 0), b2, voffB);
            PG8_BAR; PG8_WAIT_L(0); PG8_MMA(0, 1, At, B1); PG8_BAR;
            PG8_LDA(At, 0, 1); PG8_STAGE(PG8_SA(0, 0), a2, voffA);
            PG8_BAR; PG8_WAIT_L(0); PG8_MMA(1, 0, At, B0); PG8_BAR; PG8_SCHED;
            PG8_STAGE(PG8_SB(0, 1), b2 + hstep, voffB);
            PG8_WAIT_V(6); PG8_BAR; PG8_MMA(1, 1, At, B1); PG8_BAR;
            PG8_LDB(B0, 1, 0); PG8_SCHED; PG8_LDA(At, 1, 0); PG8_STAGE(PG8_SA(0, 1), a2 + hstep, voffA);
            PG8_WAIT_L(8); PG8_BAR; PG8_WAIT_L(0); PG8_MMA(0, 0, At, B0); PG8_BAR; PG8_SCHED;
            PG8_LDB(B1, 1, 1); PG8_STAGE(PG8_SB(1, 0), b3, voffB);
            PG8_BAR; PG8_WAIT_L(0); PG8_MMA(0, 1, At, B1); PG8_BAR;
            PG8_LDA(At, 1, 1); PG8_STAGE(PG8_SA(1, 0), a3, voffA);
            PG8_BAR; PG8_WAIT_L(0); PG8_MMA(1, 0, At, B0); PG8_BAR; PG8_SCHED;
            PG8_STAGE(PG8_SB(1, 1), b3 + hstep, voffB);
            PG8_WAIT_V(6); PG8_BAR; PG8_MMA(1, 1, At, B1); PG8_BAR;
            }
        }
        if constexpr (ALIGN_EPI) { if (wr == 0) PG8_BAR; }
        if constexpr (!Epi::AFTER_DRAIN) { E(acc, cur, wr, wc, fr, fq); S.done(cur); }
        if (!has_next) break;
#pragma unroll
        for (int a = 0; a < 2; ++a)
#pragma unroll
            for (int b = 0; b < 2; ++b)
#pragma unroll
                for (int m = 0; m < 4; ++m)
#pragma unroll
                    for (int n = 0; n < 2; ++n) acc[a][b][m][n] = (f32x4){0.f, 0.f, 0.f, 0.f};
        cur = nxt; cA = nA; cB = nB; ++ui;
        if constexpr (ALIGN_EPI) { if (wr == 1) PG8_BAR; }
    }
    PG8_WAIT_V(0);
    if constexpr (!ALIGN_EPI) { if (wr == 0) PG8_BAR; }
    PG8_BAR;
    if constexpr (Epi::AFTER_DRAIN) { E.fused(acc, cur, wr, wc, fr, fq, lds, wid, lane); S.done(cur); }
#undef PG8_SA
#undef PG8_SB
#undef PG8_STAGE
#undef PG8_LDA
#undef PG8_LDB
#undef PG8_MMA
#undef PG8_WAIT_V
#undef PG8_WAIT_L
#undef PG8_BAR
#undef PG8_SCHED
}
}

constexpr int NWAVES = 8;
constexpr int DM = 1024, MP = 16384, MS = 512, MT = MP + MS, SEQ = 4096, NBP = 4, NBS = 128, TS = 4, PAST = 2048;
constexpr int NQ = 768, NIN = 4864, INW = 4880, XBCW = 1536, MIXW = 1792, FF = 2816, FF2 = 5632, NH = 12, SH = 16, HD = 64, SST = 128;
constexpr int NCH = 32;
constexpr float EPS = 1e-6f;
constexpr float LOG2E = 1.4426950408889634f, LN2 = 0.6931471805599453f;
constexpr float QSCALE = 0.125f * LOG2E;

constexpr size_t MiB = 1u << 20;
constexpr size_t WS_CTL = 0, CTL_ZERO_BYTES = 1 * MiB;
constexpr size_t WS_WIN  = 2 * MiB;
constexpr size_t WS_WOUT = WS_WIN + 20 * MiB;
constexpr size_t WS_WUP  = WS_WOUT + 8 * MiB;
constexpr size_t WS_WDN  = WS_WUP + 24 * MiB;
constexpr size_t WS_XN   = WS_WDN + 12 * MiB;
constexpr size_t WS_QB   = WS_XN + 36 * MiB;
constexpr size_t WS_KB   = WS_QB + 26 * MiB;
constexpr size_t WS_VB   = WS_KB + 26 * MiB;
constexpr size_t WS_SZ   = WS_VB + 26 * MiB;
constexpr size_t WS_XBC  = WS_SZ + 36 * MiB;
constexpr size_t WS_XBCC = WS_XBC + 52 * MiB;
constexpr size_t WS_DT   = WS_XBCC + 52 * MiB;
constexpr size_t WS_ACUM = WS_DT + 2 * MiB;
constexpr size_t WS_LSE  = WS_ACUM + 2 * MiB;
constexpr size_t WS_ATTO = WS_LSE + 1 * MiB;
constexpr size_t WS_MIX  = WS_ATTO + 26 * MiB;
constexpr size_t WS_SSQP = WS_MIX + 61 * MiB;
constexpr size_t WS_ST   = WS_SSQP + 2 * MiB;
constexpr size_t WS_HPV  = WS_ST + 68 * MiB;
constexpr size_t WS_CDEC = WS_HPV + 34 * MiB;
constexpr size_t WS_X1   = WS_CDEC + 1 * MiB;
constexpr size_t WS_X2   = WS_X1 + 70 * MiB;
constexpr size_t WS_U    = WS_X2 + 70 * MiB;
constexpr size_t WS_G    = WS_U + 192 * MiB;
constexpr size_t WS_END  = WS_G + 96 * MiB;
static_assert((size_t)2 * NIN * DM * 2 <= 20 * MiB && (size_t)2 * DM * MIXW * 2 <= 8 * MiB && (size_t)2 * FF2 * DM * 2 <= 24 * MiB && (size_t)2 * DM * FF * 2 <= 12 * MiB, "weights");
static_assert((size_t)MT * DM * 2 <= 36 * MiB && (size_t)MT * NQ * 2 <= 26 * MiB && (size_t)MT * XBCW * 2 <= 52 * MiB && (size_t)MT * MIXW * 2 <= 61 * MiB && (size_t)MT * DM * 4 <= 70 * MiB && (size_t)MT * FF2 * 2 <= 192 * MiB && (size_t)MT * FF * 2 <= 96 * MiB, "acts");
constexpr int CW_TMO = 0, CW_CODE = 1;
constexpr int CW_BAR = 4096;

constexpr size_t O_YP = 0, O_YS = O_YP + (size_t)MP * DM, O_KVP0 = O_YS + (size_t)MS * DM, O_KVP1 = O_KVP0 + 2 * 4 * 128 * 512, O_KVP2 = O_KVP1 + 2 * 4 * 512 * 512,
                 O_SSMP = O_KVP2 + (size_t)2 * 4 * 2048 * 512, O_CONVP = O_SSMP + 2 * 4 * 16 * 8192, O_FFNP = O_CONVP + 2 * 4 * 3 * XBCW, O_KVS0 = O_FFNP + 2 * 4 * 2 * FF2,
                 O_KVS1 = O_KVS0 + 2 * 128 * 4 * 512, O_KVS2 = O_KVS1 + 2 * 128 * 4 * 512, O_SSMS = O_KVS2 + 2 * 128 * 4 * 512, O_CONVS = O_SSMS + (size_t)2 * 128 * 16 * 8192,
                 O_FFNS = O_CONVS + 2 * 128 * 3 * XBCW, O_END = O_FFNS + 2 * 128 * 2 * FF2;
static_assert(O_END == 68677632, "output size");

constexpr int RING_OFF = 0, RING_BYTES = 131072;
constexpr int LDSCTL_OFF = RING_BYTES, MISC_OFF = LDSCTL_OFF + 320;
constexpr int LDS_BYTES = 147456;
static_assert(MISC_OFF + 128 <= LDS_BYTES, "LDS map");

#define GAS __attribute__((address_space(1)))
#define LAS __attribute__((address_space(3)))
typedef unsigned short bf16;
typedef unsigned v4u __attribute__((ext_vector_type(4)));
typedef float f32x4 __attribute__((ext_vector_type(4)));
typedef short bf16x8 __attribute__((ext_vector_type(8)));
typedef GAS unsigned gu32;
typedef GAS unsigned long long gu64;
#define RLX_AGENT __ATOMIC_RELAXED, __HIP_MEMORY_SCOPE_AGENT
#define LDS_WAIT() asm volatile("s_waitcnt lgkmcnt(0)" ::: "memory")
#define VM_WAIT() asm volatile("s_waitcnt vmcnt(0)" ::: "memory")
__device__ __forceinline__ unsigned long long rt() { return __builtin_amdgcn_s_memrealtime(); }
__device__ __forceinline__ unsigned f2bf(float f) { unsigned u = __builtin_bit_cast(unsigned, f); return (u + 0x7fffu + ((u >> 16) & 1u)) >> 16; }
__device__ __forceinline__ unsigned pk2(float lo, float hi) { return f2bf(lo) | (f2bf(hi) << 16); }

#define XB_TMO      128
#define XB_XCNT(j)  (256  + 64 * (j))
#define XB_XSUB(j)  (1280 + 64 * (j))
#define XB_XGEN(j)  (2304 + 64 * (j))
#define XB_TOP      3328
#define XB_TOPGEN   3392
#define XCD_BAR_WORDS 3456
#define XB_SPIN_CAP (1u << 18)

__device__ __forceinline__ unsigned xb_ld(unsigned* p)              { return __hip_atomic_load(p, __ATOMIC_RELAXED, __HIP_MEMORY_SCOPE_AGENT); }
__device__ __forceinline__ unsigned xb_add(unsigned* p, unsigned v) { return __hip_atomic_fetch_add(p, v, __ATOMIC_RELAXED, __HIP_MEMORY_SCOPE_AGENT); }
__device__ __forceinline__ unsigned xb_xcc_id() { return (unsigned)__builtin_amdgcn_s_getreg((3 << 11) | 20) & 0xFu; }
#define XB_SPIN(cond, bar) do { unsigned _sp = 0; while (cond) { __builtin_amdgcn_s_sleep(1); \
    if ((++_sp & 255u) == 0u) { if (xb_ld(&(bar)[XB_TMO])) break; if (_sp > XB_SPIN_CAP) { atomicAdd(&(bar)[XB_TMO], 1u); break; } } } } while (0)

struct XcdBarrier {
    unsigned* bar; unsigned x;
    volatile LAS unsigned* st;
};

__device__ __forceinline__ XcdBarrier xcd_barrier_post(unsigned* bar, volatile LAS unsigned* st) {
    XcdBarrier b; b.bar = bar; b.x = xb_xcc_id(); b.st = st;
    if (threadIdx.x == 0) (void)xb_add(&bar[XB_XCNT(b.x)], 1u);
    return b;
}
__device__ __forceinline__ void xcd_barrier_complete(unsigned* bar, unsigned x, unsigned& nloc, unsigned& nx) {
    const unsigned G = gridDim.x * gridDim.y * gridDim.z;
    unsigned sum, cnt, mine, sp = 0u;
    for (;;) {
        sum = 0u; cnt = 0u; mine = 0u;
#pragma unroll
        for (unsigned j = 0; j < 16; ++j) { const unsigned c = xb_ld(&bar[XB_XCNT(j)]); sum += c; cnt += (c > 0u) ? 1u : 0u; mine = (j == x) ? c : mine; }
        if (sum == G) break;
        __builtin_amdgcn_s_sleep(1);
        if ((++sp & 255u) == 0u) { if (xb_ld(&bar[XB_TMO])) break; if (sp > XB_SPIN_CAP) { atomicAdd(&bar[XB_TMO], 1u); break; } }
    }
    nloc = mine > 0u ? mine : 1u; nx = cnt > 0u ? cnt : 1u;
}

__device__ __forceinline__ void xcd_barrier(const XcdBarrier& b) {
    asm volatile("s_waitcnt vmcnt(0)" ::: "memory");
    __syncthreads();
    if (threadIdx.x == 0) {
        unsigned* bar = b.bar;
        __builtin_amdgcn_s_waitcnt(0);
        unsigned nloc = b.st[0], nx = b.st[1];
        if (nloc == 0u) { xcd_barrier_complete(bar, b.x, nloc, nx); b.st[0] = nloc; b.st[1] = nx; }
        const unsigned old = xb_add(&bar[XB_XSUB(b.x)], 1u);
        const unsigned gen = old / nloc;
        if (old + 1u == (gen + 1u) * nloc) {
            __builtin_amdgcn_fence(__ATOMIC_RELEASE, "agent");
            asm volatile("s_waitcnt vmcnt(0)" ::: "memory");
            const unsigned og = xb_add(&bar[XB_TOP], 1u);
            const unsigned tg = og / nx;
            if (og + 1u == (tg + 1u) * nx) xb_add(&bar[XB_TOPGEN], 1u);
            else XB_SPIN(xb_ld(&bar[XB_TOPGEN]) == tg, bar);
            __builtin_amdgcn_fence(__ATOMIC_ACQUIRE, "agent");
            xb_add(&bar[XB_XGEN(b.x)], 1u);
            asm volatile("s_waitcnt vmcnt(0)" ::: "memory");
        } else {
            XB_SPIN(xb_ld(&bar[XB_XGEN(b.x)]) == gen, bar);
            __builtin_amdgcn_fence(__ATOMIC_ACQUIRE, "agent");
            asm volatile("s_waitcnt vmcnt(0)" ::: "memory");
        }
    }
    __syncthreads();
}


typedef short v4i16_t __attribute__((ext_vector_type(4)));
typedef float f32x2 __attribute__((ext_vector_type(2)));
typedef unsigned v2u __attribute__((ext_vector_type(2)));
__device__ __forceinline__ float bflo(unsigned w) { return __uint_as_float(w << 16); }
__device__ __forceinline__ float bfhi(unsigned w) { return __uint_as_float(w & 0xffff0000u); }
__device__ __forceinline__ float bf2f(unsigned short u) { return __uint_as_float((unsigned)u << 16); }
__device__ __forceinline__ unsigned cvtpk(float lo, float hi) { return pg8::cvt_pk_bf16(lo, hi); }
__device__ __forceinline__ float silu_f(float x) { return x * __builtin_amdgcn_rcpf(1.f + __expf(-x)); }
__device__ __forceinline__ float softplus_f(float x) { return x > 20.f ? x : log1pf(__expf(x)); }
__device__ __forceinline__ float wave_sum(float v) {
#pragma unroll
    for (int o = 1; o < 64; o <<= 1) v += __shfl_xor(v, o);
    return v;
}
__device__ __forceinline__ bf16x8 tr2(const LAS char* p0, const LAS char* p1) {
    const v4i16_t a = __builtin_amdgcn_ds_read_tr16_b64_v4i16((LAS v4i16_t*)p0), b = __builtin_amdgcn_ds_read_tr16_b64_v4i16((LAS v4i16_t*)p1);
    return __builtin_shufflevector(a, b, 0, 1, 2, 3, 4, 5, 6, 7);
}
__device__ __forceinline__ f32x4 mfma16(bf16x8 a, bf16x8 b, f32x4 c) { return __builtin_amdgcn_mfma_f32_16x16x32_bf16(a, b, c, 0, 0, 0); }

struct EpiInProj {
    static constexpr bool PERM = true, AFTER_DRAIN = false; static constexpr int HOOK_T = -1;
    bf16 *QB, *KB, *VB, *SZ, *XBC; const float *qn, *kn; float* out; int layer;
    __device__ __forceinline__ void kv_out(int row, int g, int kv, int slot, int e0, f32x4 v0, f32x4 v1) const {
        const int keep = 128 << (2 * g);
        float* p = nullptr;
        if (row < MP) { const int b = row >> 12, t = row & 4095;
            if (t >= SEQ - keep) { const size_t base = g == 0 ? O_KVP0 : (g == 1 ? O_KVP1 : O_KVP2);
                p = out + base + ((((size_t)(layer * NBP + b) * keep + (t - (SEQ - keep))) * 2 + kv) * 4 + slot) * 64 + e0; } }
        else { const int rs = row - MP, b = rs >> 2, t = rs & 3; const size_t base = g == 0 ? O_KVS0 : (g == 1 ? O_KVS1 : O_KVS2);
            p = out + base + ((((size_t)(layer * NBS + b) * TS + t) * 2 + kv) * 4 + slot) * 64 + e0; }
        if (p) { *(f32x4*)p = v0; *(f32x4*)(p + 4) = v1; }
    }
    __device__ __forceinline__ void operator()(const f32x4 (&acc)[2][2][4][2], const pg8::Unit& u, int wr, int wc, int fr, int fq) const {
        const int pn = u.pn, rbase = u.pm * 256 + wr * 64 + fr, ct = 64 * wc + 8 * fq;
        if (pn < 6) {
            const bool isq = pn < 3; const float* gn = isq ? +qn : +kn;
            f32x4 g[2][2];
#pragma unroll
            for (int bj = 0; bj < 2; ++bj)
#pragma unroll
                for (int n = 0; n < 2; ++n) g[bj][n] = *(const f32x4*)(gn + 32 * bj + 8 * fq + 4 * n);
            const float post = isq ? QSCALE : 1.f; bf16* dst = isq ? +QB : +KB; const int c0 = (isq ? pn : pn - 3) * 256 + ct;
#pragma unroll
            for (int ai = 0; ai < 2; ++ai)
#pragma unroll
                for (int m = 0; m < 4; ++m) { const int row = rbase + ai * 128 + m * 16; float ss = 0.f;
#pragma unroll
                    for (int bj = 0; bj < 2; ++bj)
#pragma unroll
                        for (int n = 0; n < 2; ++n) { const f32x4 x = acc[ai][bj][m][n]; ss += (x[0] * x[0] + x[1] * x[1]) + (x[2] * x[2] + x[3] * x[3]); }
                    ss += __shfl_xor(ss, 16); ss += __shfl_xor(ss, 32);
                    const float rs = rsqrtf(ss * (1.f / 64.f) + EPS);
#pragma unroll
                    for (int bj = 0; bj < 2; ++bj) { const f32x4 v0 = acc[ai][bj][m][0] * rs * g[bj][0], v1 = acc[ai][bj][m][1] * rs * g[bj][1];
                        v4u w; w.x = cvtpk(v0[0] * post, v0[1] * post); w.y = cvtpk(v0[2] * post, v0[3] * post); w.z = cvtpk(v1[0] * post, v1[1] * post); w.w = cvtpk(v1[2] * post, v1[3] * post);
                        *(v4u*)(dst + (size_t)row * NQ + c0 + 32 * bj) = w;
                        if (!isq) kv_out(row, pn - 3, 0, wc, 32 * bj + 8 * fq, v0, v1); } }
        } else if (pn < 9) {
            const int c0 = (pn - 6) * 256 + ct;
#pragma unroll
            for (int ai = 0; ai < 2; ++ai)
#pragma unroll
                for (int m = 0; m < 4; ++m) { const int row = rbase + ai * 128 + m * 16;
#pragma unroll
                    for (int bj = 0; bj < 2; ++bj) { const f32x4 v0 = acc[ai][bj][m][0], v1 = acc[ai][bj][m][1];
                        v4u w; w.x = cvtpk(v0[0], v0[1]); w.y = cvtpk(v0[2], v0[3]); w.z = cvtpk(v1[0], v1[1]); w.w = cvtpk(v1[2], v1[3]);
                        *(v4u*)(VB + (size_t)row * NQ + c0 + 32 * bj) = w;
                        kv_out(row, pn - 6, 1, wc, 32 * bj + 8 * fq, v0, v1); } }
        } else if (pn < 13) {
            const int c0 = (pn - 9) * 256 + ct;
#pragma unroll
            for (int ai = 0; ai < 2; ++ai)
#pragma unroll
                for (int m = 0; m < 4; ++m) { const int row = rbase + ai * 128 + m * 16;
#pragma unroll
                    for (int bj = 0; bj < 2; ++bj) { const f32x4 v0 = acc[ai][bj][m][0], v1 = acc[ai][bj][m][1];
                        v4u w; w.x = cvtpk(silu_f(v0[0]), silu_f(v0[1])); w.y = cvtpk(silu_f(v0[2]), silu_f(v0[3])); w.z = cvtpk(silu_f(v1[0]), silu_f(v1[1])); w.w = cvtpk(silu_f(v1[2]), silu_f(v1[3]));
                        *(v4u*)(SZ + (size_t)row * DM + c0 + 32 * bj) = w; } }
        } else {
            const int c0 = (pn - 13) * 256 + ct;
#pragma unroll
            for (int ai = 0; ai < 2; ++ai)
#pragma unroll
                for (int m = 0; m < 4; ++m) { const int row = rbase + ai * 128 + m * 16;
                    float* p = nullptr;
                    if (row < MP) { const int b = row >> 12, t = row & 4095; if (t >= SEQ - 3) p = out + O_CONVP + ((size_t)(layer * NBP + b) * 3 + (t - (SEQ - 3))) * XBCW + c0; }
                    else { const int rs = row - MP, b = rs >> 2, t = rs & 3; if (t >= 1) p = out + O_CONVS + ((size_t)(layer * NBS + b) * 3 + (t - 1)) * XBCW + c0; }
#pragma unroll
                    for (int bj = 0; bj < 2; ++bj) { const f32x4 v0 = acc[ai][bj][m][0], v1 = acc[ai][bj][m][1];
                        v4u w; w.x = cvtpk(v0[0], v0[1]); w.y = cvtpk(v0[2], v0[3]); w.z = cvtpk(v1[0], v1[1]); w.w = cvtpk(v1[2], v1[3]);
                        *(v4u*)(XBC + (size_t)row * XBCW + c0 + 32 * bj) = w;
                        if (p) { *(f32x4*)(p + 32 * bj) = v0; *(f32x4*)(p + 32 * bj + 4) = v1; } } }
        }
    }
    __device__ __forceinline__ void hook(f32x4 (&)[2][2][4][2], const pg8::Unit&, int, int, int, int) const {}
};

template <int HT> struct EpiResid {
    static constexpr bool PERM = true, AFTER_DRAIN = false; static constexpr int HOOK_T = HT;
    const float* baseP; const float* baseS; float* outp; const float* ssqp;
    __device__ __forceinline__ void operator()(const f32x4 (&acc)[2][2][4][2], const pg8::Unit& u, int wr, int wc, int fr, int fq) const {
        const int rbase = u.pm * 256 + wr * 64 + fr, col0 = u.pn * 256 + wc * 32 + 8 * fq;
#pragma unroll
        for (int ai = 0; ai < 2; ++ai)
#pragma unroll
            for (int m = 0; m < 4; ++m) { const int row = rbase + ai * 128 + m * 16;
                const float* bp = row < MP ? baseP + (size_t)row * DM : baseS + (size_t)(row - MP) * DM; float* op = outp + (size_t)row * DM;
#pragma unroll
                for (int bj = 0; bj < 2; ++bj) { const int c = col0 + 128 * bj;
                    const f32x4 b0 = *(const f32x4*)(bp + c), b1 = *(const f32x4*)(bp + c + 4);
                    *(f32x4*)(op + c) = b0 + acc[ai][bj][m][0]; *(f32x4*)(op + c + 4) = b1 + acc[ai][bj][m][1]; } }
    }
    __device__ __forceinline__ void hook(f32x4 (&acc)[2][2][4][2], const pg8::Unit& u, int wr, int wc, int fr, int fq) const {
        int rbase = u.pm * 256 + wr * 64 + fr; asm volatile("" : "+v"(rbase));
#pragma unroll
        for (int ai = 0; ai < 2; ++ai)
#pragma unroll
            for (int m = 0; m < 4; ++m) { const int row = rbase + ai * 128 + m * 16; const f32x4* sp = (const f32x4*)(ssqp + (size_t)row * 16);
                const f32x4 a = sp[0], b = sp[1], c = sp[2], d = sp[3];
                const float s = ((a[0] + a[1]) + (a[2] + a[3])) + ((b[0] + b[1]) + (b[2] + b[3])) + ((c[0] + c[1]) + (c[2] + c[3])) + ((d[0] + d[1]) + (d[2] + d[3]));
                const float rs = rsqrtf(s * (1.f / 1024.f) + EPS);
#pragma unroll
                for (int bj = 0; bj < 2; ++bj)
#pragma unroll
                    for (int n = 0; n < 2; ++n) acc[ai][bj][m][n] = acc[ai][bj][m][n] * rs;
                asm volatile("" ::: "memory"); }
    }
};

struct EpiUp {
    static constexpr bool PERM = true, AFTER_DRAIN = false; static constexpr int HOOK_T = -1;
    bf16* U; float* out; int layer;
    __device__ __forceinline__ void operator()(const f32x4 (&acc)[2][2][4][2], const pg8::Unit& u, int wr, int wc, int fr, int fq) const {
        const int rbase = u.pm * 256 + wr * 64 + fr, col0 = u.pn * 256 + wc * 32 + 8 * fq, tc0 = 128 * u.pn + 32 * wc + 8 * fq;
#pragma unroll
        for (int ai = 0; ai < 2; ++ai)
#pragma unroll
            for (int m = 0; m < 4; ++m) { const int row = rbase + ai * 128 + m * 16;
                float* p = nullptr;
                if (row < MP) { const int b = row >> 12, t = row & 4095; if (t >= SEQ - 2) p = out + O_FFNP + ((size_t)(layer * NBP + b) * 2 + (t - (SEQ - 2))) * FF2 + tc0; }
                else { const int rs = row - MP, b = rs >> 2, t = rs & 3; if (t >= 2) p = out + O_FFNS + ((size_t)(layer * NBS + b) * 2 + (t - 2)) * FF2 + tc0; }
#pragma unroll
                for (int bj = 0; bj < 2; ++bj) { const f32x4 v0 = acc[ai][bj][m][0], v1 = acc[ai][bj][m][1];
                    v4u w; w.x = cvtpk(v0[0], v0[1]); w.y = cvtpk(v0[2], v0[3]); w.z = cvtpk(v1[0], v1[1]); w.w = cvtpk(v1[2], v1[3]);
                    *(v4u*)(U + (size_t)row * FF2 + col0 + 128 * bj) = w;
                    if (p) { *(f32x4*)(p + bj * FF) = v0; *(f32x4*)(p + bj * FF + 4) = v1; } } }
    }
    __device__ __forceinline__ void hook(f32x4 (&)[2][2][4][2], const pg8::Unit&, int, int, int, int) const {}
};
__device__ __forceinline__ float dbg_sane(float x) { return (x == x && fabsf(x) < 1e30f) ? x : 12345.f; }

struct Args { const float* in[24]; float* out; unsigned char* ws; int ph_lo, ph_hi; };
struct Frame {
    LAS unsigned char* lds;
    volatile LAS unsigned* MISC;
    gu32* ctl;
    int tid, lane, wave, vcu, G;
    const Args* a;
};
enum { I_XP = 0, I_XS, I_KV0, I_KV1, I_KV2, I_SSM, I_CONV, I_FFNC, I_NMIX, I_WIN, I_QN, I_KN, I_CW, I_CB, I_DTB, I_ALOG, I_DSKIP, I_SNORM, I_WOUT, I_NFFN, I_WUP, I_FCW, I_FCB, I_WDN };

__device__ __forceinline__ void p0_item(const float* W, int ldw, int sk0, int sn0, bf16* WT, int ldk, int dk0, int dn0, const float* kscale, LAS float* scr, int lane) {
#pragma unroll 8
    for (int i = 0; i < 32; ++i) { const int kk = 2 * i + (lane >> 5); float v = W[(size_t)(sk0 + kk) * ldw + sn0 + (lane & 31)]; if (kscale) v *= kscale[kk]; scr[kk * 33 + (lane & 31)] = v; }
    LDS_WAIT(); asm volatile("" ::: "memory");
    const int c = lane & 7;
#pragma unroll
    for (int j = 0; j < 4; ++j) { const int n = (lane >> 3) + 8 * j; const LAS float* s = scr + (8 * c) * 33 + n;
        v4u o; o.x = pk2(s[0 * 33], s[1 * 33]); o.y = pk2(s[2 * 33], s[3 * 33]); o.z = pk2(s[4 * 33], s[5 * 33]); o.w = pk2(s[6 * 33], s[7 * 33]);
        *(GAS v4u*)(WT + (size_t)(dn0 + n) * ldk + dk0 + 8 * c) = o; }
    LDS_WAIT(); asm volatile("" ::: "memory");
}
__device__ __forceinline__ void p0_prologue(Frame& F) {
    LAS float* scr = (LAS float*)(F.lds + RING_OFF + F.wave * 16384);
    const int gw = F.vcu * NWAVES + F.wave, NGW = F.G * NWAVES;
    constexpr int I_IN = 16 * (NIN / 32), I_OUT = 28 * (DM / 32), I_UP = 16 * (FF2 / 32), I_DN = 44 * (DM / 32), PER_L = I_IN + I_OUT + I_UP + I_DN;
    for (int it = gw; it < 2 * PER_L; it += NGW) {
        const int L = it / PER_L; int r = it % PER_L;
        if (r < I_IN) { const int nb = r % (NIN / 32), kb = r / (NIN / 32), n0 = nb * 32, pn = n0 >> 8, rr = n0 & 255, bj = rr >> 7, wc = (rr & 127) >> 5;
            p0_item(F.a->in[I_WIN] + (size_t)L * DM * INW, INW, kb * 64, 256 * pn + 64 * wc + 32 * bj, ((bf16*)(F.a->ws + WS_WIN)) + (size_t)L * NIN * DM, DM, kb * 64, n0, nullptr, scr, F.lane); continue; }
        r -= I_IN;
        if (r < I_OUT) { const int nb = r % (DM / 32), kb = r / (DM / 32), dk0 = kb * 64, sk0 = dk0 < 1024 ? 768 + dk0 : dk0 - 1024;
            p0_item(F.a->in[I_WOUT] + (size_t)L * MIXW * DM, DM, sk0, nb * 32, ((bf16*)(F.a->ws + WS_WOUT)) + (size_t)L * DM * MIXW, MIXW, dk0, nb * 32, dk0 < 1024 ? F.a->in[I_SNORM] + L * DM + dk0 : nullptr, scr, F.lane); continue; }
        r -= I_OUT;
        if (r < I_UP) { const int nb = r % (FF2 / 32), kb = r / (FF2 / 32), n0 = nb * 32, pn = n0 >> 8, rr = n0 & 255, bj = rr >> 7, r2 = rr & 127;
            p0_item(F.a->in[I_WUP] + (size_t)L * DM * FF2, FF2, kb * 64, bj * FF + 128 * pn + r2, ((bf16*)(F.a->ws + WS_WUP)) + (size_t)L * FF2 * DM, DM, kb * 64, n0, nullptr, scr, F.lane); continue; }
        r -= I_UP;
        { const int nb = r % (DM / 32), kb = r / (DM / 32);
            p0_item(F.a->in[I_WDN] + (size_t)L * FF * DM, DM, kb * 64, nb * 32, ((bf16*)(F.a->ws + WS_WDN)) + (size_t)L * DM * FF, FF, kb * 64, nb * 32, nullptr, scr, F.lane); }
    }
}

template <bool WITH_DT> __device__ __forceinline__ void norm_phase(Frame& F, int L, const float* srcP, const float* srcS, const float* gain) {
    constexpr int WP = 1028;
    LAS float* wdt = (LAS float*)(F.lds + RING_OFF);
    if (WITH_DT) {
        const float* w = F.a->in[I_WIN] + (size_t)L * DM * INW + NIN;
        for (int idx = F.tid; idx < 16 * DM; idx += NWAVES * 64) { const int k = idx >> 4, j = idx & 15; wdt[j * WP + k] = w[(size_t)k * INW + j]; }
        __syncthreads();
    }
    const int gw = F.vcu * NWAVES + F.wave, NGW = F.G * NWAVES, lane = F.lane;
    f32x4 gv[4];
#pragma unroll
    for (int j = 0; j < 4; ++j) gv[j] = *(const f32x4*)(gain + 4 * lane + 256 * j);
    for (int row = gw; row < MT; row += NGW) {
        const float* xr = row < MP ? srcP + (size_t)row * DM : srcS + (size_t)(row - MP) * DM;
        f32x4 v[4]; float s = 0.f;
#pragma unroll
        for (int j = 0; j < 4; ++j) { v[j] = *(const f32x4*)(xr + 4 * lane + 256 * j); s += (v[j][0] * v[j][0] + v[j][1] * v[j][1]) + (v[j][2] * v[j][2] + v[j][3] * v[j][3]); }
        const float rstd = rsqrtf(wave_sum(s) * (1.f / DM) + EPS);
#pragma unroll
        for (int j = 0; j < 4; ++j) { v[j] = v[j] * rstd * gv[j];
            v2u o; o.x = cvtpk(v[j][0], v[j][1]); o.y = cvtpk(v[j][2], v[j][3]);
            *(v2u*)(((bf16*)(F.a->ws + WS_XN)) + (size_t)row * DM + 4 * lane + 256 * j) = o; }
        if (WITH_DT) {
            float a[16];
#pragma unroll
            for (int o = 0; o < 16; ++o) { float t = 0.f;
#pragma unroll
                for (int j = 0; j < 4; ++j) { const f32x4 w = *(const LAS f32x4*)(wdt + o * WP + 4 * lane + 256 * j); t += (v[j][0] * w[0] + v[j][1] * w[1]) + (v[j][2] * w[2] + v[j][3] * w[3]); }
                a[o] = t; if ((o & 3) == 3) asm volatile("" ::: "memory"); }
            const bool b0 = lane & 1, b1 = lane & 2, b2 = lane & 4, b3 = lane & 8;
#pragma unroll
            for (int i = 0; i < 8; ++i) { const float send = b0 ? a[i] : a[i + 8], keep = b0 ? a[i + 8] : a[i]; a[i] = keep + __shfl_xor(send, 1); }
#pragma unroll
            for (int i = 0; i < 4; ++i) { const float send = b1 ? a[i] : a[i + 4], keep = b1 ? a[i + 4] : a[i]; a[i] = keep + __shfl_xor(send, 2); }
#pragma unroll
            for (int i = 0; i < 2; ++i) { const float send = b2 ? a[i] : a[i + 2], keep = b2 ? a[i + 2] : a[i]; a[i] = keep + __shfl_xor(send, 4); }
            { const float send = b3 ? a[0] : a[1], keep = b3 ? a[1] : a[0]; a[0] = keep + __shfl_xor(send, 8); }
            float t = a[0]; t += __shfl_xor(t, 16); t += __shfl_xor(t, 32);
            const int idx = (b0 ? 8 : 0) + (b1 ? 4 : 0) + (b2 ? 2 : 0) + (b3 ? 1 : 0);
            if (lane < 16) ((float*)(F.a->ws + WS_DT))[(size_t)row * 16 + idx] = softplus_f(t + F.a->in[I_DTB][L * 16 + idx]);
        }
    }
}

constexpr int AT_PITCH = 144, AT_K = 0, AT_V = 256 * AT_PITCH, AT_BYTES = AT_V + 272 * AT_PITCH;
__device__ __forceinline__ void attn_prompt_unit(Frame& F, int b, int hd, int blk) {
    const int g = hd >> 2, d = 1 << (2 * g), nb = 32 >> (2 * g), r = blk / nb, n = blk % nb;
    LAS char* Ks = (LAS char*)(F.lds + RING_OFF + AT_K); LAS char* Vs = (LAS char*)(F.lds + RING_OFF + AT_V);
    const int tid = F.tid, lane = F.lane, w = F.wave, fr = lane & 15, fq = lane >> 4;
#pragma unroll
    for (int i = 0; i < 4; ++i) { const int c = tid + 512 * i, j = c >> 3, ch = c & 7; const int np = n - 1 + (j >> 7);
        v4u kv = (v4u){0u, 0u, 0u, 0u}, vv = (v4u){0u, 0u, 0u, 0u};
        if (np >= 0) { const size_t row = (size_t)b * SEQ + (size_t)(np * 128 + (j & 127)) * d + r; kv = *(const v4u*)(((bf16*)(F.a->ws + WS_KB)) + row * NQ + hd * 64 + ch * 8); vv = *(const v4u*)(((bf16*)(F.a->ws + WS_VB)) + row * NQ + hd * 64 + ch * 8); }
        *(LAS v4u*)(Ks + j * AT_PITCH + ch * 16) = kv; *(LAS v4u*)(Vs + j * AT_PITCH + ch * 16) = vv; }
    if (tid < 128) { const int j = 256 + (tid >> 3), ch = tid & 7; *(LAS v4u*)(Vs + j * AT_PITCH + ch * 16) = (v4u){0u, 0u, 0u, 0u}; }
    const int iq = 16 * w + fr; const size_t qrow = (size_t)b * SEQ + (size_t)(n * 128 + iq) * d + r;
    bf16x8 qf[2];
#pragma unroll
    for (int ks = 0; ks < 2; ++ks) qf[ks] = *(const bf16x8*)(((bf16*)(F.a->ws + WS_QB)) + qrow * NQ + hd * 64 + 32 * ks + 8 * fq);
    __syncthreads();
    const float slope2 = exp2f(-8.f * (float)(hd + 1) / 12.f) * LOG2E * (float)d;
    f32x4 s[10]; float mx = -1e30f;
#pragma unroll
    for (int tt = 0; tt < 9; ++tt) { f32x4 a = (f32x4){0.f, 0.f, 0.f, 0.f};
#pragma unroll
        for (int ks = 0; ks < 2; ++ks) { const bf16x8 kf = *(const LAS bf16x8*)(Ks + (16 * (w + tt) + fr) * AT_PITCH + (32 * ks + 8 * fq) * 2); a = mfma16(kf, qf[ks], a); }
#pragma unroll
        for (int e = 0; e < 4; ++e) { const int j = 16 * (w + tt) + 4 * fq + e, step = iq + 128 - j; const bool valid = (step >= 0) && (step <= 128) && (n > 0 || j >= 128);
            a[e] = valid ? a[e] - slope2 * (float)step : -1e30f; mx = fmaxf(mx, a[e]); }
        s[tt] = a; }
    mx = fmaxf(mx, __shfl_xor(mx, 16)); mx = fmaxf(mx, __shfl_xor(mx, 32));
    float l = 0.f;
#pragma unroll
    for (int tt = 0; tt < 9; ++tt)
#pragma unroll
        for (int e = 0; e < 4; ++e) { const float p = exp2f(s[tt][e] - mx); s[tt][e] = p; l += p; }
    s[9] = (f32x4){0.f, 0.f, 0.f, 0.f};
    l += __shfl_xor(l, 16); l += __shfl_xor(l, 32);
    f32x4 o[4];
#pragma unroll
    for (int dt = 0; dt < 4; ++dt) o[dt] = (f32x4){0.f, 0.f, 0.f, 0.f};
#pragma unroll
    for (int s5 = 0; s5 < 5; ++s5) {
        bf16x8 pf; { const f32x4 p0 = s[2 * s5], p1 = s[2 * s5 + 1]; v4u t; t.x = cvtpk(p0[0], p0[1]); t.y = cvtpk(p0[2], p0[3]); t.z = cvtpk(p1[0], p1[1]); t.w = cvtpk(p1[2], p1[3]); pf = __builtin_bit_cast(bf16x8, t); }
        const int k0 = 16 * (w + 2 * s5) + 4 * fq + ((lane & 15) >> 2);
#pragma unroll
        for (int dt = 0; dt < 4; ++dt) { const LAS char* p0 = Vs + k0 * AT_PITCH + (16 * dt + 4 * (lane & 3)) * 2; o[dt] = mfma16(tr2(p0, p0 + 16 * AT_PITCH), pf, o[dt]); }
    }
    const float inv = 1.f / l;
#pragma unroll
    for (int dt = 0; dt < 4; ++dt) { v2u t; t.x = cvtpk(o[dt][0] * inv, o[dt][1] * inv); t.y = cvtpk(o[dt][2] * inv, o[dt][3] * inv); *(v2u*)(((bf16*)(F.a->ws + WS_ATTO)) + qrow * NQ + hd * 64 + 16 * dt + 4 * fq) = t; }
    if (fq == 0) ((float*)(F.a->ws + WS_LSE))[qrow * 12 + hd] = (mx + log2f(l)) * LN2;
    __syncthreads();
}

__device__ __forceinline__ void attn_sample_task(Frame& F, int L, int b, int g, int t) {
    const int lane = F.lane, dil = 1 << (2 * g), Lc = 128 << (2 * g), hs = lane >> 4;
    const size_t row = (size_t)MP + b * TS + t;
    const float* const ck0 = F.a->in[I_KV0]; const float* const ck1 = F.a->in[I_KV1]; const float* const ck2 = F.a->in[I_KV2];
    const float* cache = (g == 0 ? ck0 : (g == 1 ? ck1 : ck2)) + ((size_t)(L * NBS + b) * Lc) * 512;
    const float slope2 = exp2f(-8.f * (float)(4 * g + hs + 1) / 12.f) * LOG2E * (float)dil;
    f32x4 q; { const v2u w = *(const v2u*)(((bf16*)(F.a->ws + WS_QB)) + row * NQ + 256 * g + 4 * lane); q = (f32x4){bflo(w.x), bfhi(w.x), bflo(w.y), bfhi(w.y)}; }
    float m = -1e30f, l = 0.f; f32x4 o = (f32x4){0.f, 0.f, 0.f, 0.f};
    const int nnew = (g == 0) ? t + 1 : 1;
    for (int j = 0; j < nnew; ++j) { const size_t kr = (size_t)MP + b * TS + (t - j);
        const v2u kw = *(const v2u*)(((bf16*)(F.a->ws + WS_KB)) + kr * NQ + 256 * g + 4 * lane), vw = *(const v2u*)(((bf16*)(F.a->ws + WS_VB)) + kr * NQ + 256 * g + 4 * lane);
        float sc = (q[0] * bflo(kw.x) + q[1] * bfhi(kw.x)) + (q[2] * bflo(kw.y) + q[3] * bfhi(kw.y));
        sc += __shfl_xor(sc, 1); sc += __shfl_xor(sc, 2); sc += __shfl_xor(sc, 4); sc += __shfl_xor(sc, 8);
        sc -= slope2 * (float)j;
        const float mn = fmaxf(m, sc), scale = exp2f(m - mn), p = exp2f(sc - mn);
        l = l * scale + p; o = o * scale + (f32x4){bflo(vw.x), bfhi(vw.x), bflo(vw.y), bfhi(vw.y)} * p; m = mn; }
    for (int jb = 0; jb < 128; jb += 8) {
        f32x4 kk[8], vv[8]; float sc[8];
#pragma unroll
        for (int u = 0; u < 8; ++u) { const int j = jb + u + nnew; int cr = Lc + t - j * dil; cr = cr < 0 ? 0 : cr;
            const float* p = cache + (size_t)cr * 512 + 4 * lane; kk[u] = __builtin_nontemporal_load((const f32x4*)p); vv[u] = __builtin_nontemporal_load((const f32x4*)(p + 256)); }
        float mb = -1e30f;
#pragma unroll
        for (int u = 0; u < 8; ++u) { const int j = jb + u + nnew; float x = (q[0] * kk[u][0] + q[1] * kk[u][1]) + (q[2] * kk[u][2] + q[3] * kk[u][3]);
            x += __shfl_xor(x, 1); x += __shfl_xor(x, 2); x += __shfl_xor(x, 4); x += __shfl_xor(x, 8);
            x = (j <= 128) ? x - slope2 * (float)j : -1e30f; sc[u] = x; mb = fmaxf(mb, x); }
        const float mn = fmaxf(m, mb), scale = exp2f(m - mn); l *= scale; o = o * scale;
#pragma unroll
        for (int u = 0; u < 8; ++u) { const float p = exp2f(sc[u] - mn); l += p; o = o + vv[u] * p; }
        m = mn;
    }
    const float inv = 1.f / l;
    v2u ow; ow.x = cvtpk(o[0] * inv, o[1] * inv); ow.y = cvtpk(o[2] * inv, o[3] * inv);
    *(v2u*)(((bf16*)(F.a->ws + WS_ATTO)) + row * NQ + 256 * g + 4 * lane) = ow;
    if ((lane & 15) == 0) ((float*)(F.a->ws + WS_LSE))[row * 12 + 4 * g + hs] = (m + log2f(l)) * LN2;
}

__device__ __forceinline__ void alpha_row(Frame& F, int row) {
    const int lane = F.lane; const float* ls = ((float*)(F.a->ws + WS_LSE)) + (size_t)row * 12;
#pragma unroll
    for (int rep = 0; rep < 2; ++rep) { const int c = lane + 64 * rep;
        if (c < 96) { const int hd = c >> 3, slot = hd & 3; const float l0 = ls[slot], l1 = ls[4 + slot], l2 = ls[8 + slot], mx = fmaxf(l0, fmaxf(l1, l2));
            const float e0 = __expf(l0 - mx), e1 = __expf(l1 - mx), e2 = __expf(l2 - mx), al = (hd < 4 ? e0 : (hd < 8 ? e1 : e2)) / (e0 + e1 + e2);
            const v4u x = *(const v4u*)(((bf16*)(F.a->ws + WS_ATTO)) + (size_t)row * NQ + 8 * c); v4u y;
            y.x = cvtpk(bflo(x.x) * al, bfhi(x.x) * al); y.y = cvtpk(bflo(x.y) * al, bfhi(x.y) * al); y.z = cvtpk(bflo(x.z) * al, bfhi(x.z) * al); y.w = cvtpk(bflo(x.w) * al, bfhi(x.w) * al);
            *(v4u*)(((bf16*)(F.a->ws + WS_MIX)) + (size_t)row * MIXW + 1024 + 8 * c) = y; } }
}

constexpr int S1_BP = 272, S1_XP = 528, S1_B = 0, S1_X = 128 * S1_BP, S1_W = S1_X + 128 * S1_XP, S1_BYTES = S1_W + 8 * 128 * 4;
static_assert(S1_BYTES <= RING_BYTES, "ssd1 lds");
__device__ __forceinline__ void ssd1_ld(const bf16* XBC, size_t row0, int dj, bool ok, int ch0, float (&x)[8]) {
    v4u v = (v4u){0u, 0u, 0u, 0u}; if (ok) v = *(const v4u*)(XBC + (size_t)((long)row0 + dj) * XBCW + ch0);
    x[0] = bflo(v.x); x[1] = bfhi(v.x); x[2] = bflo(v.y); x[3] = bfhi(v.y); x[4] = bflo(v.z); x[5] = bfhi(v.z); x[6] = bflo(v.w); x[7] = bfhi(v.w);
}
__device__ __forceinline__ void ssd1_conv_item(Frame& F, int L, int b, int c, int ch0, int j0, int mode  , int lcol  , int hh  ) {
    const float* cw = F.a->in[I_CW] + (size_t)L * 4 * XBCW + ch0; const float* cb = F.a->in[I_CB] + (size_t)L * XBCW + ch0;
    float w[4][8], bias[8];
#pragma unroll
    for (int tp = 0; tp < 4; ++tp) { const f32x4 a = *(const f32x4*)(cw + tp * XBCW), bq = *(const f32x4*)(cw + tp * XBCW + 4);
        w[tp][0] = a[0]; w[tp][1] = a[1]; w[tp][2] = a[2]; w[tp][3] = a[3]; w[tp][4] = bq[0]; w[tp][5] = bq[1]; w[tp][6] = bq[2]; w[tp][7] = bq[3]; }
    { const f32x4 a = *(const f32x4*)cb, bq = *(const f32x4*)(cb + 4); bias[0] = a[0]; bias[1] = a[1]; bias[2] = a[2]; bias[3] = a[3]; bias[4] = bq[0]; bias[5] = bq[1]; bias[6] = bq[2]; bias[7] = bq[3]; }
    const size_t row0 = (size_t)b * SEQ + c * 128 + j0;
    float x3[8], x2[8], x1[8], x0[8];
    ssd1_ld(((bf16*)(F.a->ws + WS_XBC)), row0, -3, c > 0 || j0 - 3 >= 0, ch0, x3); ssd1_ld(((bf16*)(F.a->ws + WS_XBC)), row0, -2, c > 0 || j0 - 2 >= 0, ch0, x2); ssd1_ld(((bf16*)(F.a->ws + WS_XBC)), row0, -1, c > 0 || j0 - 1 >= 0, ch0, x1);
    LAS char* Bs = (LAS char*)(F.lds + RING_OFF + S1_B); LAS char* Xs = (LAS char*)(F.lds + RING_OFF + S1_X); const LAS float* Ws = (const LAS float*)(F.lds + RING_OFF + S1_W);
#pragma unroll 4
    for (int j = 0; j < 16; ++j) {
        ssd1_ld(((bf16*)(F.a->ws + WS_XBC)), row0, j, true, ch0, x0); float y[8];
#pragma unroll
        for (int e = 0; e < 8; ++e) y[e] = silu_f(bias[e] + w[0][e] * x3[e] + w[1][e] * x2[e] + w[2][e] * x1[e] + w[3][e] * x0[e]);
        v4u o; o.x = cvtpk(y[0], y[1]); o.y = cvtpk(y[2], y[3]); o.z = cvtpk(y[4], y[5]); o.w = cvtpk(y[6], y[7]);
        *(v4u*)(((bf16*)(F.a->ws + WS_XBCC)) + (row0 + j) * XBCW + ch0) = o;
        if (mode == 0) *(LAS v4u*)(Bs + (j0 + j) * S1_BP + lcol * 2) = o;
        else if (mode == 2) { const float wt = Ws[hh * 128 + j0 + j]; v4u q; q.x = cvtpk(y[0] * wt, y[1] * wt); q.y = cvtpk(y[2] * wt, y[3] * wt); q.z = cvtpk(y[4] * wt, y[5] * wt); q.w = cvtpk(y[6] * wt, y[7] * wt);
            *(LAS v4u*)(Xs + (j0 + j) * S1_XP + lcol * 2) = q; }
#pragma unroll
        for (int e = 0; e < 8; ++e) { x3[e] = x2[e]; x2[e] = x1[e]; x1[e] = x0[e]; }
    }
}
__device__ __forceinline__ void ssd1_unit(Frame& F, int L, int b, int c, int g) {
    const int tid = F.tid, lane = F.lane, w = F.wave, fr = lane & 15, fq = lane >> 4;
    LAS char* Bs = (LAS char*)(F.lds + RING_OFF + S1_B); LAS char* Xs = (LAS char*)(F.lds + RING_OFF + S1_X); LAS float* Ws = (LAS float*)(F.lds + RING_OFF + S1_W);
    const size_t row0 = (size_t)b * SEQ + c * 128;
    { const int h = 8 * g + w; const float a = -__expf(F.a->in[I_ALOG][L * 16 + h]);
        const float d0 = ((float*)(F.a->ws + WS_DT))[(row0 + 2 * lane) * 16 + h], d1 = ((float*)(F.a->ws + WS_DT))[(row0 + 2 * lane + 1) * 16 + h];
        const float x0 = d0 * a, x1 = d1 * a; float sc = x0 + x1;
#pragma unroll
        for (int o = 1; o < 64; o <<= 1) { const float t = __shfl_up(sc, o); if (lane >= o) sc += t; }
        const float ac1 = sc, ac0 = sc - x1, tot = __shfl(sc, 63);
        ((float*)(F.a->ws + WS_ACUM))[(row0 + 2 * lane) * 16 + h] = ac0; ((float*)(F.a->ws + WS_ACUM))[(row0 + 2 * lane + 1) * 16 + h] = ac1;
        Ws[w * 128 + 2 * lane] = d0 * __expf(tot - ac0); Ws[w * 128 + 2 * lane + 1] = d1 * __expf(tot - ac1);
        if (lane == 0) ((float*)(F.a->ws + WS_CDEC))[(b * NCH + c) * 16 + h] = __expf(tot); }
    __syncthreads();
#pragma unroll 1
    for (int pass = 0; pass < 2; ++pass) {
        if (pass == 0) { const int cg = tid & 63, tb = tid >> 6, lc = cg * 8;
            const int mode = lc < 128 ? 0 : (lc < 256 ? 1 : 2);
            const int ch0 = mode == 0 ? 1024 + 128 * g + lc : (mode == 1 ? 1280 + 128 * g + (lc - 128) : 512 * g + (lc - 256));
            ssd1_conv_item(F, L, b, c, ch0, tb * 16, mode, mode == 0 ? lc : (lc - 256) & 255, mode == 2 ? (lc - 256) >> 6 : 0);
        } else if (tid < 256) { const int cg = tid & 31, tb = tid >> 5, lc = cg * 8;
            ssd1_conv_item(F, L, b, c, 512 * g + 256 + lc, tb * 16, 2, lc, 4 + (lc >> 6)); }
        __syncthreads();
        { const int hh4 = w >> 1, nh = w & 1, h = 8 * g + 4 * pass + hh4;
            f32x4 acc[4][4];
#pragma unroll
            for (int pt = 0; pt < 4; ++pt)
#pragma unroll
                for (int nt = 0; nt < 4; ++nt) acc[pt][nt] = (f32x4){0.f, 0.f, 0.f, 0.f};
#pragma unroll
            for (int ks = 0; ks < 4; ++ks) { const int tok = 32 * ks + 8 * fq + ((lane & 15) >> 2);
                bf16x8 af[4], bfr[4];
#pragma unroll
                for (int nt = 0; nt < 4; ++nt) { const LAS char* p = Bs + tok * S1_BP + (64 * nh + 16 * nt + 4 * (lane & 3)) * 2; af[nt] = tr2(p, p + 4 * S1_BP); }
#pragma unroll
                for (int pt = 0; pt < 4; ++pt) { const LAS char* p = Xs + tok * S1_XP + (64 * hh4 + 16 * pt + 4 * (lane & 3)) * 2; bfr[pt] = tr2(p, p + 4 * S1_XP); }
#pragma unroll
                for (int pt = 0; pt < 4; ++pt)
#pragma unroll
                    for (int nt = 0; nt < 4; ++nt) acc[pt][nt] = mfma16(af[nt], bfr[pt], acc[pt][nt]); }
            float* sp = ((float*)(F.a->ws + WS_ST)) + ((size_t)(b * NCH + c) * 16 + h) * 8192;
#pragma unroll
            for (int pt = 0; pt < 4; ++pt)
#pragma unroll
                for (int nt = 0; nt < 4; ++nt) *(f32x4*)(sp + (16 * pt + fr) * 128 + 64 * nh + 16 * nt + 4 * fq) = acc[pt][nt]; }
        __syncthreads();
    }
}

__device__ __forceinline__ void ssd_scan_phase(Frame& F, int L) {
    const int nthr = F.G * NWAVES * 64;
    for (int idx = F.vcu * NWAVES * 64 + F.tid; idx < NBP * 16 * 2048; idx += nthr) {
        const int e4 = idx & 2047, bh = idx >> 11, b = bh >> 4, h = bh & 15;
        f32x4 hc = (f32x4){0.f, 0.f, 0.f, 0.f};
#pragma unroll 1
        for (int c0 = 0; c0 < NCH; c0 += 8) {
            f32x4 s[8]; float dc[8];
#pragma unroll
            for (int u = 0; u < 8; ++u) { const size_t o = ((size_t)(b * NCH + c0 + u) * 16 + h); s[u] = *(const f32x4*)(((float*)(F.a->ws + WS_ST)) + o * 8192 + 4 * e4); dc[u] = ((float*)(F.a->ws + WS_CDEC))[o]; }
#pragma unroll
            for (int u = 0; u < 8; ++u) { const size_t o = ((size_t)(b * NCH + c0 + u) * 16 + h);
                v2u t; t.x = cvtpk(hc[0], hc[1]); t.y = cvtpk(hc[2], hc[3]); *(v2u*)(((bf16*)(F.a->ws + WS_HPV)) + o * 8192 + 4 * e4) = t;
                hc = hc * dc[u] + s[u]; }
        }
        *(f32x4*)(F.a->out + O_SSMP + ((size_t)(L * NBP + b) * 16 + h) * 8192 + 4 * e4) = hc;
    }
}

constexpr int S3_P = 272, S3_C = 0, S3_B = 64 * S3_P, S3_CB = S3_B + 128 * S3_P, S3_X = S3_CB + 64 * S3_P, S3_AC = S3_X + 128 * S3_P, S3_DT = S3_AC + 4096, S3_BYTES = S3_DT + 4096;
static_assert(S3_BYTES <= RING_BYTES, "ssd3 lds");
__device__ __forceinline__ void ssd3_unit(Frame& F, int L, int b, int c, int half, int g) {
    const int tid = F.tid, lane = F.lane, w = F.wave, fr = lane & 15, fq = lane >> 4;
    LAS char* Cs = (LAS char*)(F.lds + RING_OFF + S3_C); LAS char* Bs = (LAS char*)(F.lds + RING_OFF + S3_B); LAS char* CBs = (LAS char*)(F.lds + RING_OFF + S3_CB); LAS char* Xs = (LAS char*)(F.lds + RING_OFF + S3_X);
    LAS float* acS = (LAS float*)(F.lds + RING_OFF + S3_AC); LAS float* dtS = (LAS float*)(F.lds + RING_OFF + S3_DT);
    const size_t row0 = (size_t)b * SEQ + c * 128; const int nj = 64 * (half + 1);
#pragma unroll
    for (int i = 0; i < 2; ++i) { const int q = tid + 512 * i, r = q >> 4, ch = q & 15;
        *(LAS v4u*)(Cs + r * S3_P + ch * 16) = *(const v4u*)(((bf16*)(F.a->ws + WS_XBCC)) + (row0 + 64 * half + r) * XBCW + 1280 + 128 * g + ch * 8); }
#pragma unroll
    for (int i = 0; i < 4; ++i) { const int q = tid + 512 * i, r = q >> 4, ch = q & 15;
        if (r < nj) *(LAS v4u*)(Bs + r * S3_P + ch * 16) = *(const v4u*)(((bf16*)(F.a->ws + WS_XBCC)) + (row0 + r) * XBCW + 1024 + 128 * g + ch * 8); }
#pragma unroll
    for (int i = 0; i < 2; ++i) { const int q = tid + 512 * i, r = q >> 3, hh = q & 7; acS[q] = ((float*)(F.a->ws + WS_ACUM))[(row0 + r) * 16 + 8 * g + hh]; dtS[q] = ((float*)(F.a->ws + WS_DT))[(row0 + r) * 16 + 8 * g + hh]; }
    __syncthreads();
    if (w < 4 * (half + 1)) {
#pragma unroll
        for (int it = 0; it < 4; ++it) { f32x4 a = (f32x4){0.f, 0.f, 0.f, 0.f};
#pragma unroll
            for (int ks = 0; ks < 4; ++ks) { const bf16x8 bf = *(const LAS bf16x8*)(Bs + (16 * w + fr) * S3_P + (32 * ks + 8 * fq) * 2), cf = *(const LAS bf16x8*)(Cs + (16 * it + fr) * S3_P + (32 * ks + 8 * fq) * 2);
                a = mfma16(bf, cf, a); }
            v2u t; t.x = cvtpk(a[0], a[1]); t.y = cvtpk(a[2], a[3]); *(LAS v2u*)(CBs + (16 * it + fr) * S3_P + (16 * w + 4 * fq) * 2) = t; }
    }
    __syncthreads();
#pragma unroll 1
    for (int hp = 0; hp < 4; ++hp) {
#pragma unroll
        for (int i = 0; i < 4; ++i) { const int q = tid + 512 * i, r = q >> 4, ch = q & 15;
            if (r < nj) *(LAS v4u*)(Xs + r * S3_P + ch * 16) = *(const v4u*)(((bf16*)(F.a->ws + WS_XBCC)) + (row0 + r) * XBCW + (8 * g + 2 * hp) * 64 + ch * 8); }
        __syncthreads();
        { const int hh2 = w >> 2, it = w & 3, hl = 2 * hp + hh2, h = 8 * g + hl, il = 64 * half + 16 * it + fr;
            const float ai = acS[il * 8 + hl];
            f32x4 y1[4], y2[4];
#pragma unroll
            for (int pt = 0; pt < 4; ++pt) { y1[pt] = (f32x4){0.f, 0.f, 0.f, 0.f}; y2[pt] = (f32x4){0.f, 0.f, 0.f, 0.f}; }
#pragma unroll
            for (int ks = 0; ks < 4; ++ks) if (ks < 2 * (half + 1)) {
                const v4u cbw = *(const LAS v4u*)(CBs + (16 * it + fr) * S3_P + (32 * ks + 8 * fq) * 2);
                float gv[8]; gv[0] = bflo(cbw.x); gv[1] = bfhi(cbw.x); gv[2] = bflo(cbw.y); gv[3] = bfhi(cbw.y); gv[4] = bflo(cbw.z); gv[5] = bfhi(cbw.z); gv[6] = bflo(cbw.w); gv[7] = bfhi(cbw.w);
#pragma unroll
                for (int e = 0; e < 8; ++e) { const int j = 32 * ks + 8 * fq + e; const float aj = acS[j * 8 + hl], dj = dtS[j * 8 + hl]; gv[e] = (j <= il) ? gv[e] * __expf(ai - aj) * dj : 0.f; }
                v4u gw; gw.x = cvtpk(gv[0], gv[1]); gw.y = cvtpk(gv[2], gv[3]); gw.z = cvtpk(gv[4], gv[5]); gw.w = cvtpk(gv[6], gv[7]);
                const bf16x8 gf = __builtin_bit_cast(bf16x8, gw);
                const int tok = 32 * ks + 8 * fq + ((lane & 15) >> 2);
#pragma unroll
                for (int pt = 0; pt < 4; ++pt) { const LAS char* p = Xs + tok * S3_P + (64 * hh2 + 16 * pt + 4 * (lane & 3)) * 2; y1[pt] = mfma16(tr2(p, p + 4 * S3_P), gf, y1[pt]); }
            }
            const bf16* hp_ = ((bf16*)(F.a->ws + WS_HPV)) + ((size_t)(b * NCH + c) * 16 + h) * 8192;
#pragma unroll
            for (int ks = 0; ks < 4; ++ks) { const bf16x8 cf = *(const LAS bf16x8*)(Cs + (16 * it + fr) * S3_P + (32 * ks + 8 * fq) * 2);
#pragma unroll
                for (int pt = 0; pt < 4; ++pt) { const bf16x8 hf = *(const bf16x8*)(hp_ + (16 * pt + fr) * 128 + 32 * ks + 8 * fq); y2[pt] = mfma16(hf, cf, y2[pt]); } }
#ifdef S3_NO_INTRA
#pragma unroll
            for (int pt = 0; pt < 4; ++pt) y1[pt] = (f32x4){0.f, 0.f, 0.f, 0.f};
#endif
#ifdef S3_NO_INTER
#pragma unroll
            for (int pt = 0; pt < 4; ++pt) y2[pt] = (f32x4){0.f, 0.f, 0.f, 0.f};
#endif
            const float ei = __expf(ai), dsk = F.a->in[I_DSKIP][L * 16 + h]; const size_t row = row0 + il; float ss = 0.f;
#pragma unroll
            for (int pt = 0; pt < 4; ++pt) { const int col = 16 * pt + 4 * fq;
                const v2u xw = *(const LAS v2u*)(Xs + il * S3_P + (64 * hh2 + col) * 2), zw = *(const v2u*)(((bf16*)(F.a->ws + WS_SZ)) + row * DM + h * 64 + col);
                const float x0 = bflo(xw.x), x1 = bfhi(xw.x), x2 = bflo(xw.y), x3 = bfhi(xw.y);
                const float v0 = (y1[pt][0] + ei * y2[pt][0] + dsk * x0) * bflo(zw.x), v1 = (y1[pt][1] + ei * y2[pt][1] + dsk * x1) * bfhi(zw.x),
                            v2 = (y1[pt][2] + ei * y2[pt][2] + dsk * x2) * bflo(zw.y), v3 = (y1[pt][3] + ei * y2[pt][3] + dsk * x3) * bfhi(zw.y);
                ss += (v0 * v0 + v1 * v1) + (v2 * v2 + v3 * v3);
                v2u o; o.x = cvtpk(v0, v1); o.y = cvtpk(v2, v3); *(v2u*)(((bf16*)(F.a->ws + WS_MIX)) + row * MIXW + h * 64 + col) = o; }
            ss += __shfl_xor(ss, 16); ss += __shfl_xor(ss, 32);
            if (fq == 0) ((float*)(F.a->ws + WS_SSQP))[row * 16 + h] = ss; }
        __syncthreads();
    }
}

__device__ __forceinline__ void ssd_sample_task(Frame& F, int L, int b, int h) {
    const int lane = F.lane, g = h >> 3;
    LAS float* scr = (LAS float*)(F.lds + RING_OFF + F.wave * 8192);
    LAS float* xsS = scr; LAS float* BS = scr + 256; LAS float* CS = scr + 768; LAS float* yI = scr + 1280;
    const size_t row0 = (size_t)MP + b * TS;
#pragma unroll
    for (int q = 0; q < 5; ++q) {
        const int ch = q == 0 ? h * 64 + lane : (q < 3 ? 1024 + 128 * g + lane + 64 * (q - 1) : 1280 + 128 * g + lane + 64 * (q - 3));
        const float* sc = F.a->in[I_CONV] + ((size_t)(L * NBS + b) * 3) * XBCW + ch;
        float x[7]; x[0] = sc[0]; x[1] = sc[XBCW]; x[2] = sc[2 * XBCW];
#pragma unroll
        for (int t = 0; t < 4; ++t) x[3 + t] = bf2f(((bf16*)(F.a->ws + WS_XBC))[(row0 + t) * XBCW + ch]);
        const float* cw = F.a->in[I_CW] + (size_t)L * 4 * XBCW + ch; const float w0 = cw[0], w1 = cw[XBCW], w2 = cw[2 * XBCW], w3 = cw[3 * XBCW], bb = F.a->in[I_CB][L * XBCW + ch];
#pragma unroll
        for (int t = 0; t < 4; ++t) { const float y = silu_f(bb + w0 * x[t] + w1 * x[t + 1] + w2 * x[t + 2] + w3 * x[t + 3]);
            if (q == 0) xsS[t * 64 + lane] = y; else if (q < 3) BS[t * 128 + lane + 64 * (q - 1)] = y; else CS[t * 128 + lane + 64 * (q - 3)] = y; }
    }
    const float a = -__expf(F.a->in[I_ALOG][L * 16 + h]);
    float dt[4], ac[4];
#pragma unroll
    for (int t = 0; t < 4; ++t) { dt[t] = ((float*)(F.a->ws + WS_DT))[(row0 + t) * 16 + h]; ac[t] = dt[t] * a + (t ? ac[t - 1] : 0.f); }
    LDS_WAIT(); asm volatile("" ::: "memory");
    float cb[4][4];
#pragma unroll
    for (int i = 0; i < 4; ++i)
#pragma unroll
        for (int j = 0; j < 4; ++j) cb[i][j] = 0.f;
#pragma unroll
    for (int i = 0; i < 4; ++i)
#pragma unroll
        for (int j = 0; j <= i; ++j) cb[i][j] = wave_sum(CS[i * 128 + lane] * BS[j * 128 + lane] + CS[i * 128 + lane + 64] * BS[j * 128 + lane + 64]);
    const int plo = lane >> 4, nc = lane & 15;
    float Cv[4][8], Bv[4][8];
#pragma unroll
    for (int t = 0; t < 4; ++t)
#pragma unroll
        for (int e = 0; e < 8; ++e) { Cv[t][e] = CS[t * 128 + 8 * nc + e]; Bv[t][e] = BS[t * 128 + 8 * nc + e]; }
    const float dec = __expf(ac[3]); float wj[4];
#pragma unroll
    for (int j = 0; j < 4; ++j) wj[j] = dt[j] * __expf(ac[3] - ac[j]);
    const float* h0 = F.a->in[I_SSM] + ((size_t)(L * NBS + b) * 16 + h) * 8192; float* hout = F.a->out + O_SSMS + ((size_t)(L * NBS + b) * 16 + h) * 8192;
#pragma unroll 4
    for (int k = 0; k < 16; ++k) { const int p = plo + 4 * k;
        const f32x4 ha = __builtin_nontemporal_load((const f32x4*)(h0 + p * 128 + 8 * nc)), hb = __builtin_nontemporal_load((const f32x4*)(h0 + p * 128 + 8 * nc + 4));
        float hv[8] = {ha[0], ha[1], ha[2], ha[3], hb[0], hb[1], hb[2], hb[3]};
        float it_[4];
#pragma unroll
        for (int t = 0; t < 4; ++t) { float s = 0.f;
#pragma unroll
            for (int e = 0; e < 8; ++e) s += Cv[t][e] * hv[e];
            s += __shfl_xor(s, 1); s += __shfl_xor(s, 2); s += __shfl_xor(s, 4); s += __shfl_xor(s, 8); it_[t] = s; }
        float cj[4];
#pragma unroll
        for (int j = 0; j < 4; ++j) cj[j] = wj[j] * xsS[j * 64 + p];
#pragma unroll
        for (int e = 0; e < 8; ++e) hv[e] = hv[e] * dec + ((cj[0] * Bv[0][e] + cj[1] * Bv[1][e]) + (cj[2] * Bv[2][e] + cj[3] * Bv[3][e]));
        __builtin_nontemporal_store((f32x4){hv[0], hv[1], hv[2], hv[3]}, (f32x4*)(hout + p * 128 + 8 * nc)); __builtin_nontemporal_store((f32x4){hv[4], hv[5], hv[6], hv[7]}, (f32x4*)(hout + p * 128 + 8 * nc + 4));
        if (nc == 0) {
#pragma unroll
            for (int t = 0; t < 4; ++t) yI[t * 64 + p] = it_[t]; }
    }
    LDS_WAIT(); asm volatile("" ::: "memory");
    const float dsk = F.a->in[I_DSKIP][L * 16 + h];
#pragma unroll
    for (int i = 0; i < 4; ++i) { float y = __expf(ac[i]) * yI[i * 64 + lane] + dsk * xsS[i * 64 + lane];
#pragma unroll
        for (int j = 0; j <= i; ++j) y += cb[i][j] * __expf(ac[i] - ac[j]) * dt[j] * xsS[j * 64 + lane];
        y *= bf2f(((bf16*)(F.a->ws + WS_SZ))[(row0 + i) * DM + h * 64 + lane]);
        ((bf16*)(F.a->ws + WS_MIX))[(row0 + i) * MIXW + h * 64 + lane] = (bf16)f2bf(y);
        const float ss = wave_sum(y * y);
        if (lane == 0) ((float*)(F.a->ws + WS_SSQP))[(row0 + i) * 16 + h] = ss; }
    LDS_WAIT(); asm volatile("" ::: "memory");
}

__device__ __forceinline__ void convgate_item(Frame& F, int L, const bf16* urow0  , int ntok, bool has_prev_rows  , const float* prev  , int ch0, bf16* grow0) {
    const int pn = ch0 >> 7, ucol = 256 * pn + (ch0 & 127);
    const float* fw = F.a->in[I_FCW] + (size_t)L * 3 * FF2; const float* fb = F.a->in[I_FCB] + (size_t)L * FF2;
    float wg[3][8], wu[3][8], bg[8], bu[8];
#pragma unroll
    for (int tp = 0; tp < 3; ++tp) { const f32x4 a = *(const f32x4*)(fw + tp * FF2 + ch0), b = *(const f32x4*)(fw + tp * FF2 + ch0 + 4), c = *(const f32x4*)(fw + tp * FF2 + FF + ch0), d = *(const f32x4*)(fw + tp * FF2 + FF + ch0 + 4);
        wg[tp][0] = a[0]; wg[tp][1] = a[1]; wg[tp][2] = a[2]; wg[tp][3] = a[3]; wg[tp][4] = b[0]; wg[tp][5] = b[1]; wg[tp][6] = b[2]; wg[tp][7] = b[3];
        wu[tp][0] = c[0]; wu[tp][1] = c[1]; wu[tp][2] = c[2]; wu[tp][3] = c[3]; wu[tp][4] = d[0]; wu[tp][5] = d[1]; wu[tp][6] = d[2]; wu[tp][7] = d[3]; }
    { const f32x4 a = *(const f32x4*)(fb + ch0), b = *(const f32x4*)(fb + ch0 + 4), c = *(const f32x4*)(fb + FF + ch0), d = *(const f32x4*)(fb + FF + ch0 + 4);
        bg[0] = a[0]; bg[1] = a[1]; bg[2] = a[2]; bg[3] = a[3]; bg[4] = b[0]; bg[5] = b[1]; bg[6] = b[2]; bg[7] = b[3]; bu[0] = c[0]; bu[1] = c[1]; bu[2] = c[2]; bu[3] = c[3]; bu[4] = d[0]; bu[5] = d[1]; bu[6] = d[2]; bu[7] = d[3]; }
    float g2[8], g1[8], g0[8], u2[8], u1[8], u0[8];
#pragma unroll
    for (int e = 0; e < 8; ++e) { g2[e] = 0.f; g1[e] = 0.f; u2[e] = 0.f; u1[e] = 0.f; }
    if (has_prev_rows) {
        const v4u a = *(const v4u*)(urow0 - 2 * FF2 + ucol), b = *(const v4u*)(urow0 - FF2 + ucol), c = *(const v4u*)(urow0 - 2 * FF2 + ucol + 128), d = *(const v4u*)(urow0 - FF2 + ucol + 128);
        g2[0] = bflo(a.x); g2[1] = bfhi(a.x); g2[2] = bflo(a.y); g2[3] = bfhi(a.y); g2[4] = bflo(a.z); g2[5] = bfhi(a.z); g2[6] = bflo(a.w); g2[7] = bfhi(a.w);
        g1[0] = bflo(b.x); g1[1] = bfhi(b.x); g1[2] = bflo(b.y); g1[3] = bfhi(b.y); g1[4] = bflo(b.z); g1[5] = bfhi(b.z); g1[6] = bflo(b.w); g1[7] = bfhi(b.w);
        u2[0] = bflo(c.x); u2[1] = bfhi(c.x); u2[2] = bflo(c.y); u2[3] = bfhi(c.y); u2[4] = bflo(c.z); u2[5] = bfhi(c.z); u2[6] = bflo(c.w); u2[7] = bfhi(c.w);
        u1[0] = bflo(d.x); u1[1] = bfhi(d.x); u1[2] = bflo(d.y); u1[3] = bfhi(d.y); u1[4] = bflo(d.z); u1[5] = bfhi(d.z); u1[6] = bflo(d.w); u1[7] = bfhi(d.w);
    } else if (prev) {
#pragma unroll
        for (int e = 0; e < 8; ++e) { g2[e] = prev[ch0 + e]; g1[e] = prev[FF2 + ch0 + e]; u2[e] = prev[FF + ch0 + e]; u1[e] = prev[FF2 + FF + ch0 + e]; }
    }
#pragma unroll 4
    for (int t = 0; t < ntok; ++t) {
        const v4u a = *(const v4u*)(urow0 + (size_t)t * FF2 + ucol), c = *(const v4u*)(urow0 + (size_t)t * FF2 + ucol + 128);
        g0[0] = bflo(a.x); g0[1] = bfhi(a.x); g0[2] = bflo(a.y); g0[3] = bfhi(a.y); g0[4] = bflo(a.z); g0[5] = bfhi(a.z); g0[6] = bflo(a.w); g0[7] = bfhi(a.w);
        u0[0] = bflo(c.x); u0[1] = bfhi(c.x); u0[2] = bflo(c.y); u0[3] = bfhi(c.y); u0[4] = bflo(c.z); u0[5] = bfhi(c.z); u0[6] = bflo(c.w); u0[7] = bfhi(c.w);
        float r[8];
#pragma unroll
        for (int e = 0; e < 8; ++e) { const float gt = bg[e] + wg[0][e] * g2[e] + wg[1][e] * g1[e] + wg[2][e] * g0[e], up = bu[e] + wu[0][e] * u2[e] + wu[1][e] * u1[e] + wu[2][e] * u0[e];
            r[e] = silu_f(gt) * up; g2[e] = g1[e]; g1[e] = g0[e]; u2[e] = u1[e]; u1[e] = u0[e]; }
        v4u o; o.x = cvtpk(r[0], r[1]); o.y = cvtpk(r[2], r[3]); o.z = cvtpk(r[4], r[5]); o.w = cvtpk(r[6], r[7]);
        *(v4u*)(grow0 + (size_t)t * FF + ch0) = o;
    }
}
__device__ __forceinline__ void convgate_phase(Frame& F, int L) {
    const int nthr = F.G * NWAVES * 64, gt = F.vcu * NWAVES * 64 + F.tid;
    constexpr int NCG = FF / 8, NP = (MP / 16) * NCG, NS = NBS * NCG;
    for (int it = gt; it < NP + NS; it += nthr) {
        if (it < NP) { const int cg = it % NCG, rb = it / NCG; const size_t row = (size_t)rb * 16;
            convgate_item(F, L, ((bf16*)(F.a->ws + WS_U)) + row * FF2, 16, (row & 4095) != 0, nullptr, cg * 8, ((bf16*)(F.a->ws + WS_G)) + row * FF);
        } else { const int q = it - NP, cg = q % NCG, b = q / NCG; const size_t row = (size_t)MP + b * TS;
            convgate_item(F, L, ((bf16*)(F.a->ws + WS_U)) + row * FF2, 4, false, F.a->in[I_FFNC] + (size_t)(L * NBS + b) * 2 * FF2, cg * 8, ((bf16*)(F.a->ws + WS_G)) + row * FF); }
    }
}

#ifndef PH_MASK
#define PH_MASK 0xFFFFu
#endif
#ifndef SUB_MASK
#define SUB_MASK 0xFu
#endif
#define SUBK(k) (((SUB_MASK) >> (k)) & 1u)
#define PHK(k) (((PH_MASK) >> (k)) & 1u)
constexpr int N_PHASES = 21;
#if MK_ONE_LAUNCH
#define GRID_BAR() xcd_barrier(bar)
#else
#define GRID_BAR() do { if (F.tid == 0) __hip_atomic_store(F.ctl + CW_TMO, 0xBADBA0u, RLX_AGENT); } while (0)
#endif
#define IN(k) (lo <= (k) && (k) < hi)
#define SEAM(k) do { if (IN(k) && IN((k) + 1)) GRID_BAR(); } while (0)
#define gw (F.vcu * NWAVES + F.wave)
template <int L> __device__ __forceinline__ void layer_body(Frame& F, const XcdBarrier& bar, const int lo, const int hi) {
    const int NGW = F.G * NWAVES;
        const int pb = 1 + 10 * L;
#define RELAUNDER() do { int l_ = (int)__builtin_amdgcn_mbcnt_hi(~0u, __builtin_amdgcn_mbcnt_lo(~0u, 0u)); asm volatile("" : "+v"(l_)); F.lane = l_; F.tid = F.wave * 64 + l_; } while (0)
        const float* xP = L == 0 ? F.a->in[I_XP] : ((float*)(F.a->ws + WS_X2)); const float* xS = L == 0 ? F.a->in[I_XS] : ((float*)(F.a->ws + WS_X2)) + (size_t)MP * DM;
        float* xout = L == 0 ? +((float*)(F.a->ws + WS_X2)) : +F.a->out;
        RELAUNDER();
        if (PHK(1) && IN(pb + 0)) { norm_phase<true>(F, L, xP, xS, F.a->in[I_NMIX] + L * DM); SEAM(pb + 0); }
        RELAUNDER();
        if (PHK(2) && IN(pb + 1)) {
            pg8::Gemm g{((bf16*)(F.a->ws + WS_XN)), ((bf16*)(F.a->ws + WS_WIN)) + (size_t)L * NIN * DM, MT, NIN, DM}; pg8::StaticOrder S; S.init(MT, NIN, F.G, (int)blockIdx.x);
            EpiInProj E{((bf16*)(F.a->ws + WS_QB)), ((bf16*)(F.a->ws + WS_KB)), ((bf16*)(F.a->ws + WS_VB)), ((bf16*)(F.a->ws + WS_SZ)), ((bf16*)(F.a->ws + WS_XBC)), F.a->in[I_QN] + L * 64, F.a->in[I_KN] + L * 64, F.a->out, L};
            pg8::gemm_phase<EpiInProj, pg8::StaticOrder, true, true>(F.lds + RING_OFF, g, S, E, F.tid);
            SEAM(pb + 1);
        }
        RELAUNDER();
        if (PHK(3) && IN(pb + 2)) {
            if (SUBK(0)) for (int u = F.vcu; u < 256; u += F.G) ssd1_unit(F, L, u >> 6, (u >> 1) & 31, u & 1);
            RELAUNDER();
            if (SUBK(1)) for (int v = (F.vcu + F.G - 256 % F.G) % F.G; v < 1536; v += F.G) attn_prompt_unit(F, v / 384, (v / 32) % 12, v & 31);
            RELAUNDER();
            if (SUBK(2)) for (int t = gw; t < 2048; t += NGW) ssd_sample_task(F, L, t >> 4, t & 15);
            RELAUNDER();
            if (SUBK(3)) for (int v = gw; v < 1536; v += NGW) attn_sample_task(F, L, v / 12, (v >> 2) % 3, v & 3);
            SEAM(pb + 2);
        }
        RELAUNDER();
        if (PHK(4) && IN(pb + 3)) { ssd_scan_phase(F, L); SEAM(pb + 3); }
        RELAUNDER();
        if (PHK(5) && IN(pb + 4)) {
            for (int u = F.vcu; u < 512; u += F.G) ssd3_unit(F, L, u >> 7, (u >> 2) & 31, (u >> 1) & 1, u & 1);
            for (int row = gw; row < MT; row += NGW) alpha_row(F, row);
            SEAM(pb + 4);
        }
        RELAUNDER();
        if (PHK(6) && IN(pb + 5)) {
            pg8::Gemm g{((bf16*)(F.a->ws + WS_MIX)), ((bf16*)(F.a->ws + WS_WOUT)) + (size_t)L * DM * MIXW, MT, DM, MIXW}; pg8::StaticOrder S; S.init(MT, DM, F.G, (int)blockIdx.x);
            EpiResid<16> E{xP, xS, ((float*)(F.a->ws + WS_X1)), ((float*)(F.a->ws + WS_SSQP))};
            pg8::gemm_phase<EpiResid<16>, pg8::StaticOrder, true, true>(F.lds + RING_OFF, g, S, E, F.tid);
            SEAM(pb + 5);
        }
        RELAUNDER();
        if (PHK(7) && IN(pb + 6)) { norm_phase<false>(F, L, ((float*)(F.a->ws + WS_X1)), ((float*)(F.a->ws + WS_X1)) + (size_t)MP * DM, F.a->in[I_NFFN] + L * DM); SEAM(pb + 6); }
        RELAUNDER();
        if (PHK(8) && IN(pb + 7)) {
            pg8::Gemm g{((bf16*)(F.a->ws + WS_XN)), ((bf16*)(F.a->ws + WS_WUP)) + (size_t)L * FF2 * DM, MT, FF2, DM}; pg8::StaticOrder S; S.init(MT, FF2, F.G, (int)blockIdx.x);
            EpiUp E{((bf16*)(F.a->ws + WS_U)), F.a->out, L};
            pg8::gemm_phase<EpiUp, pg8::StaticOrder, true, true>(F.lds + RING_OFF, g, S, E, F.tid);
            SEAM(pb + 7);
        }
        RELAUNDER();
        if (PHK(9) && IN(pb + 8)) { convgate_phase(F, L); SEAM(pb + 8); }
        RELAUNDER();
        if (PHK(10) && IN(pb + 9)) {
            pg8::Gemm g{((bf16*)(F.a->ws + WS_G)), ((bf16*)(F.a->ws + WS_WDN)) + (size_t)L * DM * FF, MT, DM, FF}; pg8::StaticOrder S; S.init(MT, DM, F.G, (int)blockIdx.x);
            EpiResid<-1> E{((float*)(F.a->ws + WS_X1)), ((float*)(F.a->ws + WS_X1)) + (size_t)MP * DM, xout, nullptr};
            pg8::gemm_phase<EpiResid<-1>, pg8::StaticOrder, true, true>(F.lds + RING_OFF, g, S, E, F.tid);
            SEAM(pb + 9);
        }
}
__global__ void __launch_bounds__(NWAVES * 64, 2) mk_fwd(Args args) {
    extern __shared__ __attribute__((aligned(16))) unsigned char lds[];
    Frame F;
    F.lds = (LAS unsigned char*)lds;
    F.MISC = (volatile LAS unsigned*)(F.lds + MISC_OFF);
    F.tid = threadIdx.x; F.lane = F.tid & 63; F.wave = __builtin_amdgcn_readfirstlane(F.tid >> 6);
    F.G = gridDim.x; { const int bx = blockIdx.x; F.vcu = (F.G % 8 == 0) ? (bx % 8) * (F.G / 8) + bx / 8 : bx; }
    F.ctl = (gu32*)(args.ws + WS_CTL);
    F.a = &args;
    for (int u = F.tid; u < (LDS_BYTES - LDSCTL_OFF) / 4; u += NWAVES * 64) ((LAS unsigned*)(F.lds + LDSCTL_OFF))[u] = 0u;
    __syncthreads();
    XcdBarrier bar; bar.bar = (unsigned*)(F.ctl + CW_BAR); bar.x = 0; bar.st = nullptr;
#if MK_ONE_LAUNCH
    bar = xcd_barrier_post((unsigned*)(F.ctl + CW_BAR), F.MISC + 8);
#else
#endif
    const int lo = args.ph_lo, hi = args.ph_hi;

    if (PHK(0) && IN(0)) { p0_prologue(F); SEAM(0); }

    layer_body<0>(F, bar, lo, hi);
    layer_body<1>(F, bar, lo, hi);
#ifdef DEBUG_DUMP
    if (lo == 99) {
        float* o = F.a->out;
        const size_t nthr = (size_t)F.G * NWAVES * 64, gt = (size_t)F.vcu * NWAVES * 64 + F.tid;
        for (size_t i = gt; i < (size_t)MP * 1024; i += nthr) o[i] = DUMP_A;
        for (size_t i = gt; i < (size_t)MS * 1024; i += nthr) o[(size_t)MP * 1024 + i] = DUMP_B;
    }
#endif
#undef IN
#undef SEAM
#undef gw
#undef RELAUNDER
}

extern "C" void kernel_launch(void* const* d_in, const int* in_sizes, int n_in, void* d_out, int out_size, void* d_ws, size_t ws_size, hipStream_t stream) {
    static int grid = 0;
    if (grid == 0) {
        if (n_in != 24 || (size_t)out_size != O_END || ws_size < WS_END) { fprintf(stderr, "kernel_launch: unexpected shapes: n_in %d out %d ws %zu (need %zu)\n", n_in, out_size, ws_size, (size_t)WS_END); grid = -1; return; }
        int dev = 0, cus = 0, per_cu = 0;
        if (hipGetDevice(&dev) != hipSuccess || hipDeviceGetAttribute(&cus, hipDeviceAttributeMultiprocessorCount, dev) != hipSuccess) { grid = -1; return; }
        if (hipFuncSetAttribute((const void*)mk_fwd, hipFuncAttributeMaxDynamicSharedMemorySize, LDS_BYTES) != hipSuccess) { fprintf(stderr, "kernel_launch: hipFuncSetAttribute failed\n"); grid = -1; return; }
        if (hipOccupancyMaxActiveBlocksPerMultiprocessor(&per_cu, (const void*)mk_fwd, NWAVES * 64, LDS_BYTES) != hipSuccess || per_cu < 1) { fprintf(stderr, "kernel_launch: occupancy query says %d\n", per_cu); }
        (void)hipGetLastError();
        grid = cus;
    }
    if (grid < 0) return;
    if (hipMemsetAsync((char*)d_ws + WS_CTL, 0, CTL_ZERO_BYTES, stream) != hipSuccess) return;
    Args a{};
    for (int i = 0; i < 24; ++i) a.in[i] = (const float*)d_in[i];
    a.out = (float*)d_out; a.ws = (unsigned char*)d_ws;
#if MK_ONE_LAUNCH
    a.ph_lo = 0; a.ph_hi = N_PHASES;
    hipLaunchKernelGGL(mk_fwd, dim3(grid), dim3(NWAVES * 64), LDS_BYTES, stream, a);
#else
#ifndef LASTPH
#define LASTPH N_PHASES
#endif
    for (int p = 0; p < LASTPH; ++p) { a.ph_lo = p; a.ph_hi = p + 1; hipLaunchKernelGGL(mk_fwd, dim3(grid), dim3(NWAVES * 64), LDS_BYTES, stream, a); }
#ifdef DEBUG_DUMP
    a.ph_lo = 99; a.ph_hi = 100; hipLaunchKernelGGL(mk_fwd, dim3(grid), dim3(NWAVES * 64), LDS_BYTES, stream, a);
#endif
#endif
}
```

```cpp
#include <hip/hip_runtime.h>
#include <cstdio>
#include <cstdint>

#ifndef MK_ONE_LAUNCH
#define MK_ONE_LAUNCH 1
#endif

namespace pg8 {
#define PG8_LAS __attribute__((address_space(3)))
typedef unsigned short bf16_t;
typedef short bf16x8 __attribute__((ext_vector_type(8)));
typedef float f32x4 __attribute__((ext_vector_type(4)));
typedef unsigned u32x4 __attribute__((ext_vector_type(4)));
constexpr int BM = 256, BK = 64, HALF = 128, HTB = HALF * BK * 2  , STAGE_BYTES = 8 * HTB, NXCD = 8, WGM = 4;

__host__ __device__ __forceinline__ int lds_byte(int r, int c) { const int st = (r >> 4) * 2 + (c >> 5), rr = r & 15, cc = c & 31, ob = rr * 64 + cc * 2; return st * 1024 + (ob ^ (((ob >> 9) & 1) << 5)); }
__host__ __device__ __forceinline__ void stage_rc(int b, int& R, int& C) { const int st = b / 1024, sb = b % 1024, swz = sb ^ (((sb >> 9) & 1) << 5); R = (st >> 1) * 16 + swz / 64; C = (st & 1) * 32 + (swz % 64) / 2; }
__host__ __device__ __forceinline__ int perm32(int rho) { const int n = rho >> 4, i = rho & 15; return 8 * (i >> 2) + 4 * n + (i & 3); }

struct Unit { int pm, pn, idx, arow; };
struct Gemm { const bf16_t* A; const bf16_t* Bt; int M, N, K; };

struct StaticOrder {
    int nM, nN, nwg, G, c;
    __host__ __device__ void init(int M, int N, int G_, int c_) { nM = M / BM; nN = N / BM; nwg = nM * nN; G = G_; c = c_; }
    __host__ __device__ bool next(int i, Unit& u) const {
        const long L = (long)i * G + c; if (L >= nwg) return false;
        int wgid = (int)L; { const int q = nwg / NXCD, r = nwg % NXCD, xcd = wgid % NXCD, off = wgid / NXCD; wgid = (xcd < r ? xcd * (q + 1) : r * (q + 1) + (xcd - r) * q) + off; }
        const int nig = WGM * nN, gid = wgid / nig, fm = gid * WGM, gsz = (nM - fm) < WGM ? (nM - fm) : WGM;
        u.pm = fm + ((wgid % nig) % gsz); u.pn = (wgid % nig) / gsz; u.idx = i; u.arow = 256 * u.pm; return true;
    }
    __device__ __forceinline__ void a_ready(const Unit&) const {}
    __device__ __forceinline__ void done(const Unit&) const {}
};
typedef float f32x2_t __attribute__((ext_vector_type(2))); typedef __bf16 bf16x2_t __attribute__((ext_vector_type(2)));
__device__ __forceinline__ unsigned cvt_pk_bf16(float lo, float hi) { f32x2_t v = {lo, hi}; bf16x2_t b = __builtin_convertvector(v, bf16x2_t); return __builtin_bit_cast(unsigned, b); }

template <class Epi, class Sched, bool ALIGN_EPI = false, bool SP2 = false>
__device__ __forceinline__ void gemm_phase(PG8_LAS unsigned char* lds, const Gemm g, const Sched& S, const Epi& E, const int tid) {
    const int wid = __builtin_amdgcn_readfirstlane(tid >> 6), lane = tid & 63, wr = wid >> 2, wc = wid & 3, fr = lane & 15, fq = lane >> 4;
    const int K = g.K, nt = K / BK;
    unsigned voffA[2], voffB[2];
#pragma unroll
    for (int i = 0; i < 2; ++i) { int R, C; stage_rc(tid * 16 + i * 8192, R, C); const int Rb = Epi::PERM ? ((R & ~31) + perm32(R & 31)) : R;
        voffA[i] = (unsigned)(R * K + C) * 2u; voffB[i] = (unsigned)(Rb * K + C) * 2u; }
    const size_t kstep = (size_t)(BK * 2);
    const size_t hstep = (size_t)HALF * K * 2;
    const size_t tstep = 2 * hstep;
    const unsigned ldsw = (unsigned)wid * 1024u;
    const int aoff = lds_byte(wr * 64 + fr, fq * 8), boff = lds_byte(wc * 32 + fr, fq * 8);
#define PG8_SA(b, h) (((b) * 2 + (h)) * HTB)
#define PG8_SB(b, h) ((4 + (b) * 2 + (h)) * HTB)
#define PG8_STAGE(bufoff, gbase, voff) do { _Pragma("unroll") for (int _i = 0; _i < 2; ++_i) \
        __builtin_amdgcn_global_load_lds((const unsigned*)((const char*)(gbase) + (voff)[_i]), (PG8_LAS unsigned*)(lds + (bufoff) + ldsw + _i * 8192), 16, 0, 0); } while (0)
#define PG8_LDA(dst, b, h) do { _Pragma("unroll") for (int m = 0; m < 4; ++m) _Pragma("unroll") for (int k = 0; k < 2; ++k) dst[m][k] = *(const PG8_LAS bf16x8*)(lds + PG8_SA(b, h) + aoff + m * 2048 + k * 1024); } while (0)
#define PG8_LDB(dst, b, h) do { _Pragma("unroll") for (int n = 0; n < 2; ++n) _Pragma("unroll") for (int k = 0; k < 2; ++k) dst[n][k] = *(const PG8_LAS bf16x8*)(lds + PG8_SB(b, h) + boff + n * 2048 + k * 1024); } while (0)
#define PG8_MMA(ai, bj, At, Bt) do { __builtin_amdgcn_s_setprio(1); _Pragma("unroll") for (int m = 0; m < 4; ++m) _Pragma("unroll") for (int n = 0; n < 2; ++n) _Pragma("unroll") for (int k = 0; k < 2; ++k) \
        acc[ai][bj][m][n] = __builtin_amdgcn_mfma_f32_16x16x32_bf16(Bt[n][k], At[m][k], acc[ai][bj][m][n], 0, 0, 0); __builtin_amdgcn_s_setprio(0); } while (0)
#define PG8_KS(ai, k) do { if constexpr (Epi::KSCALE) E.kscale(acc, cur, (ai), (k), wr, wc, fr, fq); } while (0)
#define PG8_WAIT_V(n) asm volatile("s_waitcnt vmcnt(" #n ")" ::: "memory")
#define PG8_WAIT_L(n) asm volatile("s_waitcnt lgkmcnt(" #n ")" ::: "memory")
#define PG8_BAR __builtin_amdgcn_s_barrier()
#define PG8_SCHED __builtin_amdgcn_sched_barrier(0)
    Unit cur, nxt; int ui = 0;
    if (!S.next(0, cur)) return;
    f32x4 acc[2][2][4][2];
    if constexpr (Epi::INIT_ACC) E.init(acc, cur, wr, wc, fr, fq); else {
#pragma unroll
    for (int a = 0; a < 2; ++a)
#pragma unroll
        for (int b = 0; b < 2; ++b)
#pragma unroll
            for (int m = 0; m < 4; ++m)
#pragma unroll
                for (int n = 0; n < 2; ++n) acc[a][b][m][n] = (f32x4){0.f, 0.f, 0.f, 0.f}; }
    bf16x8 At[4][2], B0[2][2], B1[2][2];
    const char* cA = (const char*)g.A + (ptrdiff_t)cur.arow * (ptrdiff_t)(K * 2); const char* cB = (const char*)g.Bt + (size_t)cur.pn * tstep;
    S.a_ready(cur);
    if constexpr (SP2) {
        PG8_STAGE(PG8_SB(0, 0), cB, voffB); PG8_STAGE(PG8_SB(0, 1), cB + hstep, voffB); PG8_STAGE(PG8_SA(0, 0), cA, voffA); PG8_STAGE(PG8_SA(0, 1), cA + hstep, voffA);
        if (wr == 1) PG8_BAR;
        PG8_WAIT_V(2); PG8_BAR;
        PG8_STAGE(PG8_SB(1, 0), cB + kstep, voffB); PG8_STAGE(PG8_SA(1, 0), cA + kstep, voffA); PG8_STAGE(PG8_SB(1, 1), cB + hstep + kstep, voffB);
        PG8_WAIT_V(6); PG8_BAR;
    } else {
        PG8_STAGE(PG8_SB(0, 0), cB, voffB); PG8_STAGE(PG8_SA(0, 0), cA, voffA); PG8_STAGE(PG8_SB(0, 1), cB + hstep, voffB); PG8_STAGE(PG8_SA(0, 1), cA + hstep, voffA);
        if (wr == 1) PG8_BAR;
        PG8_WAIT_V(4); PG8_BAR;
        PG8_STAGE(PG8_SB(1, 0), cB + kstep, voffB); PG8_STAGE(PG8_SA(1, 0), cA + kstep, voffA); PG8_STAGE(PG8_SB(1, 1), cB + hstep + kstep, voffB);
        PG8_WAIT_V(6); PG8_BAR;
    }
    for (;;) {
        const bool has_next = S.next(ui + 1, nxt);
        const char* nA = has_next ? (const char*)g.A + (ptrdiff_t)nxt.arow * (ptrdiff_t)(K * 2) : cA; const char* nB = has_next ? (const char*)g.Bt + (size_t)nxt.pn * tstep : cB;
        for (int t = 0; t < nt; t += 2) {
            const bool last = (t == nt - 2);
            if constexpr (Epi::HOOK_T >= 0) { if (t == Epi::HOOK_T) E.hook(acc, cur, wr, wc, fr, fq); }
            const char* a1 = cA + (size_t)(t + 1) * kstep;
            const char* a2 = last ? nA : cA + (size_t)(t + 2) * kstep; const char* b2 = last ? nB : cB + (size_t)(t + 2) * kstep;
            const char* a3 = a2 + kstep; const char* b3 = b2 + kstep;
            if (last && has_next) S.a_ready(nxt);
            if constexpr (SP2) {
            PG8_LDB(B0, 0, 0); PG8_LDB(B1, 0, 1); PG8_SCHED; PG8_LDA(At, 0, 0); PG8_STAGE(PG8_SA(1, 1), a1 + hstep, voffA);
            PG8_WAIT_V(8); PG8_WAIT_L(0); PG8_BAR; PG8_MMA(0, 0, At, B0); PG8_MMA(0, 1, At, B1); PG8_KS(1, t); PG8_BAR; PG8_SCHED;
            PG8_LDA(At, 0, 1); PG8_STAGE(PG8_SB(0, 0), b2, voffB); PG8_STAGE(PG8_SB(0, 1), b2 + hstep, voffB); PG8_STAGE(PG8_SA(0, 0), a2, voffA);
            PG8_WAIT_V(8); PG8_WAIT_L(0); PG8_BAR; PG8_MMA(1, 0, At, B0); PG8_MMA(1, 1, At, B1); PG8_KS(0, t + 1); PG8_BAR; PG8_SCHED;
            PG8_LDB(B0, 1, 0); PG8_LDB(B1, 1, 1); PG8_SCHED; PG8_LDA(At, 1, 0); PG8_STAGE(PG8_SA(0, 1), a2 + hstep, voffA);
            PG8_WAIT_V(8); PG8_WAIT_L(0); PG8_BAR; PG8_MMA(0, 0, At, B0); PG8_MMA(0, 1, At, B1); PG8_KS(1, t + 1); PG8_BAR; PG8_SCHED;
            PG8_LDA(At, 1, 1); PG8_STAGE(PG8_SB(1, 0), b3, voffB); PG8_STAGE(PG8_SB(1, 1), b3 + hstep, voffB); PG8_STAGE(PG8_SA(1, 0), a3, voffA);
            PG8_WAIT_V(8); PG8_WAIT_L(0); PG8_BAR; PG8_MMA(1, 0, At, B0); PG8_MMA(1, 1, At, B1); PG8_KS(0, t + 2); PG8_BAR; PG8_SCHED;
            } else {
            PG8_LDB(B0, 0, 0); PG8_SCHED; PG8_LDA(At, 0, 0); PG8_STAGE(PG8_SA(1, 1), a1 + hstep, voffA);
            PG8_WAIT_L(8); PG8_BAR; PG8_WAIT_L(0); PG8_MMA(0, 0, At, B0); PG8_BAR; PG8_SCHED;
            PG8_LDB(B1, 0, 1); PG8_STAGE(PG8_SB(0, 0), b2, voffB);
            PG8_BAR; PG8_WAIT_L(0); PG8_MMA(0, 1, At, B1); PG8_BAR;
            PG8_LDA(At, 0, 1); PG8_STAGE(PG8_SA(0, 0), a2, voffA);
            PG8_BAR; PG8_WAIT_L(0); PG8_MMA(1, 0, At, B0); PG8_BAR; PG8_SCHED;
            PG8_STAGE(PG8_SB(0, 1), b2 + hstep, voffB);
            PG8_WAIT_V(6); PG8_BAR; PG8_MMA(1, 1, At, B1); PG8_BAR;
            PG8_LDB(B0, 1, 0); PG8_SCHED; PG8_LDA(At, 1, 0); PG8_STAGE(PG8_SA(0, 1), a2 + hstep, voffA);
            PG8_WAIT_L(8); PG8_BAR; PG8_WAIT_L(0); PG8_MMA(0, 0, At, B0); PG8_BAR; PG8_SCHED;
            PG8_LDB(B1, 1, 1); PG8_STAGE(PG8_SB(1, 0), b3, voffB);
            PG8_BAR; PG8_WAIT_L(0); PG8_MMA(0, 1, At, B1); PG8_BAR;
            PG8_LDA(At, 1, 1); PG8_STAGE(PG8_SA(1, 0), a3, voffA);
            PG8_BAR; PG8_WAIT_L(0); PG8_MMA(1, 0, At, B0); PG8_BAR; PG8_SCHED;
            PG8_STAGE(PG8_SB(1, 1), b3 + hstep, voffB);
            PG8_WAIT_V(6); PG8_BAR; PG8_MMA(1, 1, At, B1); PG8_BAR;
            }
        }
        if constexpr (ALIGN_EPI) { if (wr == 0) PG8_BAR; }
        if constexpr (!Epi::AFTER_DRAIN) { E(acc, cur, wr, wc, fr, fq); S.done(cur); }
        if (!has_next) break;
        if constexpr (Epi::INIT_ACC) E.init(acc, nxt, wr, wc, fr, fq); else {
#pragma unroll
        for (int a = 0; a < 2; ++a)
#pragma unroll
            for (int b = 0; b < 2; ++b)
#pragma unroll
                for (int m = 0; m < 4; ++m)
#pragma unroll
                    for (int n = 0; n < 2; ++n) acc[a][b][m][n] = (f32x4){0.f, 0.f, 0.f, 0.f}; }
        cur = nxt; cA = nA; cB = nB; ++ui;
        if constexpr (ALIGN_EPI) { if (wr == 1) PG8_BAR; }
    }
    PG8_WAIT_V(0);
    if constexpr (!ALIGN_EPI) { if (wr == 0) PG8_BAR; }
    PG8_BAR;
    if constexpr (Epi::AFTER_DRAIN) { E.fused(acc, cur, wr, wc, fr, fq, lds, wid, lane); S.done(cur); }
#undef PG8_SA
#undef PG8_SB
#undef PG8_STAGE
#undef PG8_LDA
#undef PG8_LDB
#undef PG8_MMA
#undef PG8_KS
#undef PG8_WAIT_V
#undef PG8_WAIT_L
#undef PG8_BAR
#undef PG8_SCHED
}
}

constexpr int NWAVES = 8;
constexpr int DM = 1024, MP = 16384, MS = 512, MT = MP + MS, SEQ = 4096, NBP = 4, NBS = 128, TS = 4, PAST = 2048;
constexpr int NQ = 768, NIN = 4864, INW = 4880, XBCW = 1536, MIXW = 1792, FF = 2816, FF2 = 5632, NH = 12, SH = 16, HD = 64, SST = 128;
constexpr int NCH = 32;
constexpr float EPS = 1e-6f;
constexpr float LOG2E = 1.4426950408889634f, LN2 = 0.6931471805599453f;
constexpr float QSCALE = 0.125f * LOG2E;

constexpr size_t MiB = 1u << 20;
constexpr size_t WS_CTL = 0, CTL_ZERO_BYTES = 1 * MiB;
constexpr size_t WS_WIN  = 2 * MiB;
constexpr size_t WS_WOUT = WS_WIN + 20 * MiB;
constexpr size_t WS_WUP  = WS_WOUT + 8 * MiB;
constexpr size_t WS_WDN  = WS_WUP + 24 * MiB;
constexpr size_t WS_XN   = WS_WDN + 12 * MiB;
constexpr size_t WS_QB   = WS_XN + 36 * MiB;
constexpr size_t WS_KB   = WS_QB + 26 * MiB;
constexpr size_t WS_VB   = WS_KB + 26 * MiB;
constexpr size_t WS_SZ   = WS_VB + 26 * MiB;
constexpr size_t WS_XBC  = WS_SZ + 36 * MiB;
constexpr size_t WS_XBCC = WS_XBC + 52 * MiB;
constexpr size_t WS_DT   = WS_XBCC + 52 * MiB;
constexpr size_t WS_ACUM = WS_DT + 2 * MiB;
constexpr size_t WS_LSE  = WS_ACUM + 2 * MiB;
constexpr size_t WS_ATTO = WS_LSE + 1 * MiB;
constexpr size_t WS_MIX  = WS_ATTO + 26 * MiB;
constexpr size_t WS_SSQP = WS_MIX + 61 * MiB;
constexpr size_t WS_ST   = WS_SSQP + 2 * MiB;
constexpr size_t WS_HPV  = WS_ST + 68 * MiB;
constexpr size_t WS_CDEC = WS_HPV + 34 * MiB;
constexpr size_t WS_X1   = WS_CDEC + 1 * MiB;
constexpr size_t WS_X2   = WS_X1 + 70 * MiB;
constexpr size_t WS_U    = WS_X2 + 70 * MiB;
constexpr size_t WS_G    = WS_U + 192 * MiB;
constexpr size_t WS_SSQX = WS_G + 96 * MiB;
constexpr size_t WS_WDT  = WS_SSQX + 2 * MiB;
constexpr size_t WS_END  = WS_WDT + 1 * MiB;
static_assert((size_t)2 * NIN * DM * 2 <= 20 * MiB && (size_t)2 * DM * MIXW * 2 <= 8 * MiB && (size_t)2 * FF2 * DM * 2 <= 24 * MiB && (size_t)2 * DM * FF * 2 <= 12 * MiB, "weights");
static_assert((size_t)MT * DM * 2 <= 36 * MiB && (size_t)MT * NQ * 2 <= 26 * MiB && (size_t)MT * XBCW * 2 <= 52 * MiB && (size_t)MT * MIXW * 2 <= 61 * MiB && (size_t)MT * DM * 4 <= 70 * MiB && (size_t)MT * FF2 * 2 <= 192 * MiB && (size_t)MT * FF * 2 <= 96 * MiB, "acts");
constexpr int CW_TMO = 0, CW_CODE = 1;
constexpr int CW_BAR = 4096;

constexpr size_t O_YP = 0, O_YS = O_YP + (size_t)MP * DM, O_KVP0 = O_YS + (size_t)MS * DM, O_KVP1 = O_KVP0 + 2 * 4 * 128 * 512, O_KVP2 = O_KVP1 + 2 * 4 * 512 * 512,
                 O_SSMP = O_KVP2 + (size_t)2 * 4 * 2048 * 512, O_CONVP = O_SSMP + 2 * 4 * 16 * 8192, O_FFNP = O_CONVP + 2 * 4 * 3 * XBCW, O_KVS0 = O_FFNP + 2 * 4 * 2 * FF2,
                 O_KVS1 = O_KVS0 + 2 * 128 * 4 * 512, O_KVS2 = O_KVS1 + 2 * 128 * 4 * 512, O_SSMS = O_KVS2 + 2 * 128 * 4 * 512, O_CONVS = O_SSMS + (size_t)2 * 128 * 16 * 8192,
                 O_FFNS = O_CONVS + 2 * 128 * 3 * XBCW, O_END = O_FFNS + 2 * 128 * 2 * FF2;
static_assert(O_END == 68677632, "output size");

constexpr int RING_OFF = 0, RING_BYTES = 139264;
constexpr int LDSCTL_OFF = RING_BYTES, MISC_OFF = LDSCTL_OFF + 320;
constexpr int RSTD_OFF = LDSCTL_OFF + 512, RSTD_MAXU = 6;
constexpr int EXCH_OFF = RSTD_OFF + RSTD_MAXU * 1024;
constexpr int WTAB_OFF = EXCH_OFF + 12288;
constexpr int LDS_BYTES = 163840;
static_assert(WTAB_OFF + 5120 <= LDS_BYTES, "conv weight table");
static_assert(EXCH_OFF + 12288 <= LDS_BYTES, "exchange region");
static_assert(RSTD_OFF + RSTD_MAXU * 1024 <= LDS_BYTES, "rstd table");
static_assert(MISC_OFF + 128 <= LDS_BYTES, "LDS map");

#define GAS __attribute__((address_space(1)))
#define LAS __attribute__((address_space(3)))
typedef unsigned short bf16;
typedef unsigned v4u __attribute__((ext_vector_type(4)));
typedef float f32x4 __attribute__((ext_vector_type(4)));
typedef short bf16x8 __attribute__((ext_vector_type(8)));
typedef GAS unsigned gu32;
typedef GAS unsigned long long gu64;
#define RLX_AGENT __ATOMIC_RELAXED, __HIP_MEMORY_SCOPE_AGENT
#define LDS_WAIT() asm volatile("s_waitcnt lgkmcnt(0)" ::: "memory")
#define VM_WAIT() asm volatile("s_waitcnt vmcnt(0)" ::: "memory")
__device__ __forceinline__ unsigned long long rt() { return __builtin_amdgcn_s_memrealtime(); }
__device__ __forceinline__ unsigned f2bf(float f) { unsigned u = __builtin_bit_cast(unsigned, f); return (u + 0x7fffu + ((u >> 16) & 1u)) >> 16; }
__device__ __forceinline__ unsigned pk2(float lo, float hi) { return f2bf(lo) | (f2bf(hi) << 16); }

#define XB_TMO      128
#define XB_XCNT(j)  (256  + 64 * (j))
#define XB_XSUB(j)  (1280 + 64 * (j))
#define XB_XGEN(j)  (2304 + 64 * (j))
#define XB_TOP      3328
#define XB_TOPGEN   3392
#define XCD_BAR_WORDS 3456
#define XB_SPIN_CAP (1u << 18)

__device__ __forceinline__ unsigned xb_ld(unsigned* p)              { return __hip_atomic_load(p, __ATOMIC_RELAXED, __HIP_MEMORY_SCOPE_AGENT); }
__device__ __forceinline__ unsigned xb_add(unsigned* p, unsigned v) { return __hip_atomic_fetch_add(p, v, __ATOMIC_RELAXED, __HIP_MEMORY_SCOPE_AGENT); }
__device__ __forceinline__ unsigned xb_xcc_id() { return (unsigned)__builtin_amdgcn_s_getreg((3 << 11) | 20) & 0xFu; }
#define XB_SPIN(cond, bar) do { unsigned _sp = 0; while (cond) { __builtin_amdgcn_s_sleep(1); \
    if ((++_sp & 255u) == 0u) { if (xb_ld(&(bar)[XB_TMO])) break; if (_sp > XB_SPIN_CAP) { atomicAdd(&(bar)[XB_TMO], 1u); break; } } } } while (0)

struct XcdBarrier {
    unsigned* bar; unsigned x;
    volatile LAS unsigned* st;
};

__device__ __forceinline__ XcdBarrier xcd_barrier_post(unsigned* bar, volatile LAS unsigned* st) {
    XcdBarrier b; b.bar = bar; b.x = xb_xcc_id(); b.st = st;
    if (threadIdx.x == 0) (void)xb_add(&bar[XB_XCNT(b.x)], 1u);
    return b;
}
__device__ __forceinline__ void xcd_barrier_complete(unsigned* bar, unsigned x, unsigned& nloc, unsigned& nx) {
    const unsigned G = gridDim.x * gridDim.y * gridDim.z;
    unsigned sum, cnt, mine, sp = 0u;
    for (;;) {
        sum = 0u; cnt = 0u; mine = 0u;
#pragma unroll
        for (unsigned j = 0; j < 16; ++j) { const unsigned c = xb_ld(&bar[XB_XCNT(j)]); sum += c; cnt += (c > 0u) ? 1u : 0u; mine = (j == x) ? c : mine; }
        if (sum == G) break;
        __builtin_amdgcn_s_sleep(1);
        if ((++sp & 255u) == 0u) { if (xb_ld(&bar[XB_TMO])) break; if (sp > XB_SPIN_CAP) { atomicAdd(&bar[XB_TMO], 1u); break; } }
    }
    nloc = mine > 0u ? mine : 1u; nx = cnt > 0u ? cnt : 1u;
}

__device__ __forceinline__ void xcd_barrier(const XcdBarrier& b) {
    asm volatile("s_waitcnt vmcnt(0)" ::: "memory");
    __syncthreads();
    if (threadIdx.x == 0) {
        unsigned* bar = b.bar;
        __builtin_amdgcn_s_waitcnt(0);
        unsigned nloc = b.st[0], nx = b.st[1];
        if (nloc == 0u) { xcd_barrier_complete(bar, b.x, nloc, nx); b.st[0] = nloc; b.st[1] = nx; }
        const unsigned old = xb_add(&bar[XB_XSUB(b.x)], 1u);
        const unsigned gen = old / nloc;
        if (old + 1u == (gen + 1u) * nloc) {
            __builtin_amdgcn_fence(__ATOMIC_RELEASE, "agent");
            asm volatile("s_waitcnt vmcnt(0)" ::: "memory");
            const unsigned og = xb_add(&bar[XB_TOP], 1u);
            const unsigned tg = og / nx;
            if (og + 1u == (tg + 1u) * nx) xb_add(&bar[XB_TOPGEN], 1u);
            else XB_SPIN(xb_ld(&bar[XB_TOPGEN]) == tg, bar);
            __builtin_amdgcn_fence(__ATOMIC_ACQUIRE, "agent");
            xb_add(&bar[XB_XGEN(b.x)], 1u);
            asm volatile("s_waitcnt vmcnt(0)" ::: "memory");
        } else {
            XB_SPIN(xb_ld(&bar[XB_XGEN(b.x)]) == gen, bar);
            __builtin_amdgcn_fence(__ATOMIC_ACQUIRE, "agent");
            asm volatile("s_waitcnt vmcnt(0)" ::: "memory");
        }
    }
    __syncthreads();
}


typedef short v4i16_t __attribute__((ext_vector_type(4)));
typedef float f32x2 __attribute__((ext_vector_type(2)));
typedef unsigned v2u __attribute__((ext_vector_type(2)));
__device__ __forceinline__ float bflo(unsigned w) { return __uint_as_float(w << 16); }
__device__ __forceinline__ float bfhi(unsigned w) { return __uint_as_float(w & 0xffff0000u); }
__device__ __forceinline__ float bf2f(unsigned short u) { return __uint_as_float((unsigned)u << 16); }
__device__ __forceinline__ unsigned cvtpk(float lo, float hi) { return pg8::cvt_pk_bf16(lo, hi); }
__device__ __forceinline__ float silu_f(float x) { return x * __builtin_amdgcn_rcpf(1.f + __expf(-x)); }
__device__ __forceinline__ float softplus_f(float x) { return x > 20.f ? x : log1pf(__expf(x)); }
template <int CTRL> __device__ __forceinline__ float dpp_x(float x) { return __builtin_bit_cast(float, __builtin_amdgcn_update_dpp(0, __builtin_bit_cast(int, x), CTRL, 0xf, 0xf, true)); }
__device__ __forceinline__ float red16(float s) { s += dpp_x<0xB1>(s); s += dpp_x<0x4E>(s); s += dpp_x<0x141>(s); s += dpp_x<0x140>(s); return s; }
__device__ __forceinline__ float wave_sum(float v) { v = red16(v); v += __shfl_xor(v, 16); v += __shfl_xor(v, 32); return v; }
__device__ __forceinline__ bf16x8 tr2(const LAS char* p0, const LAS char* p1) {
    const v4i16_t a = __builtin_amdgcn_ds_read_tr16_b64_v4i16((LAS v4i16_t*)p0), b = __builtin_amdgcn_ds_read_tr16_b64_v4i16((LAS v4i16_t*)p1);
    return __builtin_shufflevector(a, b, 0, 1, 2, 3, 4, 5, 6, 7);
}
__device__ __forceinline__ f32x4 mfma16(bf16x8 a, bf16x8 b, f32x4 c) { return __builtin_amdgcn_mfma_f32_16x16x32_bf16(a, b, c, 0, 0, 0); }

__device__ __forceinline__ float rstd16(const float* p) {
    const f32x4* sp = (const f32x4*)p; const f32x4 a = sp[0], b = sp[1], c = sp[2], d = sp[3];
    const float s = ((a[0] + a[1]) + (a[2] + a[3])) + ((b[0] + b[1]) + (b[2] + b[3])) + ((c[0] + c[1]) + (c[2] + c[3])) + ((d[0] + d[1]) + (d[2] + d[3]));
    return rsqrtf(s * (1.f / 1024.f) + EPS);
}
__device__ __forceinline__ void row_rstd8(const LAS float* tab, int idx, int rloc, float (&rr)[2][4]) {
#pragma unroll
    for (int ai = 0; ai < 2; ++ai)
#pragma unroll
        for (int m = 0; m < 4; ++m) rr[ai][m] = tab[idx * 256 + rloc + 128 * ai + 16 * m];
}
template <class Sched> __device__ __forceinline__ void prefill_rstd(LAS float* tab, const Sched& S, const float* ssq, int tid) {
    pg8::Unit u; f32x4 p[RSTD_MAXU][2]; bool ok[RSTD_MAXU];
    const int r = tid >> 1, hf = tid & 1;
#pragma unroll
    for (int i = 0; i < RSTD_MAXU; ++i) { ok[i] = S.next(i, u); p[i][0] = (f32x4){0.f, 0.f, 0.f, 0.f}; p[i][1] = p[i][0];
        if (ok[i]) { const int r_ = u.arow + r; const float* q = ssq + (size_t)(r_ < 0 ? 0 : r_) * 16 + 8 * hf; p[i][0] = *(const f32x4*)q; p[i][1] = *(const f32x4*)(q + 4); } }
#pragma unroll
    for (int i = 0; i < RSTD_MAXU; ++i) { float s = ((p[i][0][0] + p[i][0][1]) + (p[i][0][2] + p[i][0][3])) + ((p[i][1][0] + p[i][1][1]) + (p[i][1][2] + p[i][1][3]));
        s += dpp_x<0xB1>(s);
        if (ok[i] && hf == 0) tab[i * 256 + r] = rsqrtf(s * (1.f / 1024.f) + EPS); }
    __syncthreads();
}

__device__ __forceinline__ void store_pair16(bf16* rowp  , const v2u pk_even, const v2u pk_odd, const int pr, const int fq) {
    const bool odd = fq & 1; const v2u mine = odd ? pk_odd : pk_even, send = odd ? pk_even : pk_odd;
    v2u recv; recv.x = __shfl_xor(send.x, 16); recv.y = __shfl_xor(send.y, 16);
    v4u o; if (odd) { o.x = recv.x; o.y = recv.y; o.z = mine.x; o.w = mine.y; } else { o.x = mine.x; o.y = mine.y; o.z = recv.x; o.w = recv.y; }
    *(v4u*)(rowp + 16 * (2 * pr + (odd ? 1 : 0)) + 4 * (fq & ~1)) = o;
}
struct EpiInProj {
    static constexpr bool PERM = true, AFTER_DRAIN = false, INIT_ACC = false, KSCALE = false; static constexpr int HOOK_T = -1;
    bf16 *QB, *KB, *VB, *SZ, *XBC; const float *qn, *kn; float* out; int layer; const LAS float* ssqx;
    __device__ __forceinline__ void kv_out(int row, int g, int kv, int slot, int e0, f32x4 v0, f32x4 v1) const {
        const int keep = 128 << (2 * g);
        float* p = nullptr;
        if (row < MP) { const int b = row >> 12, t = row & 4095;
            if (t >= SEQ - keep) { const size_t base = g == 0 ? O_KVP0 : (g == 1 ? O_KVP1 : O_KVP2);
                p = out + base + ((((size_t)(layer * NBP + b) * keep + (t - (SEQ - keep))) * 2 + kv) * 4 + slot) * 64 + e0; } }
        else { const int rs = row - MP, b = rs >> 2, t = rs & 3; const size_t base = g == 0 ? O_KVS0 : (g == 1 ? O_KVS1 : O_KVS2);
            p = out + base + ((((size_t)(layer * NBS + b) * TS + t) * 2 + kv) * 4 + slot) * 64 + e0; }
        if (p) { *(f32x4*)p = v0; *(f32x4*)(p + 4) = v1; }
    }
    __device__ __forceinline__ void operator()(const f32x4 (&acc)[2][2][4][2], const pg8::Unit& u, int wr, int wc, int fr, int fq) const {
        const int pn = u.pn, rbase = u.pm * 256 + wr * 64 + fr, ct = 64 * wc + 8 * fq;
        float rr8[2][4]; row_rstd8(ssqx, u.idx, wr * 64 + fr, rr8);
        if (pn < 6) {
            const bool isq = pn < 3; const float* gn = isq ? +qn : +kn;
            f32x4 g[2][2];
#pragma unroll
            for (int bj = 0; bj < 2; ++bj)
#pragma unroll
                for (int n = 0; n < 2; ++n) g[bj][n] = *(const f32x4*)(gn + 32 * bj + 8 * fq + 4 * n);
            const float post = isq ? QSCALE : 1.f; bf16* dst = isq ? +QB : +KB; const int c0 = (isq ? pn : pn - 3) * 256 + ct;
#pragma unroll
            for (int ai = 0; ai < 2; ++ai)
#pragma unroll
                for (int m = 0; m < 4; ++m) { const int row = rbase + ai * 128 + m * 16; float ss = 0.f; const float rr = rr8[ai][m];
#pragma unroll
                    for (int bj = 0; bj < 2; ++bj)
#pragma unroll
                        for (int n = 0; n < 2; ++n) { const f32x4 x = acc[ai][bj][m][n]; ss += (x[0] * x[0] + x[1] * x[1]) + (x[2] * x[2] + x[3] * x[3]); }
                    ss += __shfl_xor(ss, 16); ss += __shfl_xor(ss, 32);
                    const float rs = rr * rsqrtf(ss * (rr * rr) * (1.f / 64.f) + EPS);
#pragma unroll
                    for (int bj = 0; bj < 2; ++bj) { const f32x4 v0 = acc[ai][bj][m][0] * rs * g[bj][0], v1 = acc[ai][bj][m][1] * rs * g[bj][1];
                        v4u w; w.x = cvtpk(v0[0] * post, v0[1] * post); w.y = cvtpk(v0[2] * post, v0[3] * post); w.z = cvtpk(v1[0] * post, v1[1] * post); w.w = cvtpk(v1[2] * post, v1[3] * post);
                        *(v4u*)(dst + (size_t)row * NQ + c0 + 32 * bj) = w;
                        if (!isq) kv_out(row, pn - 3, 0, wc, 32 * bj + 8 * fq, v0, v1); } }
        } else if (pn < 9) {
            const int c0 = (pn - 6) * 256 + ct;
#pragma unroll
            for (int ai = 0; ai < 2; ++ai)
#pragma unroll
                for (int m = 0; m < 4; ++m) { const int row = rbase + ai * 128 + m * 16; const float rr = rr8[ai][m];
#pragma unroll
                    for (int bj = 0; bj < 2; ++bj) { const f32x4 v0 = acc[ai][bj][m][0] * rr, v1 = acc[ai][bj][m][1] * rr;
                        v4u w; w.x = cvtpk(v0[0], v0[1]); w.y = cvtpk(v0[2], v0[3]); w.z = cvtpk(v1[0], v1[1]); w.w = cvtpk(v1[2], v1[3]);
                        *(v4u*)(VB + (size_t)row * NQ + c0 + 32 * bj) = w;
                        kv_out(row, pn - 6, 1, wc, 32 * bj + 8 * fq, v0, v1); } }
        } else if (pn < 13) {
            const int c0 = (pn - 9) * 256 + ct;
#pragma unroll
            for (int ai = 0; ai < 2; ++ai)
#pragma unroll
                for (int m = 0; m < 4; ++m) { const int row = rbase + ai * 128 + m * 16; const float rr = rr8[ai][m];
#pragma unroll
                    for (int bj = 0; bj < 2; ++bj) { const f32x4 v0 = acc[ai][bj][m][0] * rr, v1 = acc[ai][bj][m][1] * rr;
                        v4u w; w.x = cvtpk(silu_f(v0[0]), silu_f(v0[1])); w.y = cvtpk(silu_f(v0[2]), silu_f(v0[3])); w.z = cvtpk(silu_f(v1[0]), silu_f(v1[1])); w.w = cvtpk(silu_f(v1[2]), silu_f(v1[3]));
                        *(v4u*)(SZ + (size_t)row * DM + c0 + 32 * bj) = w; } }
        } else {
            const int c0 = (pn - 13) * 256 + ct;
#pragma unroll
            for (int ai = 0; ai < 2; ++ai)
#pragma unroll
                for (int m = 0; m < 4; ++m) { const int row = rbase + ai * 128 + m * 16; const float rr = rr8[ai][m];
                    float* p = nullptr;
                    if (row < MP) { const int b = row >> 12, t = row & 4095; if (t >= SEQ - 3) p = out + O_CONVP + ((size_t)(layer * NBP + b) * 3 + (t - (SEQ - 3))) * XBCW + c0; }
                    else { const int rs = row - MP, b = rs >> 2, t = rs & 3; if (t >= 1) p = out + O_CONVS + ((size_t)(layer * NBS + b) * 3 + (t - 1)) * XBCW + c0; }
#pragma unroll
                    for (int bj = 0; bj < 2; ++bj) { const f32x4 v0 = acc[ai][bj][m][0] * rr, v1 = acc[ai][bj][m][1] * rr;
                        v4u w; w.x = cvtpk(v0[0], v0[1]); w.y = cvtpk(v0[2], v0[3]); w.z = cvtpk(v1[0], v1[1]); w.w = cvtpk(v1[2], v1[3]);
                        *(v4u*)(XBC + (size_t)row * XBCW + c0 + 32 * bj) = w;
                        if (p) { *(f32x4*)(p + 32 * bj) = v0; *(f32x4*)(p + 32 * bj + 4) = v1; } } }
        }
    }
    __device__ __forceinline__ void hook(f32x4 (&)[2][2][4][2], const pg8::Unit&, int, int, int, int) const {}
};

template <int HT> struct EpiResid {
    static constexpr bool PERM = true, AFTER_DRAIN = false, INIT_ACC = true, KSCALE = false; static constexpr int HOOK_T = HT;
    float* outp; const LAS float* ssqp; bf16* xb; float* ssqx;
    __device__ __forceinline__ void init(f32x4 (&acc)[2][2][4][2], const pg8::Unit& u, int wr, int wc, int fr, int fq) const {
        const int rbase = u.pm * 256 + wr * 64 + fr, col0 = u.pn * 256 + wc * 32 + 8 * fq;
        float rr8[2][4];
        if (HT >= 0) row_rstd8(ssqp, u.idx, wr * 64 + fr, rr8);
#pragma unroll
        for (int ai = 0; ai < 2; ++ai)
#pragma unroll
            for (int m = 0; m < 4; ++m) { const int row = rbase + ai * 128 + m * 16; const bf16* bp = xb + (size_t)row * DM;
                const float sc = HT >= 0 ? 1.f / rr8[ai][m] : 1.f;
#pragma unroll
                for (int bj = 0; bj < 2; ++bj) { const v4u w = *(const v4u*)(bp + col0 + 128 * bj);
                    acc[ai][bj][m][0] = (f32x4){bflo(w.x), bfhi(w.x), bflo(w.y), bfhi(w.y)} * sc; acc[ai][bj][m][1] = (f32x4){bflo(w.z), bfhi(w.z), bflo(w.w), bfhi(w.w)} * sc; } }
    }
    __device__ __forceinline__ void operator()(const f32x4 (&acc)[2][2][4][2], const pg8::Unit& u, int wr, int wc, int fr, int fq) const {
        const int rbase = u.pm * 256 + wr * 64 + fr, col0 = u.pn * 256 + wc * 32 + 8 * fq;
#pragma unroll
        for (int ai = 0; ai < 2; ++ai)
#pragma unroll
            for (int m = 0; m < 4; ++m) { const int row = rbase + ai * 128 + m * 16;
                float ss = 0.f;
#pragma unroll
                for (int bj = 0; bj < 2; ++bj) { const int c = col0 + 128 * bj;
                    const f32x4 o0 = acc[ai][bj][m][0], o1 = acc[ai][bj][m][1];
                    if (outp) { float* op = outp + (size_t)row * DM; *(f32x4*)(op + c) = o0; *(f32x4*)(op + c + 4) = o1; }
                    if (ssqx) { ss += ((o0[0] * o0[0] + o0[1] * o0[1]) + (o0[2] * o0[2] + o0[3] * o0[3])) + ((o1[0] * o1[0] + o1[1] * o1[1]) + (o1[2] * o1[2] + o1[3] * o1[3]));
                        v4u w; w.x = cvtpk(o0[0], o0[1]); w.y = cvtpk(o0[2], o0[3]); w.z = cvtpk(o1[0], o1[1]); w.w = cvtpk(o1[2], o1[3]);
                        *(v4u*)(xb + (size_t)row * DM + c) = w; } }
                if (ssqx) { ss += __shfl_xor(ss, 16); ss += __shfl_xor(ss, 32);
                    if (fq == 0) ssqx[(size_t)row * 16 + 4 * u.pn + wc] = ss; } }
    }
    __device__ __forceinline__ void hook(f32x4 (&acc)[2][2][4][2], const pg8::Unit& u, int wr, int wc, int fr, int fq) const {
        float rr8[2][4]; row_rstd8(ssqp, u.idx, wr * 64 + fr, rr8);
#pragma unroll
        for (int ai = 0; ai < 2; ++ai)
#pragma unroll
            for (int m = 0; m < 4; ++m)
#pragma unroll
                for (int bj = 0; bj < 2; ++bj)
#pragma unroll
                    for (int n = 0; n < 2; ++n) acc[ai][bj][m][n] = acc[ai][bj][m][n] * rr8[ai][m];
    }
};

struct EpiUp {
    static constexpr bool PERM = true, AFTER_DRAIN = false, INIT_ACC = false, KSCALE = false; static constexpr int HOOK_T = -1;
    bf16* U; float* out; int layer; const LAS float* ssqx;
    __device__ __forceinline__ void operator()(const f32x4 (&acc)[2][2][4][2], const pg8::Unit& u, int wr, int wc, int fr, int fq) const {
        const int rbase = u.pm * 256 + wr * 64 + fr, col0 = u.pn * 256 + wc * 32 + 8 * fq, tc0 = 128 * u.pn + 32 * wc + 8 * fq;
        float rr8[2][4]; row_rstd8(ssqx, u.idx, wr * 64 + fr, rr8);
#pragma unroll
        for (int ai = 0; ai < 2; ++ai)
#pragma unroll
            for (int m = 0; m < 4; ++m) { const int row = rbase + ai * 128 + m * 16;
                float* p = nullptr;
                if (row < MP) { const int b = row >> 12, t = row & 4095; if (t >= SEQ - 2) p = out + O_FFNP + ((size_t)(layer * NBP + b) * 2 + (t - (SEQ - 2))) * FF2 + tc0; }
                else { const int rs = row - MP, b = rs >> 2, t = rs & 3; if (t >= 2) p = out + O_FFNS + ((size_t)(layer * NBS + b) * 2 + (t - 2)) * FF2 + tc0; }
                const float rr = rr8[ai][m];
#pragma unroll
                for (int bj = 0; bj < 2; ++bj) { const f32x4 v0 = acc[ai][bj][m][0] * rr, v1 = acc[ai][bj][m][1] * rr;
                    v4u w; w.x = cvtpk(v0[0], v0[1]); w.y = cvtpk(v0[2], v0[3]); w.z = cvtpk(v1[0], v1[1]); w.w = cvtpk(v1[2], v1[3]);
                    *(v4u*)(U + (size_t)row * FF2 + col0 + 128 * bj) = w;
                    if (p) { *(f32x4*)(p + bj * FF) = v0; *(f32x4*)(p + bj * FF + 4) = v1; } } }
    }
    __device__ __forceinline__ void hook(f32x4 (&)[2][2][4][2], const pg8::Unit&, int, int, int, int) const {}
};
__device__ __forceinline__ float dbg_sane(float x) { return (x == x && fabsf(x) < 1e30f) ? x : 12345.f; }

struct UpOrder {
    pg8::StaticOrder S;
    __device__ void init(int G_, int c_) { S.init(67 * 256, FF2, G_, c_); }
    __device__ bool next(int i, pg8::Unit& u) const { if (!S.next(i, u)) return false; u.arow = u.pm < 65 ? 254 * u.pm - 2 : MP + 256 * (u.pm - 65); return true; }
    __device__ __forceinline__ void a_ready(const pg8::Unit&) const {}
    __device__ __forceinline__ void done(const pg8::Unit&) const {}
};
__device__ __forceinline__ float dpp_shr1(float old, float src) { return __builtin_bit_cast(float, __builtin_amdgcn_update_dpp(__builtin_bit_cast(int, old), __builtin_bit_cast(int, src), 0x111, 0xf, 0xf, false)); }
__device__ __forceinline__ float dpp_shr2(float old, float src) { return __builtin_bit_cast(float, __builtin_amdgcn_update_dpp(__builtin_bit_cast(int, old), __builtin_bit_cast(int, src), 0x112, 0xf, 0xf, false)); }
__device__ __forceinline__ float dpp_ror1(float src) { return __builtin_bit_cast(float, __builtin_amdgcn_update_dpp(0, __builtin_bit_cast(int, src), 0x121, 0xf, 0xf, false)); }
__device__ __forceinline__ float dpp_ror2(float src) { return __builtin_bit_cast(float, __builtin_amdgcn_update_dpp(0, __builtin_bit_cast(int, src), 0x122, 0xf, 0xf, false)); }
struct EpiUpConv {
    static constexpr bool PERM = true, AFTER_DRAIN = false, INIT_ACC = false, KSCALE = false; static constexpr int HOOK_T = 8;
    bf16* G; float* out; int layer; const LAS float* rs; LAS float* exch; const float* fcw; const float* fcb; const float* stf; LAS float* wtab;
    __device__ __forceinline__ void operator()(const f32x4 (&acc)[2][2][4][2], const pg8::Unit& u, int wr, int wc, int fr, int fq) const {
        const bool samp = u.arow >= MP; const int rloc = wr * 64 + fr, ch0 = 128 * u.pn + 32 * wc + 8 * fq;
        float rr8[2][4]; row_rstd8(rs, u.idx, rloc, rr8);
        if (fr >= 14) {
#pragma unroll
            for (int ai = 0; ai < 2; ++ai)
#pragma unroll
                for (int bj = 0; bj < 2; ++bj)
#pragma unroll
                    for (int n = 0; n < 2; ++n) *(LAS f32x4*)(exch + ((((wr * 4 + wc) * 2 + ai) * 2 + (fr - 14)) * 64 + fq * 16 + bj * 8 + n * 4)) = acc[ai][bj][3][n] * rr8[ai][3];
        }
        asm volatile("s_waitcnt vmcnt(0) lgkmcnt(0)" ::: "memory"); __builtin_amdgcn_s_barrier(); asm volatile("" ::: "memory");
        v2u keep[2][4];
        pass<0>(acc, u, wr, wc, fr, fq, samp, rloc, ch0, rr8, keep);
        pass<1>(acc, u, wr, wc, fr, fq, samp, rloc, ch0, rr8, keep);
    }
    template <int n> __device__ __forceinline__ void pass(const f32x4 (&acc)[2][2][4][2], const pg8::Unit& u, int wr, int wc, int fr, int fq, const bool samp, const int rloc, const int ch0, const float (&rr8)[2][4], v2u (&keep)[2][4]) const {
            f32x4 wg[3], wu[3], bg, bu;
#pragma unroll
            for (int tp = 0; tp < 3; ++tp) { wg[tp] = *(const LAS f32x4*)(wtab + tp * 128 + (ch0 & 127) + 4 * n); wu[tp] = *(const LAS f32x4*)(wtab + (3 + tp) * 128 + (ch0 & 127) + 4 * n); }
            bg = *(const LAS f32x4*)(wtab + 6 * 128 + (ch0 & 127) + 4 * n); bu = *(const LAS f32x4*)(wtab + 7 * 128 + (ch0 & 127) + 4 * n);
#pragma unroll
            for (int ai = 0; ai < 2; ++ai) {
                const int blk = 2 * ai + wr;
                f32x4 b14g = (f32x4){0.f, 0.f, 0.f, 0.f}, b15g = b14g, b14u = b14g, b15u = b14g;
                if (blk > 0) { const int sa = (blk - 1) >> 1, sw = (blk - 1) & 1; const LAS float* s = exch + (((sw * 4 + wc) * 2 + sa) * 2) * 64 + fq * 16 + n * 4;
                    b14g = *(const LAS f32x4*)(s); b14u = *(const LAS f32x4*)(s + 8); b15g = *(const LAS f32x4*)(s + 64); b15u = *(const LAS f32x4*)(s + 64 + 8); }
                f32x4 pg = b15g, pu = b15u;
                f32x4 og1 = b15g, ou1 = b15u, og2 = (fr == 0) ? b14g : b15g, ou2 = (fr == 0) ? b14u : b15u;
#pragma unroll
                for (int m = 0; m < 4; ++m) {
                    const f32x4 g0 = acc[ai][0][m][n] * rr8[ai][m], u0 = acc[ai][1][m][n] * rr8[ai][m];
                    f32x4 g1, g2, u1, u2;
#pragma unroll
                    for (int i = 0; i < 4; ++i) {
                        const float o1g = m ? dpp_ror1(pg[i]) : og1[i], o2g = m ? dpp_ror2(pg[i]) : og2[i], o1u = m ? dpp_ror1(pu[i]) : ou1[i], o2u = m ? dpp_ror2(pu[i]) : ou2[i];
                        g1[i] = dpp_shr1(o1g, g0[i]); g2[i] = dpp_shr2(o2g, g0[i]); u1[i] = dpp_shr1(o1u, u0[i]); u2[i] = dpp_shr2(o2u, u0[i]); }
                    pg = g0; pu = u0;
                    const int r = rloc + 128 * ai + 16 * m, grow = u.arow + r;
                    bool valid;
                    if (!samp) { const int t = grow & 4095; valid = (r >= 2) && (grow < MP);
                        if (t < 2) { g2 = (f32x4){0.f, 0.f, 0.f, 0.f}; u2 = g2; if (t < 1) { g1 = g2; u1 = g2; } }
                        if (valid && t >= SEQ - 2) { float* p = out + O_FFNP + ((size_t)(layer * NBP + (grow >> 12)) * 2 + (t - (SEQ - 2))) * FF2 + ch0 + 4 * n; *(f32x4*)p = g0; *(f32x4*)(p + FF) = u0; }
                    } else { const int rs_ = grow - MP, b = rs_ >> 2, t = rs_ & 3; valid = true;
                        if (t < 2) { const float* sp = stf + (size_t)b * 2 * FF2 + ch0 + 4 * n;
                            const f32x4 s1g = *(const f32x4*)(sp + FF2), s1u = *(const f32x4*)(sp + FF2 + FF);
                            if (t == 0) { g2 = *(const f32x4*)(sp); u2 = *(const f32x4*)(sp + FF); g1 = s1g; u1 = s1u; } else { g2 = s1g; u2 = s1u; } }
                        if (t >= 2) { float* p = out + O_FFNS + ((size_t)(layer * NBS + b) * 2 + (t - 2)) * FF2 + ch0 + 4 * n; *(f32x4*)p = g0; *(f32x4*)(p + FF) = u0; }
                    }
                    if (n == 0) keep[ai][m] = (v2u){0u, 0u};
                    if (valid) { const f32x4 gc = bg + wg[0] * g2 + wg[1] * g1 + wg[2] * g0, uc = bu + wu[0] * u2 + wu[1] * u1 + wu[2] * u0;
                        v2u o; o.x = cvtpk(silu_f(gc[0]) * uc[0], silu_f(gc[1]) * uc[1]); o.y = cvtpk(silu_f(gc[2]) * uc[2], silu_f(gc[3]) * uc[3]);
                        if (n == 0) keep[ai][m] = o;
                        else { v4u o4; o4.x = keep[ai][m].x; o4.y = keep[ai][m].y; o4.z = o.x; o4.w = o.y; *(v4u*)(G + (size_t)grow * FF + ch0) = o4; } }
                }
            }
    }
    __device__ __forceinline__ void hook(f32x4 (&)[2][2][4][2], const pg8::Unit& u, int wr, int wc, int fr, int fq) const {
        if (wr == 0) { const int tid_ = wc * 64 + fq * 16 + fr, q = tid_ >> 5, c4 = tid_ & 31;
            const float* src = (q < 3 ? fcw + q * FF2 : (q < 6 ? fcw + (q - 3) * FF2 + FF : (q == 6 ? fcb : fcb + FF))) + 128 * u.pn + 4 * c4;
            __builtin_amdgcn_global_load_lds((const unsigned*)src, (LAS unsigned*)(wtab + wc * 256), 16, 0, 0); }
    }
};

struct InOrder {
    pg8::StaticOrder S;
    __device__ void init(int G_, int c_) { S.init(67 * 256, NIN, G_, c_); }
    __device__ bool next(int i, pg8::Unit& u) const { if (!S.next(i, u)) return false; u.arow = u.pm < 65 ? 253 * u.pm - 3 : MP + 256 * (u.pm - 65); return true; }
    __device__ __forceinline__ void a_ready(const pg8::Unit&) const {}
    __device__ __forceinline__ void done(const pg8::Unit&) const {}
};
__device__ __forceinline__ float dpp_shr3(float old, float src) { return __builtin_bit_cast(float, __builtin_amdgcn_update_dpp(__builtin_bit_cast(int, old), __builtin_bit_cast(int, src), 0x113, 0xf, 0xf, false)); }
__device__ __forceinline__ float dpp_ror3(float src) { return __builtin_bit_cast(float, __builtin_amdgcn_update_dpp(0, __builtin_bit_cast(int, src), 0x123, 0xf, 0xf, false)); }
struct EpiInProj3 {
    static constexpr bool PERM = true, AFTER_DRAIN = false, INIT_ACC = false, KSCALE = false; static constexpr int HOOK_T = -1;
    bf16 *QB, *KB, *VB, *SZ, *XBCC, *XBC; const float *qn, *kn; float* out; int layer; const LAS float* ssqx; LAS float* exch; const float* cw; const float* cb; const float* stc; LAS float* wtab;
    __device__ __forceinline__ void kv_out(int row, int g, int kv, int slot, int e0, f32x4 v0, f32x4 v1) const {
        const int keep = 128 << (2 * g);
        float* p = nullptr;
        if (row < MP) { const int b = row >> 12, t = row & 4095;
            if (t >= SEQ - keep) { const size_t base = g == 0 ? O_KVP0 : (g == 1 ? O_KVP1 : O_KVP2);
                p = out + base + ((((size_t)(layer * NBP + b) * keep + (t - (SEQ - keep))) * 2 + kv) * 4 + slot) * 64 + e0; } }
        else { const int rs = row - MP, b = rs >> 2, t = rs & 3; const size_t base = g == 0 ? O_KVS0 : (g == 1 ? O_KVS1 : O_KVS2);
            p = out + base + ((((size_t)(layer * NBS + b) * TS + t) * 2 + kv) * 4 + slot) * 64 + e0; }
        if (p) { *(f32x4*)p = v0; *(f32x4*)(p + 4) = v1; }
    }
    __device__ __forceinline__ void operator()(const f32x4 (&acc)[2][2][4][2], const pg8::Unit& u, int wr, int wc, int fr, int fq) const {
        asm volatile("" : "+v"(fr), "+v"(fq));
        const int pn = u.pn; int rloc = wr * 64 + fr, ct = 64 * wc + 8 * fq; const bool samp = u.arow >= MP;
        float rr8[2][4]; if (pn < 13) row_rstd8(ssqx, u.idx, rloc, rr8);
        if (pn < 6) {
            const bool isq = pn < 3; const float* gn = isq ? +qn : +kn;
            f32x4 g[2][2];
#pragma unroll
            for (int bj = 0; bj < 2; ++bj)
#pragma unroll
                for (int n = 0; n < 2; ++n) g[bj][n] = *(const f32x4*)(gn + 32 * bj + 8 * fq + 4 * n);
            const float post = isq ? QSCALE : 1.f; bf16* dst = isq ? +QB : +KB; const int c0 = (isq ? pn : pn - 3) * 256 + ct;
#pragma unroll
            for (int ai = 0; ai < 2; ++ai)
#pragma unroll
                for (int m = 0; m < 4; ++m) { const int r = rloc + ai * 128 + m * 16, row = u.arow + r; const bool valid = samp || (r >= 3 && row < MP); float ss = 0.f; const float rr = rr8[ai][m];
#pragma unroll
                    for (int bj = 0; bj < 2; ++bj)
#pragma unroll
                        for (int n = 0; n < 2; ++n) { const f32x4 x = acc[ai][bj][m][n]; ss += (x[0] * x[0] + x[1] * x[1]) + (x[2] * x[2] + x[3] * x[3]); }
                    ss += __shfl_xor(ss, 16); ss += __shfl_xor(ss, 32);
                    const float rs = rr * rsqrtf(ss * (rr * rr) * (1.f / 64.f) + EPS);
                    if (valid) {
#pragma unroll
                    for (int bj = 0; bj < 2; ++bj) { const f32x4 v0 = acc[ai][bj][m][0] * rs * g[bj][0], v1 = acc[ai][bj][m][1] * rs * g[bj][1];
                        v4u w; w.x = cvtpk(v0[0] * post, v0[1] * post); w.y = cvtpk(v0[2] * post, v0[3] * post); w.z = cvtpk(v1[0] * post, v1[1] * post); w.w = cvtpk(v1[2] * post, v1[3] * post);
                        *(v4u*)(dst + (size_t)row * NQ + c0 + 32 * bj) = w;
                        if (!isq) kv_out(row, pn - 3, 0, wc, 32 * bj + 8 * fq, v0, v1); } } }
        } else if (pn < 9) {
            const int c0 = (pn - 6) * 256 + ct;
#pragma unroll
            for (int ai = 0; ai < 2; ++ai)
#pragma unroll
                for (int m = 0; m < 4; ++m) { const int r = rloc + ai * 128 + m * 16, row = u.arow + r; const bool valid = samp || (r >= 3 && row < MP); const float rr = rr8[ai][m];
                    if (valid) {
#pragma unroll
                    for (int bj = 0; bj < 2; ++bj) { const f32x4 v0 = acc[ai][bj][m][0] * rr, v1 = acc[ai][bj][m][1] * rr;
                        v4u w; w.x = cvtpk(v0[0], v0[1]); w.y = cvtpk(v0[2], v0[3]); w.z = cvtpk(v1[0], v1[1]); w.w = cvtpk(v1[2], v1[3]);
                        *(v4u*)(VB + (size_t)row * NQ + c0 + 32 * bj) = w;
                        kv_out(row, pn - 6, 1, wc, 32 * bj + 8 * fq, v0, v1); } } }
        } else if (pn < 13) {
            const int c0 = (pn - 9) * 256 + ct;
#pragma unroll
            for (int ai = 0; ai < 2; ++ai)
#pragma unroll
                for (int m = 0; m < 4; ++m) { const int r = rloc + ai * 128 + m * 16, row = u.arow + r; const bool valid = samp || (r >= 3 && row < MP); const float rr = rr8[ai][m];
                    if (valid) {
#pragma unroll
                    for (int bj = 0; bj < 2; ++bj) { const f32x4 v0 = acc[ai][bj][m][0] * rr, v1 = acc[ai][bj][m][1] * rr;
                        v4u w; w.x = cvtpk(silu_f(v0[0]), silu_f(v0[1])); w.y = cvtpk(silu_f(v0[2]), silu_f(v0[3])); w.z = cvtpk(silu_f(v1[0]), silu_f(v1[1])); w.w = cvtpk(silu_f(v1[2]), silu_f(v1[3]));
                        *(v4u*)(SZ + (size_t)row * DM + c0 + 32 * bj) = w; } } }
        } else if (samp) {
            const int c0 = (pn - 13) * 256 + ct;
#pragma unroll
            for (int ai = 0; ai < 2; ++ai)
#pragma unroll
                for (int m = 0; m < 4; ++m) { const int r = rloc + ai * 128 + m * 16, row = u.arow + r; const float rr = ssqx[u.idx * 256 + r];
                    const int rs = row - MP, b = rs >> 2, t = rs & 3; float* p = (t >= 1) ? out + O_CONVS + ((size_t)(layer * NBS + b) * 3 + (t - 1)) * XBCW + c0 : nullptr;
#pragma unroll
                    for (int bj = 0; bj < 2; ++bj) { const f32x4 v0 = acc[ai][bj][m][0] * rr, v1 = acc[ai][bj][m][1] * rr;
                        v4u w; w.x = cvtpk(v0[0], v0[1]); w.y = cvtpk(v0[2], v0[3]); w.z = cvtpk(v1[0], v1[1]); w.w = cvtpk(v1[2], v1[3]);
                        *(v4u*)(XBC + (size_t)row * XBCW + c0 + 32 * bj) = w;
                        if (p) { *(f32x4*)(p + 32 * bj) = v0; *(f32x4*)(p + 32 * bj + 4) = v1; } } }
        } else {
            const int c0 = (pn - 13) * 256 + ct;
            if (fr >= 13) {
#pragma unroll
                for (int ai = 0; ai < 2; ++ai)
#pragma unroll
                    for (int bj = 0; bj < 2; ++bj)
#pragma unroll
                        for (int n = 0; n < 2; ++n) *(LAS f32x4*)(exch + ((((wr * 4 + wc) * 2 + ai) * 3 + (fr - 13)) * 64 + fq * 16 + bj * 8 + n * 4)) = acc[ai][bj][3][n] * ssqx[u.idx * 256 + rloc + 128 * ai + 48];
            }
            { const int tid_ = (wr * 4 + wc) * 64 + fq * 16 + fr;
                if (tid_ < 320) { const int q = tid_ >> 6, c4 = tid_ & 63; const float* src = (q < 4 ? cw + q * XBCW : cb) + (pn - 13) * 256 + 4 * c4;
                    *(LAS f32x4*)(wtab + q * 256 + 4 * c4) = *(const f32x4*)src; } }
            asm volatile("s_waitcnt vmcnt(0) lgkmcnt(0)" ::: "memory"); __builtin_amdgcn_s_barrier(); asm volatile("" ::: "memory");
#pragma unroll
            for (int bj = 0; bj < 2; ++bj) { v2u keep[2][4];
                xpass<0>(acc, u, wr, wc, fr, fq, rloc, c0 + 32 * bj, bj, keep);
                xpass<1>(acc, u, wr, wc, fr, fq, rloc, c0 + 32 * bj, bj, keep); }
        }
    }
    template <int n> __device__ __forceinline__ void xpass(const f32x4 (&acc)[2][2][4][2], const pg8::Unit& u, int wr, int wc, int fr, int fq, const int rloc, const int ch8, const int bj, v2u (&keep)[2][4]) const {
        const int ch = ch8 + 4 * n;
        f32x4 w[4], bb; const int tl = ch & 255;
#pragma unroll
        for (int tp = 0; tp < 4; ++tp) w[tp] = *(const LAS f32x4*)(wtab + tp * 256 + tl);
        bb = *(const LAS f32x4*)(wtab + 4 * 256 + tl);
#pragma unroll
        for (int ai = 0; ai < 2; ++ai) {
            const int blk = 2 * ai + wr;
            f32x4 b13 = (f32x4){0.f, 0.f, 0.f, 0.f}, b14 = b13, b15 = b13;
            if (blk > 0) { const int sa = (blk - 1) >> 1, sw = (blk - 1) & 1; const LAS float* s = exch + (((sw * 4 + wc) * 2 + sa) * 3) * 64 + fq * 16 + bj * 8 + n * 4;
                b13 = *(const LAS f32x4*)(s); b14 = *(const LAS f32x4*)(s + 64); b15 = *(const LAS f32x4*)(s + 128); }
            f32x4 px = b15;
#pragma unroll
            for (int m = 0; m < 4; ++m) {
                const float rrm = ssqx[u.idx * 256 + rloc + 128 * ai + 16 * m];
                const int r = rloc + 128 * ai + 16 * m; int grow = u.arow + r; asm volatile("" : "+v"(grow));
                const int t = grow & 4095; const bool valid = (r >= 3) && (grow < MP);
                const f32x4 x0 = acc[ai][bj][m][n] * rrm; f32x4 x1, x2, x3;
#pragma unroll
                for (int i = 0; i < 4; ++i) { const float a1 = m ? dpp_ror1(px[i]) : b15[i], a2 = m ? dpp_ror2(px[i]) : ((fr == 0) ? b14[i] : b15[i]), a3 = m ? dpp_ror3(px[i]) : ((fr == 0) ? b13[i] : ((fr == 1) ? b14[i] : b15[i]));
                    x1[i] = dpp_shr1(a1, x0[i]); x2[i] = dpp_shr2(a2, x0[i]); x3[i] = dpp_shr3(a3, x0[i]); }
                px = x0;
                if (t < 3) { x3 = (f32x4){0.f, 0.f, 0.f, 0.f}; if (t < 2) { x2 = x3; if (t < 1) x1 = x3; } }
                if (n == 0) keep[ai][m] = (v2u){0u, 0u};
                if (valid) { if (t >= SEQ - 3) *(f32x4*)(out + O_CONVP + ((size_t)(layer * NBP + (grow >> 12)) * 3 + (t - (SEQ - 3))) * XBCW + ch) = x0;
                    const f32x4 y = bb + w[0] * x3 + w[1] * x2 + w[2] * x1 + w[3] * x0;
                    v2u o; o.x = cvtpk(silu_f(y[0]), silu_f(y[1])); o.y = cvtpk(silu_f(y[2]), silu_f(y[3]));
                    if (n == 0) keep[ai][m] = o;
                    else { v4u o4; o4.x = keep[ai][m].x; o4.y = keep[ai][m].y; o4.z = o.x; o4.w = o.y; *(v4u*)(XBCC + (size_t)grow * XBCW + ch8) = o4; } }
            }
        }
    }
    __device__ __forceinline__ void hook(f32x4 (&)[2][2][4][2], const pg8::Unit&, int, int, int, int) const {}
};

struct EpiOutProj {
    static constexpr bool PERM = true, AFTER_DRAIN = false, INIT_ACC = true, KSCALE = true; static constexpr int HOOK_T = -1;
    const LAS float* rstd; const LAS float* ftab; bf16* xb; float* ssqx;
    __device__ __forceinline__ void init(f32x4 (&acc)[2][2][4][2], const pg8::Unit& u, int wr, int wc, int fr, int fq) const {
        const int rbase = u.pm * 256 + wr * 64 + fr, col0 = u.pn * 256 + wc * 32 + 8 * fq;
#pragma unroll
        for (int ai = 0; ai < 2; ++ai)
#pragma unroll
            for (int m = 0; m < 4; ++m) { const int row = rbase + ai * 128 + m * 16; const bf16* bp = xb + (size_t)row * DM; const float sc = 1.f / rstd[wr * 64 + fr + 128 * ai + 16 * m];
#pragma unroll
                for (int bj = 0; bj < 2; ++bj) { const v4u w = *(const v4u*)(bp + col0 + 128 * bj);
                    acc[ai][bj][m][0] = (f32x4){bflo(w.x), bfhi(w.x), bflo(w.y), bfhi(w.y)} * sc; acc[ai][bj][m][1] = (f32x4){bflo(w.z), bfhi(w.z), bflo(w.w), bfhi(w.w)} * sc; } }
    }
    __device__ __forceinline__ void kscale(f32x4 (&acc)[2][2][4][2], const pg8::Unit&, const int ai, const int k, int wr, int wc, int fr, int fq) const {
        if (k >= 16 && k < 28) { const LAS float* f = ftab + (k - 16) * 256 + wr * 64 + fr + 128 * ai;
#pragma unroll
            for (int m = 0; m < 4; ++m) { const float s = f[16 * m];
#pragma unroll
                for (int bj = 0; bj < 2; ++bj)
#pragma unroll
                    for (int n = 0; n < 2; ++n) acc[ai][bj][m][n] = acc[ai][bj][m][n] * s; } }
    }
    __device__ __forceinline__ void operator()(const f32x4 (&acc)[2][2][4][2], const pg8::Unit& u, int wr, int wc, int fr, int fq) const {
        const int rbase = u.pm * 256 + wr * 64 + fr, col0 = u.pn * 256 + wc * 32 + 8 * fq;
#pragma unroll
        for (int ai = 0; ai < 2; ++ai)
#pragma unroll
            for (int m = 0; m < 4; ++m) { const int row = rbase + ai * 128 + m * 16; const float fin = ftab[12 * 256 + wr * 64 + fr + 128 * ai + 16 * m];
                float ss = 0.f;
#pragma unroll
                for (int bj = 0; bj < 2; ++bj) { const int c = col0 + 128 * bj;
                    const f32x4 o0 = acc[ai][bj][m][0] * fin, o1 = acc[ai][bj][m][1] * fin;
                    ss += ((o0[0] * o0[0] + o0[1] * o0[1]) + (o0[2] * o0[2] + o0[3] * o0[3])) + ((o1[0] * o1[0] + o1[1] * o1[1]) + (o1[2] * o1[2] + o1[3] * o1[3]));
                    v4u w; w.x = cvtpk(o0[0], o0[1]); w.y = cvtpk(o0[2], o0[3]); w.z = cvtpk(o1[0], o1[1]); w.w = cvtpk(o1[2], o1[3]);
                    *(v4u*)(xb + (size_t)row * DM + c) = w; }
                ss += __shfl_xor(ss, 16); ss += __shfl_xor(ss, 32);
                if (fq == 0) ssqx[(size_t)row * 16 + 4 * u.pn + wc] = ss; }
    }
    __device__ __forceinline__ void hook(f32x4 (&)[2][2][4][2], const pg8::Unit&, int, int, int, int) const {}
};
template <class Sched> __device__ __forceinline__ void prefill_outproj(LAS float* rstd, LAS float* ftab, const Sched& S, const float* ssqp, const float* lse, int tid) {
    pg8::Unit u;
    if (S.next(0, u) && tid < 256) { const size_t row = (size_t)u.arow + tid;
        const float rs = rstd16(ssqp + row * 16); rstd[tid] = rs;
        const f32x4* lp = (const f32x4*)(lse + row * 12); const f32x4 l0 = lp[0], l1 = lp[1], l2 = lp[2];
        float al[12];
#pragma unroll
        for (int s = 0; s < 4; ++s) { const float a = l0[s], b = l1[s], c = l2[s], mx = fmaxf(a, fmaxf(b, c)); const float e0 = __expf(a - mx), e1 = __expf(b - mx), e2 = __expf(c - mx), inv = 1.f / (e0 + e1 + e2);
            al[s] = fmaxf(e0 * inv, 1e-30f); al[4 + s] = fmaxf(e1 * inv, 1e-30f); al[8 + s] = fmaxf(e2 * inv, 1e-30f); }
        ftab[tid] = rs / al[0];
#pragma unroll
        for (int h = 1; h < 12; ++h) ftab[h * 256 + tid] = al[h - 1] / al[h];
        ftab[12 * 256 + tid] = al[11]; }
    __syncthreads();
}

struct Args { const float* in[24]; float* out; unsigned char* ws; int ph_lo, ph_hi; };
struct Frame {
    LAS unsigned char* lds;
    volatile LAS unsigned* MISC;
    gu32* ctl;
    int tid, lane, wave, vcu, G;
    const Args* a;
};
enum { I_XP = 0, I_XS, I_KV0, I_KV1, I_KV2, I_SSM, I_CONV, I_FFNC, I_NMIX, I_WIN, I_QN, I_KN, I_CW, I_CB, I_DTB, I_ALOG, I_DSKIP, I_SNORM, I_WOUT, I_NFFN, I_WUP, I_FCW, I_FCB, I_WDN };

struct P0Item { const float* W; int ldw, sk0, sn0; bf16* WT; int ldk, dk0, dn0; const float* kscale; };
__device__ __forceinline__ void p0_decode(Frame& F, int it, P0Item& I) {
    constexpr int I_IN = 16 * (NIN / 32), I_OUT = 28 * (DM / 32), I_UP = 16 * (FF2 / 32), I_DN = 44 * (DM / 32), PER_L = I_IN + I_OUT + I_UP + I_DN;
    const int L = it / PER_L; int r = it % PER_L;
    if (r < I_IN) { const int nb = r % (NIN / 32), kb = r / (NIN / 32), n0 = nb * 32, pn = n0 >> 8, rr = n0 & 255, bj = rr >> 7, wc = (rr & 127) >> 5;
        I = P0Item{F.a->in[I_WIN] + (size_t)L * DM * INW, INW, kb * 64, 256 * pn + 64 * wc + 32 * bj, ((bf16*)(F.a->ws + WS_WIN)) + (size_t)L * NIN * DM, DM, kb * 64, n0, F.a->in[I_NMIX] + L * DM + kb * 64}; return; }
    r -= I_IN;
    if (r < I_OUT) { const int nb = r % (DM / 32), kb = r / (DM / 32), dk0 = kb * 64, sk0 = dk0 < 1024 ? 768 + dk0 : dk0 - 1024;
        I = P0Item{F.a->in[I_WOUT] + (size_t)L * MIXW * DM, DM, sk0, nb * 32, ((bf16*)(F.a->ws + WS_WOUT)) + (size_t)L * DM * MIXW, MIXW, dk0, nb * 32, dk0 < 1024 ? F.a->in[I_SNORM] + L * DM + dk0 : nullptr}; return; }
    r -= I_OUT;
    if (r < I_UP) { const int nb = r % (FF2 / 32), kb = r / (FF2 / 32), n0 = nb * 32, pn = n0 >> 8, rr = n0 & 255, bj = rr >> 7, r2 = rr & 127;
        I = P0Item{F.a->in[I_WUP] + (size_t)L * DM * FF2, FF2, kb * 64, bj * FF + 128 * pn + r2, ((bf16*)(F.a->ws + WS_WUP)) + (size_t)L * FF2 * DM, DM, kb * 64, n0, F.a->in[I_NFFN] + L * DM + kb * 64}; return; }
    r -= I_UP;
    { const int nb = r % (DM / 32), kb = r / (DM / 32);
        I = P0Item{F.a->in[I_WDN] + (size_t)L * FF * DM, DM, kb * 64, nb * 32, ((bf16*)(F.a->ws + WS_WDN)) + (size_t)L * DM * FF, FF, kb * 64, nb * 32, nullptr}; }
}
__device__ __forceinline__ void p0_load(const P0Item& I, f32x4 (&v)[8], int lane) {
    const int c4 = lane & 7, kr = lane >> 3;
#pragma unroll
    for (int i = 0; i < 8; ++i) v[i] = __builtin_nontemporal_load((const f32x4*)(I.W + (size_t)(I.sk0 + 8 * i + kr) * I.ldw + I.sn0 + 4 * c4));
}
__device__ __forceinline__ void p0_store(const P0Item& I, const f32x4 (&v)[8], LAS float* scr, int lane) {
    constexpr int TP = 36;
    const int c4 = lane & 7, kr = lane >> 3;
#pragma unroll
    for (int i = 0; i < 8; ++i) { const int k = 8 * i + kr; f32x4 x = v[i]; if (I.kscale) x = x * I.kscale[k];
        *(LAS f32x4*)(scr + k * TP + 4 * (c4 ^ i)) = x; }
    LDS_WAIT(); asm volatile("" ::: "memory");
    const int kc = lane & 7, nr = lane >> 3;
#pragma unroll
    for (int j = 0; j < 4; ++j) { const int n = nr + 8 * j; const LAS float* s = scr + (8 * kc) * TP + (n ^ (kc << 2));
        v4u o; o.x = cvtpk(s[0 * TP], s[1 * TP]); o.y = cvtpk(s[2 * TP], s[3 * TP]); o.z = cvtpk(s[4 * TP], s[5 * TP]); o.w = cvtpk(s[6 * TP], s[7 * TP]);
        *(GAS v4u*)(I.WT + (size_t)(I.dn0 + n) * I.ldk + I.dk0 + 8 * kc) = o; }
    LDS_WAIT(); asm volatile("" ::: "memory");
}
__device__ __forceinline__ void p0_prologue(Frame& F) {
    LAS float* scr = (LAS float*)(F.lds + RING_OFF + F.wave * 16384);
    const int gwv = F.vcu * NWAVES + F.wave, NGW = F.G * NWAVES;
    constexpr int NIT = 2 * (16 * (NIN / 32) + 28 * (DM / 32) + 16 * (FF2 / 32) + 44 * (DM / 32));
    P0Item cur, nxt; f32x4 va[8], vb[8];
    int it = gwv; if (it >= NIT) return;
    p0_decode(F, it, cur); p0_load(cur, va, F.lane);
#pragma unroll 1
    for (;;) {
        const int i1 = it + NGW; const bool h1 = i1 < NIT;
        if (h1) { p0_decode(F, i1, nxt); p0_load(nxt, vb, F.lane); }
        p0_store(cur, va, scr, F.lane);
        if (!h1) break;
        const int i2 = i1 + NGW; const bool h2 = i2 < NIT;
        if (h2) { p0_decode(F, i2, cur); p0_load(cur, va, F.lane); }
        p0_store(nxt, vb, scr, F.lane);
        if (!h2) break;
        it = i2;
    }
}

__device__ __forceinline__ void p0_prep(Frame& F) {
    const int gt = F.vcu * NWAVES * 64 + F.tid, nthr = F.G * NWAVES * 64;
    for (int i = gt; i < 2 * 16 * DM; i += nthr) { const int L = i >> 14, j = (i >> 10) & 15, k = i & 1023;
        ((bf16*)(F.a->ws + WS_WDT))[i] = (bf16)f2bf(F.a->in[I_WIN][((size_t)L * DM + k) * INW + NIN + j] * F.a->in[I_NMIX][L * DM + k]); }
    const int gwv = F.vcu * NWAVES + F.wave, NGW = F.G * NWAVES, lane = F.lane;
    for (int row0 = gwv; row0 < MT; row0 += 4 * NGW) {
        f32x4 v[4][4];
#pragma unroll
        for (int k = 0; k < 4; ++k) { const int row = row0 + k * NGW; const int rc = row < MT ? row : 0;
            const float* xr = rc < MP ? F.a->in[I_XP] + (size_t)rc * DM : F.a->in[I_XS] + (size_t)(rc - MP) * DM;
#pragma unroll
            for (int j = 0; j < 4; ++j) v[k][j] = __builtin_nontemporal_load((const f32x4*)(xr + 4 * lane + 256 * j)); }
#pragma unroll
        for (int k = 0; k < 4; ++k) { const int row = row0 + k * NGW; if (row >= MT) break;
#pragma unroll
            for (int j = 0; j < 4; ++j) { const f32x4 x = v[k][j];
                float s = (x[0] * x[0] + x[1] * x[1]) + (x[2] * x[2] + x[3] * x[3]);
                s = red16(s);
                v2u o; o.x = cvtpk(x[0], x[1]); o.y = cvtpk(x[2], x[3]);
                *(v2u*)(((bf16*)(F.a->ws + WS_XN)) + (size_t)row * DM + 4 * lane + 256 * j) = o;
                if ((lane & 15) == 0) ((float*)(F.a->ws + WS_SSQX))[(size_t)row * 16 + 4 * j + (lane >> 4)] = s; } }
    }
}
__device__ __forceinline__ void dt_phase(Frame& F, int L) {
    const int gwv = F.vcu * NWAVES + F.wave, NGW = F.G * NWAVES, lane = F.lane, fr = lane & 15, fq = lane >> 4;
    const bf16* W = ((const bf16*)(F.a->ws + WS_WDT)) + (size_t)L * 16 * DM + (size_t)fr * DM + 8 * fq;
    const f32x4 bias = *(const f32x4*)(F.a->in[I_DTB] + L * 16 + 4 * fq);
    for (int blk = gwv; blk < MT / 16; blk += NGW) {
        const bf16* X = ((const bf16*)(F.a->ws + WS_XN)) + (size_t)(16 * blk + fr) * DM + 8 * fq;
        f32x4 acc = (f32x4){0.f, 0.f, 0.f, 0.f};
#pragma unroll 16
        for (int s = 0; s < 32; ++s) acc = mfma16(*(const bf16x8*)(W + 32 * s), *(const bf16x8*)(X + 32 * s), acc);
        const size_t row = (size_t)16 * blk + fr; const float rr = rstd16(((const float*)(F.a->ws + WS_SSQX)) + row * 16);
        f32x4 o; o[0] = softplus_f(acc[0] * rr + bias[0]); o[1] = softplus_f(acc[1] * rr + bias[1]); o[2] = softplus_f(acc[2] * rr + bias[2]); o[3] = softplus_f(acc[3] * rr + bias[3]);
        *(f32x4*)(((float*)(F.a->ws + WS_DT)) + row * 16 + 4 * fq) = o;
    }
}

constexpr int AT_PITCH = 144, AT_K = 0, AT_V = 256 * AT_PITCH, AT_BYTES = AT_V + 272 * AT_PITCH;
struct AttnRegs { v4u kr[4], vr[4]; bf16x8 q[2]; };
__device__ __forceinline__ void attn_prompt_load(Frame& F, int v, AttnRegs& R, int tid) {
    const int b = v / 384, hd = (v / 32) % 12, blk = v & 31;
    const int g = hd >> 2, d = 1 << (2 * g), nb = 32 >> (2 * g), r = blk / nb, n = blk % nb;
    const int lane = tid & 63, w = tid >> 6, fr = lane & 15, fq = lane >> 4;
    const bf16* KBp = (const bf16*)(F.a->ws + WS_KB); const bf16* VBp = (const bf16*)(F.a->ws + WS_VB); const bf16* QBp = (const bf16*)(F.a->ws + WS_QB);
#pragma unroll
    for (int i = 0; i < 4; ++i) { const int c = tid + 512 * i, j = c >> 3, ch = c & 7; const int np = n - 1 + (j >> 7);
        R.kr[i] = (v4u){0u, 0u, 0u, 0u}; R.vr[i] = (v4u){0u, 0u, 0u, 0u};
        if (np >= 0) { const size_t row = (size_t)b * SEQ + (size_t)(np * 128 + (j & 127)) * d + r; R.kr[i] = *(const v4u*)(KBp + row * NQ + hd * 64 + ch * 8); R.vr[i] = *(const v4u*)(VBp + row * NQ + hd * 64 + ch * 8); } }
    const int iq = 16 * w + fr; const size_t qrow = (size_t)b * SEQ + (size_t)(n * 128 + iq) * d + r;
#pragma unroll
    for (int ks = 0; ks < 2; ++ks) R.q[ks] = *(const bf16x8*)(QBp + qrow * NQ + hd * 64 + 32 * ks + 8 * fq);
}
constexpr int SA_B = 8;
struct SaTask { f32x4 q, o; float m, l, slope2; const float* cache; int t, dil, Lc, nnew, jb, g, hs; size_t row; bool on, pend; f32x4 kk[SA_B], vv[SA_B]; };
__device__ __forceinline__ void sa_begin(Frame& F, int L, int v, bool on, SaTask& T) {
    T.on = on; T.pend = false; T.jb = 0; if (!on) return;
    const int b = v / 12, g = (v >> 2) % 3, t = v & 3, lane = F.lane;
    T.g = g; T.t = t; T.dil = 1 << (2 * g); T.Lc = 128 << (2 * g); T.hs = lane >> 4; T.row = (size_t)MP + b * TS + t;
    const float* const ck0 = F.a->in[I_KV0]; const float* const ck1 = F.a->in[I_KV1]; const float* const ck2 = F.a->in[I_KV2];
    T.cache = (g == 0 ? ck0 : (g == 1 ? ck1 : ck2)) + ((size_t)(L * NBS + b) * T.Lc) * 512;
    T.slope2 = exp2f(-8.f * (float)(4 * g + T.hs + 1) / 12.f) * LOG2E * (float)T.dil;
    const bf16* QBp = (const bf16*)(F.a->ws + WS_QB); const bf16* KBp = (const bf16*)(F.a->ws + WS_KB); const bf16* VBp = (const bf16*)(F.a->ws + WS_VB);
    { const v2u w = *(const v2u*)(QBp + T.row * NQ + 256 * g + 4 * lane); T.q = (f32x4){bflo(w.x), bfhi(w.x), bflo(w.y), bfhi(w.y)}; }
    T.m = -1e30f; T.l = 0.f; T.o = (f32x4){0.f, 0.f, 0.f, 0.f};
    T.nnew = (g == 0) ? t + 1 : 1;
    v2u kw[4], vw[4];
#pragma unroll
    for (int j = 0; j < 4; ++j) { const size_t kr = (size_t)MP + b * TS + (j < T.nnew ? t - j : t); kw[j] = *(const v2u*)(KBp + kr * NQ + 256 * g + 4 * lane); vw[j] = *(const v2u*)(VBp + kr * NQ + 256 * g + 4 * lane); }
#pragma unroll
    for (int j = 0; j < 4; ++j) { float sc = (T.q[0] * bflo(kw[j].x) + T.q[1] * bfhi(kw[j].x)) + (T.q[2] * bflo(kw[j].y) + T.q[3] * bfhi(kw[j].y));
        sc = red16(sc);
        sc = (j < T.nnew) ? sc - T.slope2 * (float)j : -1e30f;
        const float mn = fmaxf(T.m, sc), scale = exp2f(T.m - mn), p = exp2f(sc - mn);
        T.l = T.l * scale + p; T.o = T.o * scale + (f32x4){bflo(vw[j].x), bfhi(vw[j].x), bflo(vw[j].y), bfhi(vw[j].y)} * p; T.m = mn; }
}
__device__ __forceinline__ void sa_issue(Frame& F, SaTask& T) {
    const int lane = F.lane;
#pragma unroll
    for (int u = 0; u < SA_B; ++u) { const int j = T.jb + u + T.nnew; int cr = T.Lc + T.t - j * T.dil; cr = cr < 0 ? 0 : cr;
        const float* p = T.cache + (size_t)cr * 512 + 4 * lane; T.kk[u] = __builtin_nontemporal_load((const f32x4*)p); T.vv[u] = __builtin_nontemporal_load((const f32x4*)(p + 256)); }
    T.pend = true;
}
__device__ __forceinline__ void sa_consume(SaTask& T) {
    float sc[SA_B]; float mb = -1e30f;
#pragma unroll
    for (int u = 0; u < SA_B; ++u) { const int j = T.jb + u + T.nnew; float x = (T.q[0] * T.kk[u][0] + T.q[1] * T.kk[u][1]) + (T.q[2] * T.kk[u][2] + T.q[3] * T.kk[u][3]);
        x = red16(x);
        x = (j <= 128) ? x - T.slope2 * (float)j : -1e30f; sc[u] = x; mb = fmaxf(mb, x); }
    const float mn = fmaxf(T.m, mb), scale = exp2f(T.m - mn); T.l *= scale; T.o = T.o * scale;
#pragma unroll
    for (int u = 0; u < SA_B; ++u) { const float p = exp2f(sc[u] - mn); T.l += p; T.o = T.o + T.vv[u] * p; }
    T.m = mn; T.jb += SA_B; T.pend = false;
}
__device__ __forceinline__ void sa_step(Frame& F, SaTask& T) { if (T.on) { if (T.pend) sa_consume(T); if (T.jb < 128) sa_issue(F, T); } }
__device__ __forceinline__ void sa_finish(Frame& F, SaTask& T) {
    if (!T.on) return;
#pragma unroll 1
    while (T.pend || T.jb < 128) { if (T.pend) sa_consume(T); if (T.jb < 128) sa_issue(F, T); }
    const int lane = F.lane; const float inv = 1.f / T.l;
    v2u ow; ow.x = cvtpk(T.o[0] * inv, T.o[1] * inv); ow.y = cvtpk(T.o[2] * inv, T.o[3] * inv);
    *(v2u*)(((bf16*)(F.a->ws + WS_ATTO)) + T.row * NQ + 256 * T.g + 4 * lane) = ow;
    if ((lane & 15) == 0) ((float*)(F.a->ws + WS_LSE))[T.row * 12 + 4 * T.g + T.hs] = (T.m + log2f(T.l)) * LN2;
}
__device__ __forceinline__ void attn_prompt_units(Frame& F, int first, int stride, int total, SaTask& T) {
    LAS char* Ks = (LAS char*)(F.lds + RING_OFF + AT_K); LAS char* Vs = (LAS char*)(F.lds + RING_OFF + AT_V);
    const int tid = F.tid, lane = F.lane, w = F.wave, fr = lane & 15, fq = lane >> 4;
    if (first >= total) return;
    if (tid < 128) { const int j = 256 + (tid >> 3), ch = tid & 7; *(LAS v4u*)(Vs + j * AT_PITCH + ch * 16) = (v4u){0u, 0u, 0u, 0u}; }
    AttnRegs R; attn_prompt_load(F, first, R, tid);
#pragma unroll 1
    for (int v = first; v < total; v += stride) {
        const int b = v / 384, hd = (v / 32) % 12, blk = v & 31;
        const int g = hd >> 2, d = 1 << (2 * g), nb = 32 >> (2 * g), r = blk / nb, n = blk % nb;
#pragma unroll
        for (int i = 0; i < 4; ++i) { const int c = tid + 512 * i, j = c >> 3, ch = c & 7; *(LAS v4u*)(Ks + j * AT_PITCH + ch * 16) = R.kr[i]; *(LAS v4u*)(Vs + j * AT_PITCH + ch * 16) = R.vr[i]; }
        bf16x8 qf[2]; qf[0] = R.q[0]; qf[1] = R.q[1];
        __syncthreads();
        if (v + stride < total) { int tl = tid; asm volatile("" : "+v"(tl)); attn_prompt_load(F, v + stride, R, tl); }
        sa_step(F, T);
        const int iq = 16 * w + fr; const size_t qrow = (size_t)b * SEQ + (size_t)(n * 128 + iq) * d + r;
        const float slope2 = exp2f(-8.f * (float)(hd + 1) / 12.f) * LOG2E * (float)d;
        int ibase = fr - 4 * fq + 128; asm volatile("" : "+v"(ibase));
        const float sb = slope2 * (float)ibase; const int dead = (n == 0) ? 8 - w : 0;
        float mx = -1e30f;
#pragma unroll
        for (int tt = 0; tt < 9; ++tt) { f32x4 a;
#pragma unroll
            for (int e = 0; e < 4; ++e) a[e] = fmaf(slope2, (float)(16 * tt + e), tt < dead ? -1e30f : -sb);
#pragma unroll
            for (int ks = 0; ks < 2; ++ks) { const bf16x8 kf = *(const LAS bf16x8*)(Ks + (16 * (w + tt) + fr) * AT_PITCH + (32 * ks + 8 * fq) * 2); a = mfma16(kf, qf[ks], a); }
            if (tt == 0 || tt == 8) {
#pragma unroll
                for (int e = 0; e < 4; ++e) { const bool valid = (unsigned)(ibase - (16 * tt + e)) <= 128u; mx = fmaxf(mx, valid ? a[e] : -1e30f); } }
            else {
#pragma unroll
                for (int e = 0; e < 4; ++e) mx = fmaxf(mx, a[e]); } }
        mx = fmaxf(mx, __shfl_xor(mx, 16)); mx = fmaxf(mx, __shfl_xor(mx, 32));
        const float sm = sb + mx;
        float l = 0.f; f32x4 o[4];
#pragma unroll
        for (int dt = 0; dt < 4; ++dt) o[dt] = (f32x4){0.f, 0.f, 0.f, 0.f};
#pragma unroll
        for (int s5 = 0; s5 < 5; ++s5) {
            f32x4 pp[2];
#pragma unroll
            for (int u = 0; u < 2; ++u) { const int tt = 2 * s5 + u; f32x4 a = (f32x4){0.f, 0.f, 0.f, 0.f};
                if (tt < 9) {
#pragma unroll
                    for (int e = 0; e < 4; ++e) a[e] = fmaf(slope2, (float)(16 * tt + e), tt < dead ? -1e30f : -sm);
#pragma unroll
                    for (int ks = 0; ks < 2; ++ks) { const bf16x8 kf = *(const LAS bf16x8*)(Ks + (16 * (w + tt) + fr) * AT_PITCH + (32 * ks + 8 * fq) * 2); a = mfma16(kf, qf[ks], a); }
                    if (tt == 0 || tt == 8) {
#pragma unroll
                        for (int e = 0; e < 4; ++e) { const bool valid = (unsigned)(ibase - (16 * tt + e)) <= 128u; const float p = valid ? exp2f(a[e]) : 0.f; a[e] = p; l += p; } }
                    else {
#pragma unroll
                        for (int e = 0; e < 4; ++e) { const float p = exp2f(a[e]); a[e] = p; l += p; } } }
                pp[u] = a; }
            bf16x8 pf; { v4u t; t.x = cvtpk(pp[0][0], pp[0][1]); t.y = cvtpk(pp[0][2], pp[0][3]); t.z = cvtpk(pp[1][0], pp[1][1]); t.w = cvtpk(pp[1][2], pp[1][3]); pf = __builtin_bit_cast(bf16x8, t); }
            const int k0 = 16 * (w + 2 * s5) + 4 * fq + ((lane & 15) >> 2);
#pragma unroll
            for (int dt = 0; dt < 4; ++dt) { const LAS char* p0 = Vs + k0 * AT_PITCH + (16 * dt + 4 * (lane & 3)) * 2; o[dt] = mfma16(tr2(p0, p0 + 16 * AT_PITCH), pf, o[dt]); }
        }
        l += __shfl_xor(l, 16); l += __shfl_xor(l, 32);
        const float inv = 1.f / l;
#pragma unroll
        for (int dt = 0; dt < 4; ++dt) { v2u t; t.x = cvtpk(o[dt][0] * inv, o[dt][1] * inv); t.y = cvtpk(o[dt][2] * inv, o[dt][3] * inv); *(v2u*)(((bf16*)(F.a->ws + WS_MIX)) + qrow * MIXW + 1024 + hd * 64 + 16 * dt + 4 * fq) = t; }
        if (fq == 0) ((float*)(F.a->ws + WS_LSE))[qrow * 12 + hd] = (mx + log2f(l)) * LN2;
        sa_step(F, T);
        __syncthreads();
    }
}

__device__ __forceinline__ void attn_sample_task(Frame& F, int L, int b, int g, int t) {
    const int lane = F.lane, dil = 1 << (2 * g), Lc = 128 << (2 * g), hs = lane >> 4;
    const size_t row = (size_t)MP + b * TS + t;
    const float* const ck0 = F.a->in[I_KV0]; const float* const ck1 = F.a->in[I_KV1]; const float* const ck2 = F.a->in[I_KV2];
    const float* cache = (g == 0 ? ck0 : (g == 1 ? ck1 : ck2)) + ((size_t)(L * NBS + b) * Lc) * 512;
    const float slope2 = exp2f(-8.f * (float)(4 * g + hs + 1) / 12.f) * LOG2E * (float)dil;
    f32x4 q; { const v2u w = *(const v2u*)(((bf16*)(F.a->ws + WS_QB)) + row * NQ + 256 * g + 4 * lane); q = (f32x4){bflo(w.x), bfhi(w.x), bflo(w.y), bfhi(w.y)}; }
    float m = -1e30f, l = 0.f; f32x4 o = (f32x4){0.f, 0.f, 0.f, 0.f};
    const int nnew = (g == 0) ? t + 1 : 1;
    for (int j = 0; j < nnew; ++j) { const size_t kr = (size_t)MP + b * TS + (t - j);
        const v2u kw = *(const v2u*)(((bf16*)(F.a->ws + WS_KB)) + kr * NQ + 256 * g + 4 * lane), vw = *(const v2u*)(((bf16*)(F.a->ws + WS_VB)) + kr * NQ + 256 * g + 4 * lane);
        float sc = (q[0] * bflo(kw.x) + q[1] * bfhi(kw.x)) + (q[2] * bflo(kw.y) + q[3] * bfhi(kw.y));
        sc = red16(sc);
        sc -= slope2 * (float)j;
        const float mn = fmaxf(m, sc), scale = exp2f(m - mn), p = exp2f(sc - mn);
        l = l * scale + p; o = o * scale + (f32x4){bflo(vw.x), bfhi(vw.x), bflo(vw.y), bfhi(vw.y)} * p; m = mn; }
#define SA_LOAD(kk, vv, jb) do { _Pragma("unroll") for (int u = 0; u < 8; ++u) { const int j = (jb) + u + nnew; int cr = Lc + t - j * dil; cr = cr < 0 ? 0 : cr; \
        const float* p = cache + (size_t)cr * 512 + 4 * lane; kk[u] = __builtin_nontemporal_load((const f32x4*)p); vv[u] = __builtin_nontemporal_load((const f32x4*)(p + 256)); } } while (0)
#define SA_COMP(kk, vv, jb) do { float sc[8]; float mb = -1e30f; \
        _Pragma("unroll") for (int u = 0; u < 8; ++u) { const int j = (jb) + u + nnew; float x = (q[0] * kk[u][0] + q[1] * kk[u][1]) + (q[2] * kk[u][2] + q[3] * kk[u][3]); \
            x = red16(x); \
            x = (j <= 128) ? x - slope2 * (float)j : -1e30f; sc[u] = x; mb = fmaxf(mb, x); } \
        const float mn = fmaxf(m, mb), scale = exp2f(m - mn); l *= scale; o = o * scale; \
        _Pragma("unroll") for (int u = 0; u < 8; ++u) { const float p = exp2f(sc[u] - mn); l += p; o = o + vv[u] * p; } \
        m = mn; } while (0)
    { f32x4 kA[8], vA[8], kB[8], vB[8];
        SA_LOAD(kA, vA, 0);
#pragma unroll 1
        for (int jb = 0; jb < 128; jb += 16) {
            SA_LOAD(kB, vB, jb + 8);
            SA_COMP(kA, vA, jb);
            if (jb + 16 < 128) SA_LOAD(kA, vA, jb + 16);
            SA_COMP(kB, vB, jb + 8);
        } }
#undef SA_LOAD
#undef SA_COMP
    const float inv = 1.f / l;
    v2u ow; ow.x = cvtpk(o[0] * inv, o[1] * inv); ow.y = cvtpk(o[2] * inv, o[3] * inv);
    *(v2u*)(((bf16*)(F.a->ws + WS_ATTO)) + row * NQ + 256 * g + 4 * lane) = ow;
    if ((lane & 15) == 0) ((float*)(F.a->ws + WS_LSE))[row * 12 + 4 * g + hs] = (m + log2f(l)) * LN2;
}

template <int NR> __device__ __forceinline__ void alpha_rows(Frame& F, int row0, int rstride) {
    const int lane = F.lane; const float* LSEp = (const float*)(F.a->ws + WS_LSE); const bf16* AO = (const bf16*)(F.a->ws + WS_ATTO); bf16* MX = (bf16*)(F.a->ws + WS_MIX);
    float al[NR][2]; v4u x[NR][2];
#pragma unroll
    for (int k = 0; k < NR; ++k) { const int row = row0 + k * rstride; const bool rv = row < MT; const float* ls = LSEp + (size_t)(rv ? row : 0) * 12;
#pragma unroll
        for (int rep = 0; rep < 2; ++rep) { const int c = lane + 64 * rep, cc = c < 96 ? c : 0, hd = cc >> 3, slot = hd & 3; const float l0 = ls[slot], l1 = ls[4 + slot], l2 = ls[8 + slot], mx = fmaxf(l0, fmaxf(l1, l2));
            const float e0 = __expf(l0 - mx), e1 = __expf(l1 - mx), e2 = __expf(l2 - mx); al[k][rep] = (hd < 4 ? e0 : (hd < 8 ? e1 : e2)) / (e0 + e1 + e2);
            x[k][rep] = *(const v4u*)(AO + (size_t)(rv ? row : 0) * NQ + 8 * cc); } }
#pragma unroll
    for (int k = 0; k < NR; ++k) { const int row = row0 + k * rstride;
#pragma unroll
        for (int rep = 0; rep < 2; ++rep) { const int c = lane + 64 * rep; const float a_ = al[k][rep]; const v4u v = x[k][rep]; v4u y;
            y.x = cvtpk(bflo(v.x) * a_, bfhi(v.x) * a_); y.y = cvtpk(bflo(v.y) * a_, bfhi(v.y) * a_); y.z = cvtpk(bflo(v.z) * a_, bfhi(v.z) * a_); y.w = cvtpk(bflo(v.w) * a_, bfhi(v.w) * a_);
            if (c < 96 && row < MT) *(v4u*)(MX + (size_t)row * MIXW + 1024 + 8 * c) = y; } }
}

constexpr int S1_BP = 272, S1_XP = 528, S1_B = 0, S1_X = 128 * S1_BP, S1_W = S1_X + 128 * S1_XP, S1_BYTES = S1_W + 8 * 128 * 4;
static_assert(S1_BYTES <= RING_BYTES, "ssd1 lds");
__device__ __forceinline__ void ssd1_ld(const bf16* XBC, size_t row0, int dj, bool ok, int ch0, float (&x)[8]) {
    v4u v = (v4u){0u, 0u, 0u, 0u}; if (ok) v = *(const v4u*)(XBC + (size_t)((long)row0 + dj) * XBCW + ch0);
    x[0] = bflo(v.x); x[1] = bfhi(v.x); x[2] = bflo(v.y); x[3] = bfhi(v.y); x[4] = bflo(v.z); x[5] = bfhi(v.z); x[6] = bflo(v.w); x[7] = bfhi(v.w);
}
__device__ __forceinline__ void ssd1_conv_item(Frame& F, int L, int b, int c, int ch0, int j0, int mode  , int lcol  , int hh  ) {
    const float* cw = F.a->in[I_CW] + (size_t)L * 4 * XBCW + ch0; const float* cb = F.a->in[I_CB] + (size_t)L * XBCW + ch0;
    float w[4][8], bias[8];
#pragma unroll
    for (int tp = 0; tp < 4; ++tp) { const f32x4 a = *(const f32x4*)(cw + tp * XBCW), bq = *(const f32x4*)(cw + tp * XBCW + 4);
        w[tp][0] = a[0]; w[tp][1] = a[1]; w[tp][2] = a[2]; w[tp][3] = a[3]; w[tp][4] = bq[0]; w[tp][5] = bq[1]; w[tp][6] = bq[2]; w[tp][7] = bq[3]; }
    { const f32x4 a = *(const f32x4*)cb, bq = *(const f32x4*)(cb + 4); bias[0] = a[0]; bias[1] = a[1]; bias[2] = a[2]; bias[3] = a[3]; bias[4] = bq[0]; bias[5] = bq[1]; bias[6] = bq[2]; bias[7] = bq[3]; }
    const size_t row0 = (size_t)b * SEQ + c * 128 + j0;
    float x3[8], x2[8], x1[8], x0[8];
    ssd1_ld(((bf16*)(F.a->ws + WS_XBC)), row0, -3, c > 0 || j0 - 3 >= 0, ch0, x3); ssd1_ld(((bf16*)(F.a->ws + WS_XBC)), row0, -2, c > 0 || j0 - 2 >= 0, ch0, x2); ssd1_ld(((bf16*)(F.a->ws + WS_XBC)), row0, -1, c > 0 || j0 - 1 >= 0, ch0, x1);
    LAS char* Bs = (LAS char*)(F.lds + RING_OFF + S1_B); LAS char* Xs = (LAS char*)(F.lds + RING_OFF + S1_X); const LAS float* Ws = (const LAS float*)(F.lds + RING_OFF + S1_W);
#pragma unroll 8
    for (int j = 0; j < 16; ++j) {
        ssd1_ld(((bf16*)(F.a->ws + WS_XBC)), row0, j, true, ch0, x0); float y[8];
#pragma unroll
        for (int e = 0; e < 8; ++e) y[e] = silu_f(bias[e] + w[0][e] * x3[e] + w[1][e] * x2[e] + w[2][e] * x1[e] + w[3][e] * x0[e]);
        v4u o; o.x = cvtpk(y[0], y[1]); o.y = cvtpk(y[2], y[3]); o.z = cvtpk(y[4], y[5]); o.w = cvtpk(y[6], y[7]);
        *(v4u*)(((bf16*)(F.a->ws + WS_XBCC)) + (row0 + j) * XBCW + ch0) = o;
        if (mode == 0) *(LAS v4u*)(Bs + (j0 + j) * S1_BP + lcol * 2) = o;
        else if (mode == 2) { const float wt = Ws[hh * 128 + j0 + j]; v4u q; q.x = cvtpk(y[0] * wt, y[1] * wt); q.y = cvtpk(y[2] * wt, y[3] * wt); q.z = cvtpk(y[4] * wt, y[5] * wt); q.w = cvtpk(y[6] * wt, y[7] * wt);
            *(LAS v4u*)(Xs + (j0 + j) * S1_XP + lcol * 2) = q; }
#pragma unroll
        for (int e = 0; e < 8; ++e) { x3[e] = x2[e]; x2[e] = x1[e]; x1[e] = x0[e]; }
    }
}
__device__ __forceinline__ void ssd1_unit(Frame& F, int L, int b, int c, int g) {
    const int tid = F.tid, lane = F.lane, w = F.wave, fr = lane & 15, fq = lane >> 4;
    LAS char* Bs = (LAS char*)(F.lds + RING_OFF + S1_B); LAS char* Xs = (LAS char*)(F.lds + RING_OFF + S1_X); LAS float* Ws = (LAS float*)(F.lds + RING_OFF + S1_W);
    const size_t row0 = (size_t)b * SEQ + c * 128;
    const bf16* XC = (const bf16*)(F.a->ws + WS_XBCC);
    v4u braw[4], xraw[8];
#pragma unroll
    for (int i = 0; i < 4; ++i) { const int q = tid + 512 * i, r = q >> 4, ch = q & 15; braw[i] = *(const v4u*)(XC + (row0 + r) * XBCW + 1024 + 128 * g + ch * 8); }
#pragma unroll
    for (int i = 0; i < 8; ++i) { const int q = tid + 512 * i, r = q >> 5, ch = q & 31; xraw[i] = *(const v4u*)(XC + (row0 + r) * XBCW + 512 * g + ch * 8); }
    { const int h = 8 * g + w; const float a = -__expf(F.a->in[I_ALOG][L * 16 + h]);
        const float d0 = ((float*)(F.a->ws + WS_DT))[(row0 + 2 * lane) * 16 + h], d1 = ((float*)(F.a->ws + WS_DT))[(row0 + 2 * lane + 1) * 16 + h];
        const float x0 = d0 * a, x1 = d1 * a; float sc = x0 + x1;
#pragma unroll
        for (int o = 1; o < 64; o <<= 1) { const float t = __shfl_up(sc, o); if (lane >= o) sc += t; }
        const float ac1 = sc, ac0 = sc - x1, tot = __shfl(sc, 63);
        ((float*)(F.a->ws + WS_ACUM))[(row0 + 2 * lane) * 16 + h] = ac0; ((float*)(F.a->ws + WS_ACUM))[(row0 + 2 * lane + 1) * 16 + h] = ac1;
        Ws[w * 128 + 2 * lane] = d0 * __expf(tot - ac0); Ws[w * 128 + 2 * lane + 1] = d1 * __expf(tot - ac1);
        if (lane == 0) ((float*)(F.a->ws + WS_CDEC))[(b * NCH + c) * 16 + h] = __expf(tot); }
#pragma unroll
    for (int i = 0; i < 4; ++i) { const int q = tid + 512 * i, r = q >> 4, ch = q & 15; *(LAS v4u*)(Bs + r * S1_BP + ch * 16) = braw[i]; }
    __syncthreads();
#pragma unroll 1
    for (int pass = 0; pass < 2; ++pass) {
#pragma unroll
        for (int i = 0; i < 8; ++i) { const int q = tid + 512 * i, r = q >> 5, ch = q & 31; const v4u v = xraw[i]; const float wt = Ws[(4 * pass + (ch >> 3)) * 128 + r];
            v4u o; o.x = cvtpk(bflo(v.x) * wt, bfhi(v.x) * wt); o.y = cvtpk(bflo(v.y) * wt, bfhi(v.y) * wt); o.z = cvtpk(bflo(v.z) * wt, bfhi(v.z) * wt); o.w = cvtpk(bflo(v.w) * wt, bfhi(v.w) * wt);
            *(LAS v4u*)(Xs + r * S1_XP + ch * 16) = o; }
        __syncthreads();
        if (pass == 0) {
#pragma unroll
            for (int i = 0; i < 8; ++i) { const int q = tid + 512 * i, r = q >> 5, ch = q & 31; xraw[i] = *(const v4u*)(XC + (row0 + r) * XBCW + 512 * g + 256 + ch * 8); } }
        { const int hh4 = w >> 1, nh = w & 1, h = 8 * g + 4 * pass + hh4;
            f32x4 acc[4][4];
#pragma unroll
            for (int pt = 0; pt < 4; ++pt)
#pragma unroll
                for (int nt = 0; nt < 4; ++nt) acc[pt][nt] = (f32x4){0.f, 0.f, 0.f, 0.f};
#pragma unroll
            for (int ks = 0; ks < 4; ++ks) { const int tok = 32 * ks + 8 * fq + ((lane & 15) >> 2);
                bf16x8 af[4], bfr[4];
#pragma unroll
                for (int nt = 0; nt < 4; ++nt) { const LAS char* p = Bs + tok * S1_BP + (64 * nh + 16 * nt + 4 * (lane & 3)) * 2; af[nt] = tr2(p, p + 4 * S1_BP); }
#pragma unroll
                for (int pt = 0; pt < 4; ++pt) { const LAS char* p = Xs + tok * S1_XP + (64 * hh4 + 16 * pt + 4 * (lane & 3)) * 2; bfr[pt] = tr2(p, p + 4 * S1_XP); }
#pragma unroll
                for (int pt = 0; pt < 4; ++pt)
#pragma unroll
                    for (int nt = 0; nt < 4; ++nt) acc[pt][nt] = mfma16(af[nt], bfr[pt], acc[pt][nt]); }
            bf16* sp = ((bf16*)(F.a->ws + WS_ST)) + ((size_t)(b * NCH + c) * 16 + h) * 8192;
#pragma unroll
            for (int pt = 0; pt < 4; ++pt)
#pragma unroll
                for (int pr = 0; pr < 2; ++pr) { v2u e0, e1; e0.x = cvtpk(acc[pt][2 * pr][0], acc[pt][2 * pr][1]); e0.y = cvtpk(acc[pt][2 * pr][2], acc[pt][2 * pr][3]);
                    e1.x = cvtpk(acc[pt][2 * pr + 1][0], acc[pt][2 * pr + 1][1]); e1.y = cvtpk(acc[pt][2 * pr + 1][2], acc[pt][2 * pr + 1][3]);
                    store_pair16(sp + (16 * pt + fr) * 128 + 64 * nh, e0, e1, pr, fq); } }
        __syncthreads();
    }
}

__device__ __forceinline__ void ssd_scan_phase(Frame& F, int L) {
    const int nthr = F.G * NWAVES * 64;
    for (int idx = F.vcu * NWAVES * 64 + F.tid; idx < NBP * 16 * 2048; idx += nthr) {
        const int e4 = idx & 2047, bh = __builtin_amdgcn_readfirstlane(idx >> 11), b = bh >> 4, h = bh & 15;
        f32x4 h0 = (f32x4){0.f, 0.f, 0.f, 0.f};
        v2u s[NCH]; float dc[NCH];
#pragma unroll
        for (int u = 0; u < NCH; ++u) { const size_t o = ((size_t)(b * NCH + u) * 16 + h); s[u] = *(const v2u*)(((const bf16*)(F.a->ws + WS_ST)) + o * 8192 + 4 * e4); dc[u] = ((float*)(F.a->ws + WS_CDEC))[o]; }
        __builtin_amdgcn_sched_barrier(0);
#pragma unroll
        for (int u = 0; u < NCH; ++u) { const size_t o = ((size_t)(b * NCH + u) * 16 + h);
            v2u t; t.x = cvtpk(h0[0], h0[1]); t.y = cvtpk(h0[2], h0[3]); *(v2u*)(((bf16*)(F.a->ws + WS_HPV)) + o * 8192 + 4 * e4) = t;
            h0 = h0 * dc[u] + (f32x4){bflo(s[u].x), bfhi(s[u].x), bflo(s[u].y), bfhi(s[u].y)}; }
        float* op = F.a->out + O_SSMP + ((size_t)(L * NBP + b) * 16 + h) * 8192 + 4 * e4; *(f32x4*)op = h0;
    }
}

constexpr int S3_P = 272, S3_XP = 528, S3_C = 0, S3_CB = 128 * S3_P, S3_X = S3_CB + 128 * S3_P  , S3_BYTES = S3_X + 128 * S3_XP;
static_assert(S3_BYTES <= RING_BYTES && 128 * S3_P <= 128 * S3_XP, "ssd3 lds");
__device__ __forceinline__ void ssd3_unit(Frame& F, int L, int b, int c, int g) {
    int lane = F.lane; asm volatile("" : "+v"(lane));
    const int w = F.wave, tid = w * 64 + lane, fr = lane & 15, fq = lane >> 4;
    LAS char* Cs = (LAS char*)(F.lds + RING_OFF + S3_C); LAS char* Bs = (LAS char*)(F.lds + RING_OFF + S3_X); LAS char* CBs = (LAS char*)(F.lds + RING_OFF + S3_CB); LAS char* Xs = (LAS char*)(F.lds + RING_OFF + S3_X);
    LAS float* acS = (LAS float*)(F.lds + EXCH_OFF); LAS float* dtS = acS + 1024;
    const size_t row0 = (size_t)b * SEQ + c * 128;
    const bf16* XC = (const bf16*)(F.a->ws + WS_XBCC);
#pragma unroll
    for (int i = 0; i < 4; ++i) { const int q = tid + 512 * i, r = q >> 4, ch = q & 15;
        *(LAS v4u*)(Cs + r * S3_P + ch * 16) = *(const v4u*)(XC + (row0 + r) * XBCW + 1280 + 128 * g + ch * 8);
        *(LAS v4u*)(Bs + r * S3_P + ch * 16) = *(const v4u*)(XC + (row0 + r) * XBCW + 1024 + 128 * g + ch * 8); }
    v4u xr[8];
#pragma unroll
    for (int i = 0; i < 8; ++i) { const int q = tid + 512 * i, r = q >> 5, ch = q & 31; xr[i] = *(const v4u*)(XC + (row0 + r) * XBCW + (8 * g) * 64 + ch * 8); }
#pragma unroll
    for (int i = 0; i < 2; ++i) { const int q = tid + 512 * i, r = q >> 3, hh = q & 7; acS[hh * 128 + r] = ((float*)(F.a->ws + WS_ACUM))[(row0 + r) * 16 + 8 * g + hh]; dtS[hh * 128 + r] = ((float*)(F.a->ws + WS_DT))[(row0 + r) * 16 + 8 * g + hh]; }
    __syncthreads();
#pragma unroll
    for (int it = 0; it < 8; ++it) if (it >= w) { f32x4 a = (f32x4){0.f, 0.f, 0.f, 0.f};
#pragma unroll
        for (int ks = 0; ks < 4; ++ks) { const bf16x8 bf = *(const LAS bf16x8*)(Bs + (16 * w + fr) * S3_P + (32 * ks + 8 * fq) * 2), cf = *(const LAS bf16x8*)(Cs + (16 * it + fr) * S3_P + (32 * ks + 8 * fq) * 2);
            a = mfma16(bf, cf, a); }
        v2u t; t.x = cvtpk(a[0], a[1]); t.y = cvtpk(a[2], a[3]); *(LAS v2u*)(CBs + (16 * it + fr) * S3_P + (16 * w + 4 * fq) * 2) = t; }
    __syncthreads();
#pragma unroll 1
    for (int hp = 0; hp < 2; ++hp) {
        int tl = tid; asm volatile("" : "+v"(tl));
#pragma unroll
        for (int i = 0; i < 8; ++i) { const int q = tl + 512 * i, r = q >> 5, ch = q & 31; *(LAS v4u*)(Xs + r * S3_XP + ch * 16) = xr[i]; }
        __syncthreads();
        if (hp == 0) {
#pragma unroll
            for (int i = 0; i < 8; ++i) { const int q = tl + 512 * i, r = q >> 5, ch = q & 31; xr[i] = *(const v4u*)(XC + (row0 + r) * XBCW + (8 * g + 4) * 64 + ch * 8); } }
        { const int hh4 = w >> 1, ih = w & 1, hl = 4 * hp + hh4, h = 8 * g + hl;
            const bf16* hp_ = ((bf16*)(F.a->ws + WS_HPV)) + ((size_t)(b * NCH + c) * 16 + h) * 8192;
            bf16x8 hf[4][4];
#pragma unroll
            for (int ks = 0; ks < 4; ++ks)
#pragma unroll
                for (int pt = 0; pt < 4; ++pt) hf[ks][pt] = *(const bf16x8*)(hp_ + (16 * pt + fr) * 128 + 32 * ks + 8 * fq);
            const float dsk = F.a->in[I_DSKIP][L * 16 + h];
            const bf16* szp = ((const bf16*)(F.a->ws + WS_SZ)) + row0 * DM + h * 64 + 4 * fq;
            v2u zwn[4];
#pragma unroll
            for (int pt = 0; pt < 4; ++pt) zwn[pt] = *(const v2u*)(szp + (size_t)(16 * ih + fr) * DM + 16 * pt);
#pragma unroll 1
            for (int i2 = 0; i2 < 4; ++i2) { const int it = 2 * i2 + ((i2 & 1) ? 1 - ih : ih), il = 16 * it + fr;
                v2u zwc[4];
#pragma unroll
                for (int pt = 0; pt < 4; ++pt) zwc[pt] = zwn[pt];
                if (i2 < 3) { const int itn = 2 * (i2 + 1) + (((i2 + 1) & 1) ? 1 - ih : ih);
#pragma unroll
                    for (int pt = 0; pt < 4; ++pt) zwn[pt] = *(const v2u*)(szp + (size_t)(16 * itn + fr) * DM + 16 * pt); }
                const float ai = acS[hl * 128 + il];
                f32x4 y1[4], y2[4];
#pragma unroll
                for (int pt = 0; pt < 4; ++pt) { y1[pt] = (f32x4){0.f, 0.f, 0.f, 0.f}; y2[pt] = (f32x4){0.f, 0.f, 0.f, 0.f}; }
#pragma unroll
                for (int ks = 0; ks < 4; ++ks) if (2 * ks <= it) {
                    const v4u cbw = *(const LAS v4u*)(CBs + (16 * it + fr) * S3_P + (32 * ks + 8 * fq) * 2);
                    const int j0 = 32 * ks + 8 * fq;
                    const f32x4 a0 = *(const LAS f32x4*)(acS + hl * 128 + j0), a1 = *(const LAS f32x4*)(acS + hl * 128 + j0 + 4), d0 = *(const LAS f32x4*)(dtS + hl * 128 + j0), d1 = *(const LAS f32x4*)(dtS + hl * 128 + j0 + 4);
                    float gv[8]; gv[0] = bflo(cbw.x); gv[1] = bfhi(cbw.x); gv[2] = bflo(cbw.y); gv[3] = bfhi(cbw.y); gv[4] = bflo(cbw.z); gv[5] = bfhi(cbw.z); gv[6] = bflo(cbw.w); gv[7] = bfhi(cbw.w);
#pragma unroll
                    for (int e = 0; e < 8; ++e) { const float aj = e < 4 ? a0[e & 3] : a1[e & 3], dj = e < 4 ? d0[e & 3] : d1[e & 3];
                        const float ex = __expf(fminf(ai - aj, 0.f)) * dj * gv[e]; gv[e] = (j0 + e <= il) ? ex : 0.f; }
                    v4u gw; gw.x = cvtpk(gv[0], gv[1]); gw.y = cvtpk(gv[2], gv[3]); gw.z = cvtpk(gv[4], gv[5]); gw.w = cvtpk(gv[6], gv[7]);
                    const bf16x8 gf = __builtin_bit_cast(bf16x8, gw);
                    const int tok = 32 * ks + 8 * fq + ((lane & 15) >> 2);
#pragma unroll
                    for (int pt = 0; pt < 4; ++pt) { const LAS char* p = Xs + tok * S3_XP + (64 * hh4 + 16 * pt + 4 * (lane & 3)) * 2; y1[pt] = mfma16(tr2(p, p + 4 * S3_XP), gf, y1[pt]); }
                    asm volatile("" ::: "memory");
                }
#pragma unroll
                for (int ks = 0; ks < 4; ++ks) { const bf16x8 cf = *(const LAS bf16x8*)(Cs + (16 * it + fr) * S3_P + (32 * ks + 8 * fq) * 2);
#pragma unroll
                    for (int pt = 0; pt < 4; ++pt) y2[pt] = mfma16(hf[ks][pt], cf, y2[pt]); }
                const float ei = __expf(ai); const size_t row = row0 + il; float ss = 0.f;
#pragma unroll
                for (int pt = 0; pt < 4; ++pt) { const int col = 16 * pt + 4 * fq;
                    const v2u xw = *(const LAS v2u*)(Xs + il * S3_XP + (64 * hh4 + col) * 2), zw = zwc[pt];
                    const float x0 = bflo(xw.x), x1 = bfhi(xw.x), x2 = bflo(xw.y), x3 = bfhi(xw.y);
                    const float v0 = (y1[pt][0] + ei * y2[pt][0] + dsk * x0) * bflo(zw.x), v1 = (y1[pt][1] + ei * y2[pt][1] + dsk * x1) * bfhi(zw.x),
                                v2 = (y1[pt][2] + ei * y2[pt][2] + dsk * x2) * bflo(zw.y), v3 = (y1[pt][3] + ei * y2[pt][3] + dsk * x3) * bfhi(zw.y);
                    ss += (v0 * v0 + v1 * v1) + (v2 * v2 + v3 * v3);
                    v2u o; o.x = cvtpk(v0, v1); o.y = cvtpk(v2, v3); *(v2u*)(((bf16*)(F.a->ws + WS_MIX)) + row * MIXW + h * 64 + col) = o; }
                ss += __shfl_xor(ss, 16); ss += __shfl_xor(ss, 32);
                if (fq == 0) ((float*)(F.a->ws + WS_SSQP))[row * 16 + h] = ss; }
        }
        __syncthreads();
    }
}

__device__ __forceinline__ void ssd_sample_task(Frame& F, int L, int b, int h) {
    int lane = F.lane; asm volatile("" : "+v"(lane));
    const int g = h >> 3;
    LAS float* scr = (LAS float*)(F.lds + RING_OFF + F.wave * 8192);
    LAS float* xsS = scr; LAS float* BS = scr + 256; LAS float* CS = scr + 768; LAS float* yI = scr + 1280;
    const size_t row0 = (size_t)MP + b * TS;
    const int plo = lane >> 4, nc = lane & 15;
    const float* h0 = F.a->in[I_SSM] + ((size_t)(L * NBS + b) * 16 + h) * 8192; float* hout = F.a->out + O_SSMS + ((size_t)(L * NBS + b) * 16 + h) * 8192;
    f32x4 pha[8], phb[8];
#pragma unroll
    for (int k = 0; k < 8; ++k) { const int p = plo + 4 * k; pha[k] = __builtin_nontemporal_load((const f32x4*)(h0 + p * 128 + 8 * nc)); phb[k] = __builtin_nontemporal_load((const f32x4*)(h0 + p * 128 + 8 * nc + 4)); }
#pragma unroll
    for (int q = 0; q < 5; ++q) {
        const int ch = q == 0 ? h * 64 + lane : (q < 3 ? 1024 + 128 * g + lane + 64 * (q - 1) : 1280 + 128 * g + lane + 64 * (q - 3));
        const float* sc = F.a->in[I_CONV] + ((size_t)(L * NBS + b) * 3) * XBCW + ch;
        float x[7]; x[0] = sc[0]; x[1] = sc[XBCW]; x[2] = sc[2 * XBCW];
#pragma unroll
        for (int t = 0; t < 4; ++t) x[3 + t] = bf2f(((bf16*)(F.a->ws + WS_XBC))[(row0 + t) * XBCW + ch]);
        const float* cw = F.a->in[I_CW] + (size_t)L * 4 * XBCW + ch; const float w0 = cw[0], w1 = cw[XBCW], w2 = cw[2 * XBCW], w3 = cw[3 * XBCW], bb = F.a->in[I_CB][L * XBCW + ch];
#pragma unroll
        for (int t = 0; t < 4; ++t) { const float y = silu_f(bb + w0 * x[t] + w1 * x[t + 1] + w2 * x[t + 2] + w3 * x[t + 3]);
            if (q == 0) xsS[t * 64 + lane] = y; else if (q < 3) BS[t * 128 + lane + 64 * (q - 1)] = y; else CS[t * 128 + lane + 64 * (q - 3)] = y; }
    }
    const float a = -__expf(F.a->in[I_ALOG][L * 16 + h]), dsk = F.a->in[I_DSKIP][L * 16 + h];
    float dt[4], ac[4];
#pragma unroll
    for (int t = 0; t < 4; ++t) { dt[t] = ((float*)(F.a->ws + WS_DT))[(row0 + t) * 16 + h]; ac[t] = dt[t] * a + (t ? ac[t - 1] : 0.f); }
    LDS_WAIT(); asm volatile("" ::: "memory");
    float cb[4][4];
#pragma unroll
    for (int i = 0; i < 4; ++i)
#pragma unroll
        for (int j = 0; j < 4; ++j) cb[i][j] = 0.f;
#pragma unroll
    for (int i = 0; i < 4; ++i)
#pragma unroll
        for (int j = 0; j <= i; ++j) cb[i][j] = wave_sum(CS[i * 128 + lane] * BS[j * 128 + lane] + CS[i * 128 + lane + 64] * BS[j * 128 + lane + 64]);
    float Cv[4][8], Bv[4][8];
#pragma unroll
    for (int t = 0; t < 4; ++t)
#pragma unroll
        for (int e = 0; e < 8; ++e) { Cv[t][e] = CS[t * 128 + 8 * nc + e]; Bv[t][e] = BS[t * 128 + 8 * nc + e]; }
    const float dec = __expf(ac[3]); float wj[4];
#pragma unroll
    for (int j = 0; j < 4; ++j) wj[j] = dt[j] * __expf(ac[3] - ac[j]);
    unsigned short zq[4];
#pragma unroll
    for (int t = 0; t < 4; ++t) zq[t] = ((const unsigned short*)(F.a->ws + WS_SZ))[(row0 + t) * DM + h * 64 + lane];
#pragma unroll
    for (int k = 0; k < 16; ++k) { const int p = plo + 4 * k;
        const f32x4 ha = pha[k & 7], hb = phb[k & 7];
        float hv[8] = {ha[0], ha[1], ha[2], ha[3], hb[0], hb[1], hb[2], hb[3]};
        if (k < 8) { pha[k] = __builtin_nontemporal_load((const f32x4*)(h0 + (p + 32) * 128 + 8 * nc)); phb[k] = __builtin_nontemporal_load((const f32x4*)(h0 + (p + 32) * 128 + 8 * nc + 4)); }
        float it_[4];
#pragma unroll
        for (int t = 0; t < 4; ++t) { float s = 0.f;
#pragma unroll
            for (int e = 0; e < 8; ++e) s += Cv[t][e] * hv[e];
            s = red16(s); it_[t] = s; }
        float cj[4];
#pragma unroll
        for (int j = 0; j < 4; ++j) cj[j] = wj[j] * xsS[j * 64 + p];
#pragma unroll
        for (int e = 0; e < 8; ++e) hv[e] = hv[e] * dec + ((cj[0] * Bv[0][e] + cj[1] * Bv[1][e]) + (cj[2] * Bv[2][e] + cj[3] * Bv[3][e]));
        __builtin_nontemporal_store((f32x4){hv[0], hv[1], hv[2], hv[3]}, (f32x4*)(hout + p * 128 + 8 * nc)); __builtin_nontemporal_store((f32x4){hv[4], hv[5], hv[6], hv[7]}, (f32x4*)(hout + p * 128 + 8 * nc + 4));
        if (nc == 0) {
#pragma unroll
            for (int t = 0; t < 4; ++t) yI[t * 64 + p] = it_[t]; }
        asm volatile("" ::: "memory");
    }
    LDS_WAIT(); asm volatile("" ::: "memory");
#pragma unroll
    for (int i = 0; i < 4; ++i) { float y = __expf(ac[i]) * yI[i * 64 + lane] + dsk * xsS[i * 64 + lane];
#pragma unroll
        for (int j = 0; j <= i; ++j) y += cb[i][j] * __expf(ac[i] - ac[j]) * dt[j] * xsS[j * 64 + lane];
        y *= bf2f(zq[i]);
        ((bf16*)(F.a->ws + WS_MIX))[(row0 + i) * MIXW + h * 64 + lane] = (bf16)f2bf(y);
        const float ss = wave_sum(y * y);
        if (lane == 0) ((float*)(F.a->ws + WS_SSQP))[(row0 + i) * 16 + h] = ss; }
    LDS_WAIT(); asm volatile("" ::: "memory");
}

__device__ __forceinline__ void convgate_item(Frame& F, int L, const bf16* urow0  , int ntok, bool has_prev_rows  , const float* prev  , int ch0, bf16* grow0) {
    const int pn = ch0 >> 7, ucol = 256 * pn + (ch0 & 127);
    const float* fw = F.a->in[I_FCW] + (size_t)L * 3 * FF2; const float* fb = F.a->in[I_FCB] + (size_t)L * FF2;
    float wg[3][8], wu[3][8], bg[8], bu[8];
#pragma unroll
    for (int tp = 0; tp < 3; ++tp) { const f32x4 a = *(const f32x4*)(fw + tp * FF2 + ch0), b = *(const f32x4*)(fw + tp * FF2 + ch0 + 4), c = *(const f32x4*)(fw + tp * FF2 + FF + ch0), d = *(const f32x4*)(fw + tp * FF2 + FF + ch0 + 4);
        wg[tp][0] = a[0]; wg[tp][1] = a[1]; wg[tp][2] = a[2]; wg[tp][3] = a[3]; wg[tp][4] = b[0]; wg[tp][5] = b[1]; wg[tp][6] = b[2]; wg[tp][7] = b[3];
        wu[tp][0] = c[0]; wu[tp][1] = c[1]; wu[tp][2] = c[2]; wu[tp][3] = c[3]; wu[tp][4] = d[0]; wu[tp][5] = d[1]; wu[tp][6] = d[2]; wu[tp][7] = d[3]; }
    { const f32x4 a = *(const f32x4*)(fb + ch0), b = *(const f32x4*)(fb + ch0 + 4), c = *(const f32x4*)(fb + FF + ch0), d = *(const f32x4*)(fb + FF + ch0 + 4);
        bg[0] = a[0]; bg[1] = a[1]; bg[2] = a[2]; bg[3] = a[3]; bg[4] = b[0]; bg[5] = b[1]; bg[6] = b[2]; bg[7] = b[3]; bu[0] = c[0]; bu[1] = c[1]; bu[2] = c[2]; bu[3] = c[3]; bu[4] = d[0]; bu[5] = d[1]; bu[6] = d[2]; bu[7] = d[3]; }
    float g2[8], g1[8], g0[8], u2[8], u1[8], u0[8];
#pragma unroll
    for (int e = 0; e < 8; ++e) { g2[e] = 0.f; g1[e] = 0.f; u2[e] = 0.f; u1[e] = 0.f; }
    if (has_prev_rows) {
        const v4u a = *(const v4u*)(urow0 - 2 * FF2 + ucol), b = *(const v4u*)(urow0 - FF2 + ucol), c = *(const v4u*)(urow0 - 2 * FF2 + ucol + 128), d = *(const v4u*)(urow0 - FF2 + ucol + 128);
        g2[0] = bflo(a.x); g2[1] = bfhi(a.x); g2[2] = bflo(a.y); g2[3] = bfhi(a.y); g2[4] = bflo(a.z); g2[5] = bfhi(a.z); g2[6] = bflo(a.w); g2[7] = bfhi(a.w);
        g1[0] = bflo(b.x); g1[1] = bfhi(b.x); g1[2] = bflo(b.y); g1[3] = bfhi(b.y); g1[4] = bflo(b.z); g1[5] = bfhi(b.z); g1[6] = bflo(b.w); g1[7] = bfhi(b.w);
        u2[0] = bflo(c.x); u2[1] = bfhi(c.x); u2[2] = bflo(c.y); u2[3] = bfhi(c.y); u2[4] = bflo(c.z); u2[5] = bfhi(c.z); u2[6] = bflo(c.w); u2[7] = bfhi(c.w);
        u1[0] = bflo(d.x); u1[1] = bfhi(d.x); u1[2] = bflo(d.y); u1[3] = bfhi(d.y); u1[4] = bflo(d.z); u1[5] = bfhi(d.z); u1[6] = bflo(d.w); u1[7] = bfhi(d.w);
    } else if (prev) {
#pragma unroll
        for (int e = 0; e < 8; ++e) { g2[e] = prev[ch0 + e]; g1[e] = prev[FF2 + ch0 + e]; u2[e] = prev[FF + ch0 + e]; u1[e] = prev[FF2 + FF + ch0 + e]; }
    }
#pragma unroll 4
    for (int t = 0; t < ntok; ++t) {
        const v4u a = *(const v4u*)(urow0 + (size_t)t * FF2 + ucol), c = *(const v4u*)(urow0 + (size_t)t * FF2 + ucol + 128);
        g0[0] = bflo(a.x); g0[1] = bfhi(a.x); g0[2] = bflo(a.y); g0[3] = bfhi(a.y); g0[4] = bflo(a.z); g0[5] = bfhi(a.z); g0[6] = bflo(a.w); g0[7] = bfhi(a.w);
        u0[0] = bflo(c.x); u0[1] = bfhi(c.x); u0[2] = bflo(c.y); u0[3] = bfhi(c.y); u0[4] = bflo(c.z); u0[5] = bfhi(c.z); u0[6] = bflo(c.w); u0[7] = bfhi(c.w);
        float r[8];
#pragma unroll
        for (int e = 0; e < 8; ++e) { const float gt = bg[e] + wg[0][e] * g2[e] + wg[1][e] * g1[e] + wg[2][e] * g0[e], up = bu[e] + wu[0][e] * u2[e] + wu[1][e] * u1[e] + wu[2][e] * u0[e];
            r[e] = silu_f(gt) * up; g2[e] = g1[e]; g1[e] = g0[e]; u2[e] = u1[e]; u1[e] = u0[e]; }
        v4u o; o.x = cvtpk(r[0], r[1]); o.y = cvtpk(r[2], r[3]); o.z = cvtpk(r[4], r[5]); o.w = cvtpk(r[6], r[7]);
        *(v4u*)(grow0 + (size_t)t * FF + ch0) = o;
    }
}
__device__ __forceinline__ void convgate_phase(Frame& F, int L) {
    const int nthr = F.G * NWAVES * 64, gt = F.vcu * NWAVES * 64 + F.tid;
    constexpr int NCG = FF / 8, NP = (MP / 16) * NCG, NS = NBS * NCG;
    for (int it = gt; it < NP + NS; it += nthr) {
        if (it < NP) { const int cg = it % NCG, rb = it / NCG; const size_t row = (size_t)rb * 16;
            convgate_item(F, L, ((bf16*)(F.a->ws + WS_U)) + row * FF2, 16, (row & 4095) != 0, nullptr, cg * 8, ((bf16*)(F.a->ws + WS_G)) + row * FF);
        } else { const int q = it - NP, cg = q % NCG, b = q / NCG; const size_t row = (size_t)MP + b * TS;
            convgate_item(F, L, ((bf16*)(F.a->ws + WS_U)) + row * FF2, 4, false, F.a->in[I_FFNC] + (size_t)(L * NBS + b) * 2 * FF2, cg * 8, ((bf16*)(F.a->ws + WS_G)) + row * FF); }
    }
}

template <bool HOOK> __device__ __forceinline__ void sample_gemm(Frame& F, const bf16* A, const bf16* Bt, const int K, const float* base, float* outp, const float* ssqp, bf16* xb, float* ssqx) {
    const int lane = F.lane, w = F.wave, fr = lane & 15, fq = lane >> 4, nsteps = K / 32;
    LAS float* slab = (LAS float*)(F.lds + RING_OFF) + w * (HOOK ? 4096 : 2048);
    for (int tile = F.vcu; tile < 256; tile += F.G) {
        const int rb = tile >> 4, cb = tile & 15;
        f32x4 acc0[2][4], acc1[2][4];
#pragma unroll
        for (int mt = 0; mt < 2; ++mt)
#pragma unroll
            for (int nt = 0; nt < 4; ++nt) { acc0[mt][nt] = (f32x4){0.f, 0.f, 0.f, 0.f}; acc1[mt][nt] = (f32x4){0.f, 0.f, 0.f, 0.f}; }
        const bf16* ap = A + (size_t)(MP + 32 * rb + fr) * K + 8 * fq; const bf16* bp = Bt + (size_t)(64 * cb + fr) * K + 8 * fq;
        const int idx_ = F.tid * 4, m_ = idx_ >> 6, n_ = idx_ & 63; const size_t row_ = (size_t)MP + 32 * rb + m_;
        const v2u o_bw = *(const v2u*)(xb + row_ * DM + 64 * cb + n_); const f32x4 o_base = (f32x4){bflo(o_bw.x), bfhi(o_bw.x), bflo(o_bw.y), bfhi(o_bw.y)};
        f32x4 sq4[4]; if (HOOK) { const f32x4* sp = (const f32x4*)(ssqp + row_ * 16); sq4[0] = sp[0]; sq4[1] = sp[1]; sq4[2] = sp[2]; sq4[3] = sp[3]; }
#pragma unroll 8
        for (int s = w; s < nsteps; s += 8) {
            bf16x8 af[2], bf[4];
#pragma unroll
            for (int mt = 0; mt < 2; ++mt) af[mt] = *(const bf16x8*)(ap + (size_t)(16 * mt) * K + 32 * s);
#pragma unroll
            for (int nt = 0; nt < 4; ++nt) bf[nt] = *(const bf16x8*)(bp + (size_t)(16 * nt) * K + 32 * s);
            if (HOOK && s >= 32) {
#pragma unroll
                for (int mt = 0; mt < 2; ++mt)
#pragma unroll
                    for (int nt = 0; nt < 4; ++nt) acc1[mt][nt] = mfma16(bf[nt], af[mt], acc1[mt][nt]);
            } else {
#pragma unroll
                for (int mt = 0; mt < 2; ++mt)
#pragma unroll
                    for (int nt = 0; nt < 4; ++nt) acc0[mt][nt] = mfma16(bf[nt], af[mt], acc0[mt][nt]);
            }
        }
#pragma unroll
        for (int mt = 0; mt < 2; ++mt)
#pragma unroll
            for (int nt = 0; nt < 4; ++nt) { *(LAS f32x4*)(slab + (16 * mt + fr) * 64 + 16 * nt + 4 * fq) = acc0[mt][nt]; if (HOOK) *(LAS f32x4*)(slab + 2048 + (16 * mt + fr) * 64 + 16 * nt + 4 * fq) = acc1[mt][nt]; }
        __syncthreads();
        { const int idx = F.tid * 4, m = idx >> 6, n = idx & 63; const size_t row = (size_t)MP + 32 * rb + m;
            const LAS float* r0 = (const LAS float*)(F.lds + RING_OFF) + idx;
            f32x4 s0 = (f32x4){0.f, 0.f, 0.f, 0.f}, s1 = (f32x4){0.f, 0.f, 0.f, 0.f};
#pragma unroll
            for (int ww = 0; ww < 8; ++ww) { s0 = s0 + *(const LAS f32x4*)(r0 + ww * (HOOK ? 4096 : 2048)); if (HOOK) s1 = s1 + *(const LAS f32x4*)(r0 + ww * 4096 + 2048); }
            f32x4 o = o_base;
            if (HOOK) { const f32x4 a = sq4[0], b = sq4[1], c = sq4[2], d = sq4[3];
                const float sq = ((a[0] + a[1]) + (a[2] + a[3])) + ((b[0] + b[1]) + (b[2] + b[3])) + ((c[0] + c[1]) + (c[2] + c[3])) + ((d[0] + d[1]) + (d[2] + d[3]));
                o = o + s0 * rsqrtf(sq * (1.f / 1024.f) + EPS) + s1; }
            else o = o + s0;
            if (outp) *(f32x4*)(outp + row * DM + 64 * cb + n) = o;
            if (ssqx) { v2u xw; xw.x = cvtpk(o[0], o[1]); xw.y = cvtpk(o[2], o[3]); *(v2u*)(xb + row * DM + 64 * cb + n) = xw;
                float ss = (o[0] * o[0] + o[1] * o[1]) + (o[2] * o[2] + o[3] * o[3]);
                ss = red16(ss);
                if ((lane & 15) == 0) ssqx[row * 16 + cb] = ss; } }
        __syncthreads();
    }
}

#ifndef PH_MASK
#define PH_MASK 0xFFFFu
#endif
#ifndef SUB_MASK
#define SUB_MASK 0xFu
#endif
#define SUBK(k) (((SUB_MASK) >> (k)) & 1u)
#ifndef SUBREP_MASK
#define SUBREP_MASK 0u
#endif
#define RPT(k) for (int rp_ = 0; rp_ <= (int)(((SUBREP_MASK) >> (k)) & 1u); ++rp_)
#define PHK(k) (((PH_MASK) >> (k)) & 1u)
#ifndef REP_MASK
#define REP_MASK 0u
#endif
#define REPK(k) ((int)(((REP_MASK) >> (k)) & 1u))
constexpr int N_PHASES = 21;
#if MK_ONE_LAUNCH
#define GRID_BAR() xcd_barrier(bar)
#else
#define GRID_BAR() do { if (F.tid == 0) __hip_atomic_store(F.ctl + CW_TMO, 0xBADBA0u, RLX_AGENT); } while (0)
#endif
#define IN(k) (lo <= (k) && (k) < hi)
#define SEAM(k) do { if (IN(k) && IN((k) + 1)) GRID_BAR(); } while (0)
#define gw (F.vcu * NWAVES + F.wave)
template <int L> __device__ __forceinline__ void layer_body(Frame& F, const XcdBarrier& bar, const int lo, const int hi) {
    const int NGW = F.G * NWAVES;
        const int pb = 1 + 10 * L;
#define RELAUNDER() do { int l_; asm volatile("v_mbcnt_lo_u32_b32 %0, -1, 0\n\tv_mbcnt_hi_u32_b32 %0, -1, %0" : "=v"(l_)); F.lane = l_; F.tid = F.wave * 64 + l_; } while (0)
        const float* xP = L == 0 ? F.a->in[I_XP] : ((float*)(F.a->ws + WS_X2)); const float* xS = L == 0 ? F.a->in[I_XS] : ((float*)(F.a->ws + WS_X2)) + (size_t)MP * DM;
        float* xout = L == 0 ? +((float*)(F.a->ws + WS_X2)) : +F.a->out;
        RELAUNDER();
        RELAUNDER();
        if (PHK(2) && IN(pb + 1)) { for (int rep_ = 0; rep_ <= REPK(2); ++rep_) { if (rep_) GRID_BAR();
            pg8::Gemm g{((bf16*)(F.a->ws + WS_XN)), ((bf16*)(F.a->ws + WS_WIN)) + (size_t)L * NIN * DM, 67 * 256, NIN, DM}; InOrder S; S.init(F.G, (int)blockIdx.x);
            EpiInProj3 E{((bf16*)(F.a->ws + WS_QB)), ((bf16*)(F.a->ws + WS_KB)), ((bf16*)(F.a->ws + WS_VB)), ((bf16*)(F.a->ws + WS_SZ)), ((bf16*)(F.a->ws + WS_XBCC)), ((bf16*)(F.a->ws + WS_XBC)), F.a->in[I_QN] + L * 64, F.a->in[I_KN] + L * 64, F.a->out, L, (const LAS float*)(F.lds + RSTD_OFF),
                         (LAS float*)(F.lds + EXCH_OFF), F.a->in[I_CW] + (size_t)L * 4 * XBCW, F.a->in[I_CB] + (size_t)L * XBCW, F.a->in[I_CONV] + (size_t)L * NBS * 3 * XBCW, (LAS float*)(F.lds + WTAB_OFF)};
            prefill_rstd((LAS float*)(F.lds + RSTD_OFF), S, ((const float*)(F.a->ws + WS_SSQX)), F.tid);
            pg8::gemm_phase<EpiInProj3, InOrder, true, true>(F.lds + RING_OFF, g, S, E, F.tid);
            RELAUNDER(); dt_phase(F, L);
            } SEAM(pb + 1);
        }
        RELAUNDER();
        if (PHK(3) && IN(pb + 2)) { for (int rep_ = 0; rep_ <= REPK(3); ++rep_) { if (rep_) GRID_BAR();
            if (SUBK(0)) RPT(0) for (int u = F.vcu; u < 256; u += F.G) ssd1_unit(F, L, u >> 6, (u >> 1) & 31, u & 1);
            RELAUNDER();
            { SaTask T; const int v0 = F.vcu * 6 + F.wave; sa_begin(F, L, v0, SUBK(3) && F.wave < 6 && v0 < 1536, T);
                if (SUBK(1)) RPT(1) attn_prompt_units(F, F.vcu % F.G, F.G, 1536, T);
                sa_finish(F, T);
                if (SUBK(3) && F.wave < 6) for (int v = v0 + F.G * 6; v < 1536; v += F.G * 6) attn_sample_task(F, L, v / 12, (v >> 2) % 3, v & 3); }
            RELAUNDER();
            } SEAM(pb + 2);
        }
        RELAUNDER();
        if (PHK(4) && IN(pb + 3)) { for (int rep_ = 0; rep_ <= REPK(4); ++rep_) { if (rep_) GRID_BAR(); ssd_scan_phase(F, L); } SEAM(pb + 3); }
        RELAUNDER();
        if (PHK(5) && IN(pb + 4)) { for (int rep_ = 0; rep_ <= REPK(5); ++rep_) { if (rep_) GRID_BAR();
#pragma unroll 1
            for (int ps = 0; ps < 2; ++ps) {
                if ((ps == 0) == ((F.vcu & 1) != 0)) { RPT(2) for (int t = gw; t < 2048; t += NGW) ssd_sample_task(F, L, t >> 4, t & 15); __syncthreads(); }
                else { RPT(4) for (int u = F.vcu; u < 256; u += F.G) ssd3_unit(F, L, u >> 6, (u >> 1) & 31, u & 1);
                       RPT(5) for (int row = MP + gw; row < MT; row += 4 * NGW) alpha_rows<4>(F, row, NGW); }
                RELAUNDER();
            }
            } SEAM(pb + 4);
        }
        RELAUNDER();
        if (PHK(6) && IN(pb + 5)) { {
            pg8::Gemm g{((bf16*)(F.a->ws + WS_MIX)), ((bf16*)(F.a->ws + WS_WOUT)) + (size_t)L * DM * MIXW, MP, DM, MIXW}; pg8::StaticOrder S; S.init(MP, DM, F.G, (int)blockIdx.x);
            EpiOutProj E{(const LAS float*)(F.lds + RSTD_OFF), (const LAS float*)(F.lds + EXCH_OFF), ((bf16*)(F.a->ws + WS_XN)), ((float*)(F.a->ws + WS_SSQX))};
            prefill_outproj((LAS float*)(F.lds + RSTD_OFF), (LAS float*)(F.lds + EXCH_OFF), S, ((const float*)(F.a->ws + WS_SSQP)), ((const float*)(F.a->ws + WS_LSE)), F.tid);
            pg8::gemm_phase<EpiOutProj, pg8::StaticOrder, true, true>(F.lds + RING_OFF, g, S, E, F.tid);
            }
            { RELAUNDER(); sample_gemm<true>(F, ((bf16*)(F.a->ws + WS_MIX)), ((bf16*)(F.a->ws + WS_WOUT)) + (size_t)L * DM * MIXW, MIXW, nullptr, nullptr, ((float*)(F.a->ws + WS_SSQP)), ((bf16*)(F.a->ws + WS_XN)), ((float*)(F.a->ws + WS_SSQX))); }
            SEAM(pb + 5);
        }
        RELAUNDER();
        RELAUNDER();
        if (PHK(8) && IN(pb + 7)) { for (int rep_ = 0; rep_ <= REPK(8); ++rep_) { if (rep_) GRID_BAR();
            pg8::Gemm g{((bf16*)(F.a->ws + WS_XN)), ((bf16*)(F.a->ws + WS_WUP)) + (size_t)L * FF2 * DM, 67 * 256, FF2, DM}; UpOrder S; S.init(F.G, (int)blockIdx.x);
            EpiUpConv E{((bf16*)(F.a->ws + WS_G)), F.a->out, L, (const LAS float*)(F.lds + RSTD_OFF), (LAS float*)(F.lds + EXCH_OFF), F.a->in[I_FCW] + (size_t)L * 3 * FF2, F.a->in[I_FCB] + (size_t)L * FF2, F.a->in[I_FFNC] + (size_t)L * NBS * 2 * FF2, (LAS float*)(F.lds + WTAB_OFF)};
            prefill_rstd((LAS float*)(F.lds + RSTD_OFF), S, ((const float*)(F.a->ws + WS_SSQX)), F.tid);
            pg8::gemm_phase<EpiUpConv, UpOrder, true, true>(F.lds + RING_OFF, g, S, E, F.tid);
            } SEAM(pb + 7);
        }
        RELAUNDER();
        RELAUNDER();
        if (PHK(10) && IN(pb + 9)) { {
            pg8::Gemm g{((bf16*)(F.a->ws + WS_G)), ((bf16*)(F.a->ws + WS_WDN)) + (size_t)L * DM * FF, MP, DM, FF}; pg8::StaticOrder S; S.init(MP, DM, F.G, (int)blockIdx.x);
            EpiResid<-1> E{L == 1 ? +F.a->out : (float*)nullptr, nullptr, ((bf16*)(F.a->ws + WS_XN)), L == 1 ? (float*)nullptr : ((float*)(F.a->ws + WS_SSQX))};
            pg8::gemm_phase<EpiResid<-1>, pg8::StaticOrder, true, true>(F.lds + RING_OFF, g, S, E, F.tid);
#if (((REP_MASK) >> 10) & 1u)
            GRID_BAR(); pg8::gemm_phase<EpiResid<-1>, pg8::StaticOrder, true, true>(F.lds + RING_OFF, g, S, E, F.tid);
#endif
            }
            { RELAUNDER(); sample_gemm<false>(F, ((bf16*)(F.a->ws + WS_G)), ((bf16*)(F.a->ws + WS_WDN)) + (size_t)L * DM * FF, FF, nullptr, L == 1 ? +F.a->out : (float*)nullptr, nullptr, ((bf16*)(F.a->ws + WS_XN)), L == 1 ? (float*)nullptr : ((float*)(F.a->ws + WS_SSQX))); }
            SEAM(pb + 9);
        }
}
__global__ void __launch_bounds__(NWAVES * 64, 2) mk_fwd(Args args) {
    extern __shared__ __attribute__((aligned(16))) unsigned char lds[];
    Frame F;
    F.lds = (LAS unsigned char*)lds;
    F.MISC = (volatile LAS unsigned*)(F.lds + MISC_OFF);
    F.tid = threadIdx.x; F.lane = F.tid & 63; F.wave = __builtin_amdgcn_readfirstlane(F.tid >> 6);
    F.G = gridDim.x; { const int bx = blockIdx.x; F.vcu = (F.G % 8 == 0) ? (bx % 8) * (F.G / 8) + bx / 8 : bx; }
    F.ctl = (gu32*)(args.ws + WS_CTL);
    F.a = &args;
    for (int u = F.tid; u < (LDS_BYTES - LDSCTL_OFF) / 4; u += NWAVES * 64) ((LAS unsigned*)(F.lds + LDSCTL_OFF))[u] = 0u;
    __syncthreads();
    XcdBarrier bar; bar.bar = (unsigned*)(F.ctl + CW_BAR); bar.x = 0; bar.st = nullptr;
#if MK_ONE_LAUNCH
    bar = xcd_barrier_post((unsigned*)(F.ctl + CW_BAR), F.MISC + 8);
#else
#endif
    const int lo = args.ph_lo, hi = args.ph_hi;

    if (PHK(0) && IN(0)) { for (int rep_ = 0; rep_ <= REPK(0); ++rep_) { if (rep_) GRID_BAR(); p0_prologue(F); p0_prep(F); } SEAM(0); }

    layer_body<0>(F, bar, lo, hi);
    layer_body<1>(F, bar, lo, hi);
#ifdef DEBUG_DUMP
    if (lo == 99) {
        float* o = F.a->out;
        const size_t nthr = (size_t)F.G * NWAVES * 64, gt = (size_t)F.vcu * NWAVES * 64 + F.tid;
        for (size_t i = gt; i < (size_t)MP * 1024; i += nthr) o[i] = DUMP_A;
        for (size_t i = gt; i < (size_t)MS * 1024; i += nthr) o[(size_t)MP * 1024 + i] = DUMP_B;
    }
#endif
#undef IN
#undef SEAM
#undef gw
#undef RELAUNDER
}

extern "C" void kernel_launch(void* const* d_in, const int* in_sizes, int n_in, void* d_out, int out_size, void* d_ws, size_t ws_size, hipStream_t stream) {
    static int grid = 0;
    if (grid == 0) {
        if (n_in != 24 || (size_t)out_size != O_END || ws_size < WS_END) { fprintf(stderr, "kernel_launch: unexpected shapes: n_in %d out %d ws %zu (need %zu)\n", n_in, out_size, ws_size, (size_t)WS_END); grid = -1; return; }
        int dev = 0, cus = 0, per_cu = 0;
        if (hipGetDevice(&dev) != hipSuccess || hipDeviceGetAttribute(&cus, hipDeviceAttributeMultiprocessorCount, dev) != hipSuccess) { grid = -1; return; }
        if (hipFuncSetAttribute((const void*)mk_fwd, hipFuncAttributeMaxDynamicSharedMemorySize, LDS_BYTES) != hipSuccess) { fprintf(stderr, "kernel_launch: hipFuncSetAttribute failed\n"); grid = -1; return; }
        if (hipOccupancyMaxActiveBlocksPerMultiprocessor(&per_cu, (const void*)mk_fwd, NWAVES * 64, LDS_BYTES) != hipSuccess || per_cu < 1) { fprintf(stderr, "kernel_launch: occupancy query says %d\n", per_cu); }
        (void)hipGetLastError();
        if (cus < 256) { fprintf(stderr, "kernel_launch: built for a 256-CU device (one GEMM unit per workgroup in the N = 1024 projections); found %d CUs; nothing launched\n", cus); grid = -1; return; }
        grid = 256;
    }
    if (grid < 0) return;
    if (hipMemsetAsync((char*)d_ws + WS_CTL, 0, CTL_ZERO_BYTES, stream) != hipSuccess) return;
    Args a{};
    for (int i = 0; i < 24; ++i) a.in[i] = (const float*)d_in[i];
    a.out = (float*)d_out; a.ws = (unsigned char*)d_ws;
#if MK_ONE_LAUNCH
    a.ph_lo = 0; a.ph_hi = N_PHASES;
    hipLaunchKernelGGL(mk_fwd, dim3(grid), dim3(NWAVES * 64), LDS_BYTES, stream, a);
#else
#ifndef LASTPH
#define LASTPH N_PHASES
#endif
    for (int p = 0; p < LASTPH; ++p) { a.ph_lo = p; a.ph_hi = p + 1; hipLaunchKernelGGL(mk_fwd, dim3(grid), dim3(NWAVES * 64), LDS_BYTES, stream, a); }
#ifdef DEBUG_DUMP
    a.ph_lo = 99; a.ph_hi = 100; hipLaunchKernelGGL(mk_fwd, dim3(grid), dim3(NWAVES * 64), LDS_BYTES, stream, a);
#endif
#endif
}
```

```cpp
#include <hip/hip_runtime.h>
#include <cstdio>
#include <cstdint>

#ifndef MK_ONE_LAUNCH
#define MK_ONE_LAUNCH 1
#endif

namespace pg8 {
#define PG8_LAS __attribute__((address_space(3)))
typedef unsigned short bf16_t;
typedef short bf16x8 __attribute__((ext_vector_type(8)));
typedef float f32x4 __attribute__((ext_vector_type(4)));
typedef unsigned u32x4 __attribute__((ext_vector_type(4)));
constexpr int BM = 256, BK = 64, HALF = 128, HTB = HALF * BK * 2  , STAGE_BYTES = 8 * HTB, NXCD = 8, WGM = 4;

__host__ __device__ __forceinline__ int lds_byte(int r, int c) { const int st = (r >> 4) * 2 + (c >> 5), rr = r & 15, cc = c & 31, ob = rr * 64 + cc * 2; return st * 1024 + (ob ^ (((ob >> 9) & 1) << 5)); }
__host__ __device__ __forceinline__ void stage_rc(int b, int& R, int& C) { const int st = b / 1024, sb = b % 1024, swz = sb ^ (((sb >> 9) & 1) << 5); R = (st >> 1) * 16 + swz / 64; C = (st & 1) * 32 + (swz % 64) / 2; }
__host__ __device__ __forceinline__ int perm32(int rho) { const int n = rho >> 4, i = rho & 15; return 8 * (i >> 2) + 4 * n + (i & 3); }

struct Unit { int pm, pn, idx, arow; };
struct Gemm { const bf16_t* A; const bf16_t* Bt; int M, N, K; };

struct StaticOrder {
    int nM, nN, nwg, G, c;
    __host__ __device__ void init(int M, int N, int G_, int c_) { nM = M / BM; nN = N / BM; nwg = nM * nN; G = G_; c = c_; }
    __host__ __device__ bool next(int i, Unit& u) const {
        const long L = (long)i * G + c; if (L >= nwg) return false;
        int wgid = (int)L; { const int q = nwg / NXCD, r = nwg % NXCD, xcd = wgid % NXCD, off = wgid / NXCD; wgid = (xcd < r ? xcd * (q + 1) : r * (q + 1) + (xcd - r) * q) + off; }
        const int nig = WGM * nN, gid = wgid / nig, fm = gid * WGM, gsz = (nM - fm) < WGM ? (nM - fm) : WGM;
        u.pm = fm + ((wgid % nig) % gsz); u.pn = (wgid % nig) / gsz; u.idx = i; u.arow = 256 * u.pm; return true;
    }
    __device__ __forceinline__ void a_ready(const Unit&) const {}
    __device__ __forceinline__ void done(const Unit&) const {}
};
typedef float f32x2_t __attribute__((ext_vector_type(2))); typedef __bf16 bf16x2_t __attribute__((ext_vector_type(2)));
__device__ __forceinline__ unsigned cvt_pk_bf16(float lo, float hi) { f32x2_t v = {lo, hi}; bf16x2_t b = __builtin_convertvector(v, bf16x2_t); return __builtin_bit_cast(unsigned, b); }

struct NoPre { __device__ __forceinline__ void operator()() const {} };
template <class Epi, class Sched, bool ALIGN_EPI = false, bool SP2 = false, class Pre = NoPre>
__device__ __forceinline__ void gemm_phase(PG8_LAS unsigned char* lds, const Gemm g, const Sched& S, const Epi& E, const int tid, const Pre pre = Pre()) {
    const int wid = __builtin_amdgcn_readfirstlane(tid >> 6), lane = tid & 63, wr = wid >> 2, wc = wid & 3, fr = lane & 15, fq = lane >> 4;
    const int K = g.K, nt = K / BK;
    unsigned voffA[2], voffB[2];
#pragma unroll
    for (int i = 0; i < 2; ++i) { int R, C; stage_rc(tid * 16 + i * 8192, R, C); const int Rb = Epi::PERM ? ((R & ~31) + perm32(R & 31)) : R;
        voffA[i] = (unsigned)(R * K + C) * 2u; voffB[i] = (unsigned)(Rb * K + C) * 2u; }
    const size_t kstep = (size_t)(BK * 2);
    const size_t hstep = (size_t)HALF * K * 2;
    const size_t tstep = 2 * hstep;
    const unsigned ldsw = (unsigned)wid * 1024u;
    const int aoff = lds_byte(wr * 64 + fr, fq * 8), boff = lds_byte(wc * 32 + fr, fq * 8);
#define PG8_SA(b, h) (((b) * 2 + (h)) * HTB)
#define PG8_SB(b, h) ((4 + (b) * 2 + (h)) * HTB)
#define PG8_STAGE(bufoff, gbase, voff) do { _Pragma("unroll") for (int _i = 0; _i < 2; ++_i) \
        __builtin_amdgcn_global_load_lds((const unsigned*)((const char*)(gbase) + (voff)[_i]), (PG8_LAS unsigned*)(lds + (bufoff) + ldsw + _i * 8192), 16, 0, 0); } while (0)
#define PG8_LDA(dst, b, h) do { _Pragma("unroll") for (int m = 0; m < 4; ++m) _Pragma("unroll") for (int k = 0; k < 2; ++k) dst[m][k] = *(const PG8_LAS bf16x8*)(lds + PG8_SA(b, h) + aoff + m * 2048 + k * 1024); } while (0)
#define PG8_LDB(dst, b, h) do { _Pragma("unroll") for (int n = 0; n < 2; ++n) _Pragma("unroll") for (int k = 0; k < 2; ++k) dst[n][k] = *(const PG8_LAS bf16x8*)(lds + PG8_SB(b, h) + boff + n * 2048 + k * 1024); } while (0)
#define PG8_MMA(ai, bj, At, Bt) do { __builtin_amdgcn_s_setprio(1); _Pragma("unroll") for (int m = 0; m < 4; ++m) _Pragma("unroll") for (int n = 0; n < 2; ++n) _Pragma("unroll") for (int k = 0; k < 2; ++k) \
        acc[ai][bj][m][n] = __builtin_amdgcn_mfma_f32_16x16x32_bf16(Bt[n][k], At[m][k], acc[ai][bj][m][n], 0, 0, 0); __builtin_amdgcn_s_setprio(0); } while (0)
#define PG8_KS(ai, k) do { if constexpr (Epi::KSCALE) E.kscale(acc, cur, (ai), (k), wr, wc, fr, fq); } while (0)
#define PG8_WAIT_V(n) asm volatile("s_waitcnt vmcnt(" #n ")" ::: "memory")
#define PG8_WAIT_L(n) asm volatile("s_waitcnt lgkmcnt(" #n ")" ::: "memory")
#define PG8_BAR __builtin_amdgcn_s_barrier()
#define PG8_SCHED __builtin_amdgcn_sched_barrier(0)
    Unit cur, nxt; int ui = 0;
    if (!S.next(0, cur)) return;
    bf16x8 At[4][2], B0[2][2], B1[2][2];
    const char* cA = (const char*)g.A + (ptrdiff_t)cur.arow * (ptrdiff_t)(K * 2); const char* cB = (const char*)g.Bt + (size_t)cur.pn * tstep;
    S.a_ready(cur);
    f32x4 acc[2][2][4][2];
    if constexpr (Epi::INIT_ACC) E.init(acc, cur, wr, wc, fr, fq);
    if constexpr (SP2) {
        PG8_STAGE(PG8_SB(0, 0), cB, voffB); PG8_STAGE(PG8_SB(0, 1), cB + hstep, voffB); PG8_STAGE(PG8_SA(0, 0), cA, voffA); PG8_STAGE(PG8_SA(0, 1), cA + hstep, voffA);
        pre();
    }
    if constexpr (!Epi::INIT_ACC) {
#pragma unroll
    for (int a = 0; a < 2; ++a)
#pragma unroll
        for (int b = 0; b < 2; ++b)
#pragma unroll
            for (int m = 0; m < 4; ++m)
#pragma unroll
                for (int n = 0; n < 2; ++n) acc[a][b][m][n] = (f32x4){0.f, 0.f, 0.f, 0.f}; }
    if constexpr (SP2) {
        if (wr == 1) PG8_BAR;
        PG8_WAIT_V(2); PG8_BAR;
        PG8_STAGE(PG8_SB(1, 0), cB + kstep, voffB); PG8_STAGE(PG8_SA(1, 0), cA + kstep, voffA); PG8_STAGE(PG8_SB(1, 1), cB + hstep + kstep, voffB);
        PG8_WAIT_V(6); PG8_BAR;
    } else {
        PG8_STAGE(PG8_SB(0, 0), cB, voffB); PG8_STAGE(PG8_SA(0, 0), cA, voffA); PG8_STAGE(PG8_SB(0, 1), cB + hstep, voffB); PG8_STAGE(PG8_SA(0, 1), cA + hstep, voffA);
        if (wr == 1) PG8_BAR;
        PG8_WAIT_V(4); PG8_BAR;
        PG8_STAGE(PG8_SB(1, 0), cB + kstep, voffB); PG8_STAGE(PG8_SA(1, 0), cA + kstep, voffA); PG8_STAGE(PG8_SB(1, 1), cB + hstep + kstep, voffB);
        PG8_WAIT_V(6); PG8_BAR;
    }
    for (;;) {
        const bool has_next = S.next(ui + 1, nxt);
        const char* nA = has_next ? (const char*)g.A + (ptrdiff_t)nxt.arow * (ptrdiff_t)(K * 2) : cA; const char* nB = has_next ? (const char*)g.Bt + (size_t)nxt.pn * tstep : cB;
        for (int t = 0; t < nt; t += 2) {
            const bool last = (t == nt - 2);
            if constexpr (Epi::HOOK_T >= 0) { if (t == Epi::HOOK_T) E.hook(acc, cur, wr, wc, fr, fq); }
            const char* a1 = cA + (size_t)(t + 1) * kstep;
            const char* a2 = last ? nA : cA + (size_t)(t + 2) * kstep; const char* b2 = last ? nB : cB + (size_t)(t + 2) * kstep;
            const char* a3 = a2 + kstep; const char* b3 = b2 + kstep;
            if (last && has_next) S.a_ready(nxt);
            if constexpr (SP2) {
            PG8_LDB(B0, 0, 0); PG8_LDB(B1, 0, 1); PG8_SCHED; PG8_LDA(At, 0, 0); PG8_STAGE(PG8_SA(1, 1), a1 + hstep, voffA);
            PG8_WAIT_V(8); PG8_WAIT_L(0); PG8_BAR; PG8_MMA(0, 0, At, B0); PG8_MMA(0, 1, At, B1); PG8_KS(1, t); PG8_BAR; PG8_SCHED;
            PG8_LDA(At, 0, 1); PG8_STAGE(PG8_SB(0, 0), b2, voffB); PG8_STAGE(PG8_SB(0, 1), b2 + hstep, voffB); PG8_STAGE(PG8_SA(0, 0), a2, voffA);
            PG8_WAIT_V(8); PG8_WAIT_L(0); PG8_BAR; PG8_MMA(1, 0, At, B0); PG8_MMA(1, 1, At, B1); PG8_KS(0, t + 1); PG8_BAR; PG8_SCHED;
            PG8_LDB(B0, 1, 0); PG8_LDB(B1, 1, 1); PG8_SCHED; PG8_LDA(At, 1, 0); PG8_STAGE(PG8_SA(0, 1), a2 + hstep, voffA);
            PG8_WAIT_V(8); PG8_WAIT_L(0); PG8_BAR; PG8_MMA(0, 0, At, B0); PG8_MMA(0, 1, At, B1); PG8_KS(1, t + 1); PG8_BAR; PG8_SCHED;
            PG8_LDA(At, 1, 1); PG8_STAGE(PG8_SB(1, 0), b3, voffB); PG8_STAGE(PG8_SB(1, 1), b3 + hstep, voffB); PG8_STAGE(PG8_SA(1, 0), a3, voffA);
            PG8_WAIT_V(8); PG8_WAIT_L(0); PG8_BAR; PG8_MMA(1, 0, At, B0); PG8_MMA(1, 1, At, B1); PG8_KS(0, t + 2); PG8_BAR; PG8_SCHED;
            } else {
            PG8_LDB(B0, 0, 0); PG8_SCHED; PG8_LDA(At, 0, 0); PG8_STAGE(PG8_SA(1, 1), a1 + hstep, voffA);
            PG8_WAIT_L(8); PG8_BAR; PG8_WAIT_L(0); PG8_MMA(0, 0, At, B0); PG8_BAR; PG8_SCHED;
            PG8_LDB(B1, 0, 1); PG8_STAGE(PG8_SB(0, 0), b2, voffB);
            PG8_BAR; PG8_WAIT_L(0); PG8_MMA(0, 1, At, B1); PG8_BAR;
            PG8_LDA(At, 0, 1); PG8_STAGE(PG8_SA(0, 0), a2, voffA);
            PG8_BAR; PG8_WAIT_L(0); PG8_MMA(1, 0, At, B0); PG8_BAR; PG8_SCHED;
            PG8_STAGE(PG8_SB(0, 1), b2 + hstep, voffB);
            PG8_WAIT_V(6); PG8_BAR; PG8_MMA(1, 1, At, B1); PG8_BAR;
            PG8_LDB(B0, 1, 0); PG8_SCHED; PG8_LDA(At, 1, 0); PG8_STAGE(PG8_SA(0, 1), a2 + hstep, voffA);
            PG8_WAIT_L(8); PG8_BAR; PG8_WAIT_L(0); PG8_MMA(0, 0, At, B0); PG8_BAR; PG8_SCHED;
            PG8_LDB(B1, 1, 1); PG8_STAGE(PG8_SB(1, 0), b3, voffB);
            PG8_BAR; PG8_WAIT_L(0); PG8_MMA(0, 1, At, B1); PG8_BAR;
            PG8_LDA(At, 1, 1); PG8_STAGE(PG8_SA(1, 0), a3, voffA);
            PG8_BAR; PG8_WAIT_L(0); PG8_MMA(1, 0, At, B0); PG8_BAR; PG8_SCHED;
            PG8_STAGE(PG8_SB(1, 1), b3 + hstep, voffB);
            PG8_WAIT_V(6); PG8_BAR; PG8_MMA(1, 1, At, B1); PG8_BAR;
            }
        }
        if constexpr (ALIGN_EPI) { if (wr == 0) PG8_BAR; }
        if constexpr (!Epi::AFTER_DRAIN) { E(acc, cur, wr, wc, fr, fq); S.done(cur); }
        if (!has_next) break;
        if constexpr (Epi::INIT_ACC) E.init(acc, nxt, wr, wc, fr, fq); else {
#pragma unroll
        for (int a = 0; a < 2; ++a)
#pragma unroll
            for (int b = 0; b < 2; ++b)
#pragma unroll
                for (int m = 0; m < 4; ++m)
#pragma unroll
                    for (int n = 0; n < 2; ++n) acc[a][b][m][n] = (f32x4){0.f, 0.f, 0.f, 0.f}; }
        cur = nxt; cA = nA; cB = nB; ++ui;
        if constexpr (ALIGN_EPI) { if (wr == 1) PG8_BAR; }
    }
    PG8_WAIT_V(0);
    if constexpr (!ALIGN_EPI) { if (wr == 0) PG8_BAR; }
    PG8_BAR;
    if constexpr (Epi::AFTER_DRAIN) { E.fused(acc, cur, wr, wc, fr, fq, lds, wid, lane); S.done(cur); }
#undef PG8_SA
#undef PG8_SB
#undef PG8_STAGE
#undef PG8_LDA
#undef PG8_LDB
#undef PG8_MMA
#undef PG8_KS
#undef PG8_WAIT_V
#undef PG8_WAIT_L
#undef PG8_BAR
#undef PG8_SCHED
}
}

constexpr int NWAVES = 8;
constexpr int DM = 1024, MP = 16384, MS = 512, MT = MP + MS, SEQ = 4096, NBP = 4, NBS = 128, TS = 4, PAST = 2048;
constexpr int NQ = 768, NIN = 4864, INW = 4880, XBCW = 1536, MIXW = 1792, FF = 2816, FF2 = 5632, NH = 12, SH = 16, HD = 64, SST = 128;
constexpr int NCH = 32;
constexpr float EPS = 1e-6f;
constexpr float LOG2E = 1.4426950408889634f, LN2 = 0.6931471805599453f;
constexpr float QSCALE = 0.125f * LOG2E;

constexpr size_t MiB = 1u << 20;
constexpr size_t WS_CTL = 0, CTL_ZERO_BYTES = 1 * MiB;
constexpr size_t WS_WIN  = 2 * MiB;
constexpr size_t WS_WOUT = WS_WIN + 20 * MiB;
constexpr size_t WS_WUP  = WS_WOUT + 8 * MiB;
constexpr size_t WS_WDN  = WS_WUP + 24 * MiB;
constexpr size_t WS_XN   = WS_WDN + 12 * MiB;
constexpr size_t WS_QB   = WS_XN + 36 * MiB;
constexpr size_t WS_KB   = WS_QB + 26 * MiB;
constexpr size_t WS_VB   = WS_KB + 26 * MiB;
constexpr size_t WS_SZ   = WS_VB + 26 * MiB;
constexpr size_t WS_XBC  = WS_SZ + 36 * MiB;
constexpr size_t WS_XBCC = WS_XBC + 52 * MiB;
constexpr size_t WS_DT   = WS_XBCC + 52 * MiB;
constexpr size_t WS_ACUM = WS_DT + 2 * MiB;
constexpr size_t WS_LSE  = WS_ACUM + 2 * MiB;
constexpr size_t WS_ATTO = WS_LSE + 1 * MiB;
constexpr size_t WS_MIX  = WS_ATTO + 26 * MiB;
constexpr size_t WS_SSQP = WS_MIX + 61 * MiB;
constexpr size_t WS_ST   = WS_SSQP + 2 * MiB;
constexpr size_t WS_HPV  = WS_ST + 68 * MiB;
constexpr size_t WS_CDEC = WS_HPV + 34 * MiB;
constexpr size_t WS_X1   = WS_CDEC + 1 * MiB;
constexpr size_t WS_X2   = WS_X1 + 70 * MiB;
constexpr size_t WS_U    = WS_X2 + 70 * MiB;
constexpr size_t WS_G    = WS_U + 192 * MiB;
constexpr size_t WS_SSQX = WS_G + 96 * MiB;
constexpr size_t WS_WDT  = WS_SSQX + 2 * MiB;
constexpr size_t WS_END  = WS_WDT + 1 * MiB;
static_assert((size_t)2 * NIN * DM * 2 <= 20 * MiB && (size_t)2 * DM * MIXW * 2 <= 8 * MiB && (size_t)2 * FF2 * DM * 2 <= 24 * MiB && (size_t)2 * DM * FF * 2 <= 12 * MiB, "weights");
static_assert((size_t)MT * DM * 2 <= 36 * MiB && (size_t)MT * NQ * 2 <= 26 * MiB && (size_t)MT * XBCW * 2 <= 52 * MiB && (size_t)MT * MIXW * 2 <= 61 * MiB && (size_t)MT * DM * 4 <= 70 * MiB && (size_t)MT * FF2 * 2 <= 192 * MiB && (size_t)MT * FF * 2 <= 96 * MiB, "acts");
constexpr int CW_TMO = 0, CW_CODE = 1;
constexpr int CW_BAR = 4096;

constexpr size_t O_YP = 0, O_YS = O_YP + (size_t)MP * DM, O_KVP0 = O_YS + (size_t)MS * DM, O_KVP1 = O_KVP0 + 2 * 4 * 128 * 512, O_KVP2 = O_KVP1 + 2 * 4 * 512 * 512,
                 O_SSMP = O_KVP2 + (size_t)2 * 4 * 2048 * 512, O_CONVP = O_SSMP + 2 * 4 * 16 * 8192, O_FFNP = O_CONVP + 2 * 4 * 3 * XBCW, O_KVS0 = O_FFNP + 2 * 4 * 2 * FF2,
                 O_KVS1 = O_KVS0 + 2 * 128 * 4 * 512, O_KVS2 = O_KVS1 + 2 * 128 * 4 * 512, O_SSMS = O_KVS2 + 2 * 128 * 4 * 512, O_CONVS = O_SSMS + (size_t)2 * 128 * 16 * 8192,
                 O_FFNS = O_CONVS + 2 * 128 * 3 * XBCW, O_END = O_FFNS + 2 * 128 * 2 * FF2;
static_assert(O_END == 68677632, "output size");

constexpr int RING_OFF = 0, RING_BYTES = 139264;
constexpr int LDSCTL_OFF = RING_BYTES, MISC_OFF = LDSCTL_OFF + 320;
constexpr int RSTD_OFF = LDSCTL_OFF + 512, RSTD_MAXU = 6;
constexpr int EXCH_OFF = RSTD_OFF + RSTD_MAXU * 1024;
constexpr int WTAB_OFF = EXCH_OFF + 12288;
constexpr int LDS_BYTES = 163840;
static_assert(WTAB_OFF + 5120 <= LDS_BYTES, "conv weight table");
static_assert(EXCH_OFF + 12288 <= LDS_BYTES, "exchange region");
static_assert(RSTD_OFF + RSTD_MAXU * 1024 <= LDS_BYTES, "rstd table");
static_assert(MISC_OFF + 128 <= LDS_BYTES, "LDS map");

#define GAS __attribute__((address_space(1)))
#define LAS __attribute__((address_space(3)))
typedef unsigned short bf16;
typedef unsigned v4u __attribute__((ext_vector_type(4)));
typedef float f32x4 __attribute__((ext_vector_type(4)));
typedef short bf16x8 __attribute__((ext_vector_type(8)));
typedef GAS unsigned gu32;
typedef GAS unsigned long long gu64;
#define RLX_AGENT __ATOMIC_RELAXED, __HIP_MEMORY_SCOPE_AGENT
#define LDS_WAIT() asm volatile("s_waitcnt lgkmcnt(0)" ::: "memory")
#define VM_WAIT() asm volatile("s_waitcnt vmcnt(0)" ::: "memory")
__device__ __forceinline__ unsigned long long rt() { return __builtin_amdgcn_s_memrealtime(); }
__device__ __forceinline__ unsigned f2bf(float f) { unsigned u = __builtin_bit_cast(unsigned, f); return (u + 0x7fffu + ((u >> 16) & 1u)) >> 16; }
__device__ __forceinline__ unsigned pk2(float lo, float hi) { return f2bf(lo) | (f2bf(hi) << 16); }

#define XB_TMO      128
#define XB_XCNT(j)  (256  + 64 * (j))
#define XB_XSUB(j)  (1280 + 64 * (j))
#define XB_XGEN(j)  (2304 + 64 * (j))
#define XB_TOP      3328
#define XB_TOPGEN   3392
#define XCD_BAR_WORDS 3456
#define XB_SPIN_CAP (1u << 18)

__device__ __forceinline__ unsigned xb_ld(unsigned* p)              { return __hip_atomic_load(p, __ATOMIC_RELAXED, __HIP_MEMORY_SCOPE_AGENT); }
__device__ __forceinline__ unsigned xb_add(unsigned* p, unsigned v) { return __hip_atomic_fetch_add(p, v, __ATOMIC_RELAXED, __HIP_MEMORY_SCOPE_AGENT); }
__device__ __forceinline__ unsigned xb_xcc_id() { return (unsigned)__builtin_amdgcn_s_getreg((3 << 11) | 20) & 0xFu; }
#define XB_SPIN(cond, bar) do { unsigned _sp = 0; while (cond) { __builtin_amdgcn_s_sleep(1); \
    if ((++_sp & 255u) == 0u) { if (xb_ld(&(bar)[XB_TMO])) break; if (_sp > XB_SPIN_CAP) { atomicAdd(&(bar)[XB_TMO], 1u); break; } } } } while (0)

struct XcdBarrier {
    unsigned* bar; unsigned x;
    volatile LAS unsigned* st;
};

__device__ __forceinline__ XcdBarrier xcd_barrier_post(unsigned* bar, volatile LAS unsigned* st) {
    XcdBarrier b; b.bar = bar; b.x = xb_xcc_id(); b.st = st;
    if (threadIdx.x == 0) (void)xb_add(&bar[XB_XCNT(b.x)], 1u);
    return b;
}
__device__ __forceinline__ void xcd_barrier_complete(unsigned* bar, unsigned x, unsigned& nloc, unsigned& nx) {
    const unsigned G = gridDim.x * gridDim.y * gridDim.z;
    unsigned sum, cnt, mine, sp = 0u;
    for (;;) {
        sum = 0u; cnt = 0u; mine = 0u;
#pragma unroll
        for (unsigned j = 0; j < 16; ++j) { const unsigned c = xb_ld(&bar[XB_XCNT(j)]); sum += c; cnt += (c > 0u) ? 1u : 0u; mine = (j == x) ? c : mine; }
        if (sum == G) break;
        __builtin_amdgcn_s_sleep(1);
        if ((++sp & 255u) == 0u) { if (xb_ld(&bar[XB_TMO])) break; if (sp > XB_SPIN_CAP) { atomicAdd(&bar[XB_TMO], 1u); break; } }
    }
    nloc = mine > 0u ? mine : 1u; nx = cnt > 0u ? cnt : 1u;
}

__device__ __forceinline__ void xcd_barrier(const XcdBarrier& b) {
    asm volatile("s_waitcnt vmcnt(0)" ::: "memory");
    __syncthreads();
    if (threadIdx.x == 0) {
        unsigned* bar = b.bar;
        __builtin_amdgcn_s_waitcnt(0);
        unsigned nloc = b.st[0], nx = b.st[1];
        if (nloc == 0u) { xcd_barrier_complete(bar, b.x, nloc, nx); b.st[0] = nloc; b.st[1] = nx; }
        const unsigned old = xb_add(&bar[XB_XSUB(b.x)], 1u);
        const unsigned gen = old / nloc;
        if (old + 1u == (gen + 1u) * nloc) {
            __builtin_amdgcn_fence(__ATOMIC_RELEASE, "agent");
            asm volatile("s_waitcnt vmcnt(0)" ::: "memory");
            const unsigned og = xb_add(&bar[XB_TOP], 1u);
            const unsigned tg = og / nx;
            if (og + 1u == (tg + 1u) * nx) xb_add(&bar[XB_TOPGEN], 1u);
            else XB_SPIN(xb_ld(&bar[XB_TOPGEN]) == tg, bar);
            __builtin_amdgcn_fence(__ATOMIC_ACQUIRE, "agent");
            xb_add(&bar[XB_XGEN(b.x)], 1u);
            asm volatile("s_waitcnt vmcnt(0)" ::: "memory");
        } else {
            XB_SPIN(xb_ld(&bar[XB_XGEN(b.x)]) == gen, bar);
            __builtin_amdgcn_fence(__ATOMIC_ACQUIRE, "agent");
            asm volatile("s_waitcnt vmcnt(0)" ::: "memory");
        }
    }
    __syncthreads();
}


typedef short v4i16_t __attribute__((ext_vector_type(4)));
typedef float f32x2 __attribute__((ext_vector_type(2)));
typedef unsigned v2u __attribute__((ext_vector_type(2)));
__device__ __forceinline__ float bflo(unsigned w) { return __uint_as_float(w << 16); }
__device__ __forceinline__ float bfhi(unsigned w) { return __uint_as_float(w & 0xffff0000u); }
__device__ __forceinline__ float bf2f(unsigned short u) { return __uint_as_float((unsigned)u << 16); }
__device__ __forceinline__ unsigned cvtpk(float lo, float hi) { return pg8::cvt_pk_bf16(lo, hi); }
__device__ __forceinline__ float silu_f(float x) { return x * __builtin_amdgcn_rcpf(1.f + __expf(-x)); }
__device__ __forceinline__ float softplus_f(float x) { return x > 20.f ? x : log1pf(__expf(x)); }
template <int CTRL> __device__ __forceinline__ float dpp_x(float x) { return __builtin_bit_cast(float, __builtin_amdgcn_update_dpp(0, __builtin_bit_cast(int, x), CTRL, 0xf, 0xf, true)); }
__device__ __forceinline__ float red16(float s) { s += dpp_x<0xB1>(s); s += dpp_x<0x4E>(s); s += dpp_x<0x141>(s); s += dpp_x<0x140>(s); return s; }
__device__ __forceinline__ float wave_sum(float v) { v = red16(v); v += __shfl_xor(v, 16); v += __shfl_xor(v, 32); return v; }
__device__ __forceinline__ bf16x8 tr2(const LAS char* p0, const LAS char* p1) {
    const v4i16_t a = __builtin_amdgcn_ds_read_tr16_b64_v4i16((LAS v4i16_t*)p0), b = __builtin_amdgcn_ds_read_tr16_b64_v4i16((LAS v4i16_t*)p1);
    return __builtin_shufflevector(a, b, 0, 1, 2, 3, 4, 5, 6, 7);
}
__device__ __forceinline__ f32x4 mfma16(bf16x8 a, bf16x8 b, f32x4 c) { return __builtin_amdgcn_mfma_f32_16x16x32_bf16(a, b, c, 0, 0, 0); }

__device__ __forceinline__ float rstd16(const float* p) {
    const f32x4* sp = (const f32x4*)p; const f32x4 a = sp[0], b = sp[1], c = sp[2], d = sp[3];
    const float s = ((a[0] + a[1]) + (a[2] + a[3])) + ((b[0] + b[1]) + (b[2] + b[3])) + ((c[0] + c[1]) + (c[2] + c[3])) + ((d[0] + d[1]) + (d[2] + d[3]));
    return rsqrtf(s * (1.f / 1024.f) + EPS);
}
__device__ __forceinline__ void row_rstd8(const LAS float* tab, int idx, int rloc, float (&rr)[2][4]) {
#pragma unroll
    for (int ai = 0; ai < 2; ++ai)
#pragma unroll
        for (int m = 0; m < 4; ++m) rr[ai][m] = tab[idx * 256 + rloc + 128 * ai + 16 * m];
}
template <class Sched> __device__ __forceinline__ void prefill_rstd(LAS float* tab, const Sched& S, const float* ssq, int tid) {
    pg8::Unit u; f32x4 p[RSTD_MAXU][2]; bool ok[RSTD_MAXU];
    const int r = tid >> 1, hf = tid & 1;
#pragma unroll
    for (int i = 0; i < RSTD_MAXU; ++i) { ok[i] = S.next(i, u); p[i][0] = (f32x4){0.f, 0.f, 0.f, 0.f}; p[i][1] = p[i][0];
        if (ok[i]) { const int r_ = u.arow + r; const float* q = ssq + (size_t)(r_ < 0 ? 0 : r_) * 16 + 8 * hf; p[i][0] = *(const f32x4*)q; p[i][1] = *(const f32x4*)(q + 4); } }
#pragma unroll
    for (int i = 0; i < RSTD_MAXU; ++i) { float s = ((p[i][0][0] + p[i][0][1]) + (p[i][0][2] + p[i][0][3])) + ((p[i][1][0] + p[i][1][1]) + (p[i][1][2] + p[i][1][3]));
        s += dpp_x<0xB1>(s);
        if (ok[i] && hf == 0) tab[i * 256 + r] = rsqrtf(s * (1.f / 1024.f) + EPS); }
    __syncthreads();
}
template <class Sched> struct PreRstd { LAS float* tab; Sched S; const float* ssq; int tid; __device__ __forceinline__ void operator()() const { prefill_rstd(tab, S, ssq, tid); } };

__device__ __forceinline__ void store_pair16(bf16* rowp  , const v2u pk_even, const v2u pk_odd, const int pr, const int fq) {
    const bool odd = fq & 1; const v2u mine = odd ? pk_odd : pk_even, send = odd ? pk_even : pk_odd;
    v2u recv; recv.x = __shfl_xor(send.x, 16); recv.y = __shfl_xor(send.y, 16);
    v4u o; if (odd) { o.x = recv.x; o.y = recv.y; o.z = mine.x; o.w = mine.y; } else { o.x = mine.x; o.y = mine.y; o.z = recv.x; o.w = recv.y; }
    *(v4u*)(rowp + 16 * (2 * pr + (odd ? 1 : 0)) + 4 * (fq & ~1)) = o;
}
struct EpiInProj {
    static constexpr bool PERM = true, AFTER_DRAIN = false, INIT_ACC = false, KSCALE = false; static constexpr int HOOK_T = -1;
    bf16 *QB, *KB, *VB, *SZ, *XBC; const float *qn, *kn; float* out; int layer; const LAS float* ssqx;
    __device__ __forceinline__ void kv_out(int row, int g, int kv, int slot, int e0, f32x4 v0, f32x4 v1) const {
        const int keep = 128 << (2 * g);
        float* p = nullptr;
        if (row < MP) { const int b = row >> 12, t = row & 4095;
            if (t >= SEQ - keep) { const size_t base = g == 0 ? O_KVP0 : (g == 1 ? O_KVP1 : O_KVP2);
                p = out + base + ((((size_t)(layer * NBP + b) * keep + (t - (SEQ - keep))) * 2 + kv) * 4 + slot) * 64 + e0; } }
        else { const int rs = row - MP, b = rs >> 2, t = rs & 3; const size_t base = g == 0 ? O_KVS0 : (g == 1 ? O_KVS1 : O_KVS2);
            p = out + base + ((((size_t)(layer * NBS + b) * TS + t) * 2 + kv) * 4 + slot) * 64 + e0; }
        if (p) { *(f32x4*)p = v0; *(f32x4*)(p + 4) = v1; }
    }
    __device__ __forceinline__ void operator()(const f32x4 (&acc)[2][2][4][2], const pg8::Unit& u, int wr, int wc, int fr, int fq) const {
        const int pn = u.pn, rbase = u.pm * 256 + wr * 64 + fr, ct = 64 * wc + 8 * fq;
        float rr8[2][4]; row_rstd8(ssqx, u.idx, wr * 64 + fr, rr8);
        if (pn < 6) {
            const bool isq = pn < 3; const float* gn = isq ? +qn : +kn;
            f32x4 g[2][2];
#pragma unroll
            for (int bj = 0; bj < 2; ++bj)
#pragma unroll
                for (int n = 0; n < 2; ++n) g[bj][n] = *(const f32x4*)(gn + 32 * bj + 8 * fq + 4 * n);
            const float post = isq ? QSCALE : 1.f; bf16* dst = isq ? +QB : +KB; const int c0 = (isq ? pn : pn - 3) * 256 + ct;
#pragma unroll
            for (int ai = 0; ai < 2; ++ai)
#pragma unroll
                for (int m = 0; m < 4; ++m) { const int row = rbase + ai * 128 + m * 16; float ss = 0.f; const float rr = rr8[ai][m];
#pragma unroll
                    for (int bj = 0; bj < 2; ++bj)
#pragma unroll
                        for (int n = 0; n < 2; ++n) { const f32x4 x = acc[ai][bj][m][n]; ss += (x[0] * x[0] + x[1] * x[1]) + (x[2] * x[2] + x[3] * x[3]); }
                    ss += __shfl_xor(ss, 16); ss += __shfl_xor(ss, 32);
                    const float rs = rr * rsqrtf(ss * (rr * rr) * (1.f / 64.f) + EPS);
#pragma unroll
                    for (int bj = 0; bj < 2; ++bj) { const f32x4 v0 = acc[ai][bj][m][0] * rs * g[bj][0], v1 = acc[ai][bj][m][1] * rs * g[bj][1];
                        v4u w; w.x = cvtpk(v0[0] * post, v0[1] * post); w.y = cvtpk(v0[2] * post, v0[3] * post); w.z = cvtpk(v1[0] * post, v1[1] * post); w.w = cvtpk(v1[2] * post, v1[3] * post);
                        *(v4u*)(dst + (size_t)row * NQ + c0 + 32 * bj) = w;
                        if (!isq) kv_out(row, pn - 3, 0, wc, 32 * bj + 8 * fq, v0, v1); } }
        } else if (pn < 9) {
            const int c0 = (pn - 6) * 256 + ct;
#pragma unroll
            for (int ai = 0; ai < 2; ++ai)
#pragma unroll
                for (int m = 0; m < 4; ++m) { const int row = rbase + ai * 128 + m * 16; const float rr = rr8[ai][m];
#pragma unroll
                    for (int bj = 0; bj < 2; ++bj) { const f32x4 v0 = acc[ai][bj][m][0] * rr, v1 = acc[ai][bj][m][1] * rr;
                        v4u w; w.x = cvtpk(v0[0], v0[1]); w.y = cvtpk(v0[2], v0[3]); w.z = cvtpk(v1[0], v1[1]); w.w = cvtpk(v1[2], v1[3]);
                        *(v4u*)(VB + (size_t)row * NQ + c0 + 32 * bj) = w;
                        kv_out(row, pn - 6, 1, wc, 32 * bj + 8 * fq, v0, v1); } }
        } else if (pn < 13) {
            const int c0 = (pn - 9) * 256 + ct;
#pragma unroll
            for (int ai = 0; ai < 2; ++ai)
#pragma unroll
                for (int m = 0; m < 4; ++m) { const int row = rbase + ai * 128 + m * 16; const float rr = rr8[ai][m];
#pragma unroll
                    for (int bj = 0; bj < 2; ++bj) { const f32x4 v0 = acc[ai][bj][m][0] * rr, v1 = acc[ai][bj][m][1] * rr;
                        v4u w; w.x = cvtpk(silu_f(v0[0]), silu_f(v0[1])); w.y = cvtpk(silu_f(v0[2]), silu_f(v0[3])); w.z = cvtpk(silu_f(v1[0]), silu_f(v1[1])); w.w = cvtpk(silu_f(v1[2]), silu_f(v1[3]));
                        *(v4u*)(SZ + (size_t)row * DM + c0 + 32 * bj) = w; } }
        } else {
            const int c0 = (pn - 13) * 256 + ct;
#pragma unroll
            for (int ai = 0; ai < 2; ++ai)
#pragma unroll
                for (int m = 0; m < 4; ++m) { const int row = rbase + ai * 128 + m * 16; const float rr = rr8[ai][m];
                    float* p = nullptr;
                    if (row < MP) { const int b = row >> 12, t = row & 4095; if (t >= SEQ - 3) p = out + O_CONVP + ((size_t)(layer * NBP + b) * 3 + (t - (SEQ - 3))) * XBCW + c0; }
                    else { const int rs = row - MP, b = rs >> 2, t = rs & 3; if (t >= 1) p = out + O_CONVS + ((size_t)(layer * NBS + b) * 3 + (t - 1)) * XBCW + c0; }
#pragma unroll
                    for (int bj = 0; bj < 2; ++bj) { const f32x4 v0 = acc[ai][bj][m][0] * rr, v1 = acc[ai][bj][m][1] * rr;
                        v4u w; w.x = cvtpk(v0[0], v0[1]); w.y = cvtpk(v0[2], v0[3]); w.z = cvtpk(v1[0], v1[1]); w.w = cvtpk(v1[2], v1[3]);
                        *(v4u*)(XBC + (size_t)row * XBCW + c0 + 32 * bj) = w;
                        if (p) { *(f32x4*)(p + 32 * bj) = v0; *(f32x4*)(p + 32 * bj + 4) = v1; } } }
        }
    }
    __device__ __forceinline__ void hook(f32x4 (&)[2][2][4][2], const pg8::Unit&, int, int, int, int) const {}
};

template <int HT> struct EpiResid {
    static constexpr bool PERM = true, AFTER_DRAIN = false, INIT_ACC = true, KSCALE = false; static constexpr int HOOK_T = HT;
    float* outp; const LAS float* ssqp; bf16* xb; float* ssqx;
    __device__ __forceinline__ void init(f32x4 (&acc)[2][2][4][2], const pg8::Unit& u, int wr, int wc, int fr, int fq) const {
        const int rbase = u.pm * 256 + wr * 64 + fr, col0 = u.pn * 256 + wc * 32 + 8 * fq;
        float rr8[2][4];
        if (HT >= 0) row_rstd8(ssqp, u.idx, wr * 64 + fr, rr8);
#pragma unroll
        for (int ai = 0; ai < 2; ++ai)
#pragma unroll
            for (int m = 0; m < 4; ++m) { const int row = rbase + ai * 128 + m * 16; const bf16* bp = xb + (size_t)row * DM;
                const float sc = HT >= 0 ? 1.f / rr8[ai][m] : 1.f;
#pragma unroll
                for (int bj = 0; bj < 2; ++bj) { const v4u w = *(const v4u*)(bp + col0 + 128 * bj);
                    acc[ai][bj][m][0] = (f32x4){bflo(w.x), bfhi(w.x), bflo(w.y), bfhi(w.y)} * sc; acc[ai][bj][m][1] = (f32x4){bflo(w.z), bfhi(w.z), bflo(w.w), bfhi(w.w)} * sc; } }
    }
    __device__ __forceinline__ void operator()(const f32x4 (&acc)[2][2][4][2], const pg8::Unit& u, int wr, int wc, int fr, int fq) const {
        const int rbase = u.pm * 256 + wr * 64 + fr, col0 = u.pn * 256 + wc * 32 + 8 * fq;
#pragma unroll
        for (int ai = 0; ai < 2; ++ai)
#pragma unroll
            for (int m = 0; m < 4; ++m) { const int row = rbase + ai * 128 + m * 16;
                float ss = 0.f;
#pragma unroll
                for (int bj = 0; bj < 2; ++bj) { const int c = col0 + 128 * bj;
                    const f32x4 o0 = acc[ai][bj][m][0], o1 = acc[ai][bj][m][1];
                    if (outp) { float* op = outp + (size_t)row * DM; *(f32x4*)(op + c) = o0; *(f32x4*)(op + c + 4) = o1; }
                    if (ssqx) { ss += ((o0[0] * o0[0] + o0[1] * o0[1]) + (o0[2] * o0[2] + o0[3] * o0[3])) + ((o1[0] * o1[0] + o1[1] * o1[1]) + (o1[2] * o1[2] + o1[3] * o1[3]));
                        v4u w; w.x = cvtpk(o0[0], o0[1]); w.y = cvtpk(o0[2], o0[3]); w.z = cvtpk(o1[0], o1[1]); w.w = cvtpk(o1[2], o1[3]);
                        *(v4u*)(xb + (size_t)row * DM + c) = w; } }
                if (ssqx) { ss += __shfl_xor(ss, 16); ss += __shfl_xor(ss, 32);
                    if (fq == 0) ssqx[(size_t)row * 16 + 4 * u.pn + wc] = ss; } }
    }
    __device__ __forceinline__ void hook(f32x4 (&acc)[2][2][4][2], const pg8::Unit& u, int wr, int wc, int fr, int fq) const {
        float rr8[2][4]; row_rstd8(ssqp, u.idx, wr * 64 + fr, rr8);
#pragma unroll
        for (int ai = 0; ai < 2; ++ai)
#pragma unroll
            for (int m = 0; m < 4; ++m)
#pragma unroll
                for (int bj = 0; bj < 2; ++bj)
#pragma unroll
                    for (int n = 0; n < 2; ++n) acc[ai][bj][m][n] = acc[ai][bj][m][n] * rr8[ai][m];
    }
};

struct EpiUp {
    static constexpr bool PERM = true, AFTER_DRAIN = false, INIT_ACC = false, KSCALE = false; static constexpr int HOOK_T = -1;
    bf16* U; float* out; int layer; const LAS float* ssqx;
    __device__ __forceinline__ void operator()(const f32x4 (&acc)[2][2][4][2], const pg8::Unit& u, int wr, int wc, int fr, int fq) const {
        const int rbase = u.pm * 256 + wr * 64 + fr, col0 = u.pn * 256 + wc * 32 + 8 * fq, tc0 = 128 * u.pn + 32 * wc + 8 * fq;
        float rr8[2][4]; row_rstd8(ssqx, u.idx, wr * 64 + fr, rr8);
#pragma unroll
        for (int ai = 0; ai < 2; ++ai)
#pragma unroll
            for (int m = 0; m < 4; ++m) { const int row = rbase + ai * 128 + m * 16;
                float* p = nullptr;
                if (row < MP) { const int b = row >> 12, t = row & 4095; if (t >= SEQ - 2) p = out + O_FFNP + ((size_t)(layer * NBP + b) * 2 + (t - (SEQ - 2))) * FF2 + tc0; }
                else { const int rs = row - MP, b = rs >> 2, t = rs & 3; if (t >= 2) p = out + O_FFNS + ((size_t)(layer * NBS + b) * 2 + (t - 2)) * FF2 + tc0; }
                const float rr = rr8[ai][m];
#pragma unroll
                for (int bj = 0; bj < 2; ++bj) { const f32x4 v0 = acc[ai][bj][m][0] * rr, v1 = acc[ai][bj][m][1] * rr;
                    v4u w; w.x = cvtpk(v0[0], v0[1]); w.y = cvtpk(v0[2], v0[3]); w.z = cvtpk(v1[0], v1[1]); w.w = cvtpk(v1[2], v1[3]);
                    *(v4u*)(U + (size_t)row * FF2 + col0 + 128 * bj) = w;
                    if (p) { *(f32x4*)(p + bj * FF) = v0; *(f32x4*)(p + bj * FF + 4) = v1; } } }
    }
    __device__ __forceinline__ void hook(f32x4 (&)[2][2][4][2], const pg8::Unit&, int, int, int, int) const {}
};
__device__ __forceinline__ float dbg_sane(float x) { return (x == x && fabsf(x) < 1e30f) ? x : 12345.f; }

struct UpOrder {
    pg8::StaticOrder S;
    __device__ void init(int G_, int c_) { S.init(67 * 256, FF2, G_, c_); }
    __device__ bool next(int i, pg8::Unit& u) const { if (!S.next(i, u)) return false; u.arow = u.pm < 65 ? 254 * u.pm - 2 : MP + 256 * (u.pm - 65); return true; }
    __device__ __forceinline__ void a_ready(const pg8::Unit&) const {}
    __device__ __forceinline__ void done(const pg8::Unit&) const {}
};
__device__ __forceinline__ float dpp_shr1(float old, float src) { return __builtin_bit_cast(float, __builtin_amdgcn_update_dpp(__builtin_bit_cast(int, old), __builtin_bit_cast(int, src), 0x111, 0xf, 0xf, false)); }
__device__ __forceinline__ float dpp_shr2(float old, float src) { return __builtin_bit_cast(float, __builtin_amdgcn_update_dpp(__builtin_bit_cast(int, old), __builtin_bit_cast(int, src), 0x112, 0xf, 0xf, false)); }
__device__ __forceinline__ float dpp_ror1(float src) { return __builtin_bit_cast(float, __builtin_amdgcn_update_dpp(0, __builtin_bit_cast(int, src), 0x121, 0xf, 0xf, false)); }
__device__ __forceinline__ float dpp_ror2(float src) { return __builtin_bit_cast(float, __builtin_amdgcn_update_dpp(0, __builtin_bit_cast(int, src), 0x122, 0xf, 0xf, false)); }
struct EpiUpConv {
    static constexpr bool PERM = true, AFTER_DRAIN = false, INIT_ACC = false, KSCALE = false; static constexpr int HOOK_T = 8;
    bf16* G; float* out; int layer; const LAS float* rs; LAS float* exch; const float* fcw; const float* fcb; const float* stf; LAS float* wtab;
    __device__ __forceinline__ void operator()(const f32x4 (&acc)[2][2][4][2], const pg8::Unit& u, int wr, int wc, int fr, int fq) const {
        const bool samp = u.arow >= MP; const int rloc = wr * 64 + fr, ch0 = 128 * u.pn + 32 * wc + 8 * fq;
        float rr8[2][4]; row_rstd8(rs, u.idx, rloc, rr8);
        if (fr >= 14) {
#pragma unroll
            for (int ai = 0; ai < 2; ++ai)
#pragma unroll
                for (int bj = 0; bj < 2; ++bj)
#pragma unroll
                    for (int n = 0; n < 2; ++n) *(LAS f32x4*)(exch + ((((wr * 4 + wc) * 2 + ai) * 2 + (fr - 14)) * 64 + fq * 16 + bj * 8 + n * 4)) = acc[ai][bj][3][n] * rr8[ai][3];
        }
        asm volatile("s_waitcnt vmcnt(0) lgkmcnt(0)" ::: "memory"); __builtin_amdgcn_s_barrier(); asm volatile("" ::: "memory");
        v2u keep[2][4];
        pass<0>(acc, u, wr, wc, fr, fq, samp, rloc, ch0, rr8, keep);
        pass<1>(acc, u, wr, wc, fr, fq, samp, rloc, ch0, rr8, keep);
    }
    template <int n> __device__ __forceinline__ void pass(const f32x4 (&acc)[2][2][4][2], const pg8::Unit& u, int wr, int wc, int fr, int fq, const bool samp, const int rloc, const int ch0, const float (&rr8)[2][4], v2u (&keep)[2][4]) const {
            f32x4 wg[3], wu[3], bg, bu;
#pragma unroll
            for (int tp = 0; tp < 3; ++tp) { wg[tp] = *(const LAS f32x4*)(wtab + tp * 128 + (ch0 & 127) + 4 * n); wu[tp] = *(const LAS f32x4*)(wtab + (3 + tp) * 128 + (ch0 & 127) + 4 * n); }
            bg = *(const LAS f32x4*)(wtab + 6 * 128 + (ch0 & 127) + 4 * n); bu = *(const LAS f32x4*)(wtab + 7 * 128 + (ch0 & 127) + 4 * n);
#pragma unroll
            for (int ai = 0; ai < 2; ++ai) {
                const int blk = 2 * ai + wr;
                f32x4 b14g = (f32x4){0.f, 0.f, 0.f, 0.f}, b15g = b14g, b14u = b14g, b15u = b14g;
                if (blk > 0) { const int sa = (blk - 1) >> 1, sw = (blk - 1) & 1; const LAS float* s = exch + (((sw * 4 + wc) * 2 + sa) * 2) * 64 + fq * 16 + n * 4;
                    b14g = *(const LAS f32x4*)(s); b14u = *(const LAS f32x4*)(s + 8); b15g = *(const LAS f32x4*)(s + 64); b15u = *(const LAS f32x4*)(s + 64 + 8); }
                f32x4 pg = b15g, pu = b15u;
                f32x4 og1 = b15g, ou1 = b15u, og2 = (fr == 0) ? b14g : b15g, ou2 = (fr == 0) ? b14u : b15u;
#pragma unroll
                for (int m = 0; m < 4; ++m) {
                    const f32x4 g0 = acc[ai][0][m][n] * rr8[ai][m], u0 = acc[ai][1][m][n] * rr8[ai][m];
                    f32x4 g1, g2, u1, u2;
#pragma unroll
                    for (int i = 0; i < 4; ++i) {
                        const float o1g = m ? dpp_ror1(pg[i]) : og1[i], o2g = m ? dpp_ror2(pg[i]) : og2[i], o1u = m ? dpp_ror1(pu[i]) : ou1[i], o2u = m ? dpp_ror2(pu[i]) : ou2[i];
                        g1[i] = dpp_shr1(o1g, g0[i]); g2[i] = dpp_shr2(o2g, g0[i]); u1[i] = dpp_shr1(o1u, u0[i]); u2[i] = dpp_shr2(o2u, u0[i]); }
                    pg = g0; pu = u0;
                    const int r = rloc + 128 * ai + 16 * m, grow = u.arow + r;
                    bool valid;
                    if (!samp) { const int t = grow & 4095; valid = (r >= 2) && (grow < MP);
                        if (t < 2) { g2 = (f32x4){0.f, 0.f, 0.f, 0.f}; u2 = g2; if (t < 1) { g1 = g2; u1 = g2; } }
                        if (valid && t >= SEQ - 2) { float* p = out + O_FFNP + ((size_t)(layer * NBP + (grow >> 12)) * 2 + (t - (SEQ - 2))) * FF2 + ch0 + 4 * n; *(f32x4*)p = g0; *(f32x4*)(p + FF) = u0; }
                    } else { const int rs_ = grow - MP, b = rs_ >> 2, t = rs_ & 3; valid = true;
                        if (t < 2) { const float* sp = stf + (size_t)b * 2 * FF2 + ch0 + 4 * n;
                            const f32x4 s1g = *(const f32x4*)(sp + FF2), s1u = *(const f32x4*)(sp + FF2 + FF);
                            if (t == 0) { g2 = *(const f32x4*)(sp); u2 = *(const f32x4*)(sp + FF); g1 = s1g; u1 = s1u; } else { g2 = s1g; u2 = s1u; } }
                        if (t >= 2) { float* p = out + O_FFNS + ((size_t)(layer * NBS + b) * 2 + (t - 2)) * FF2 + ch0 + 4 * n; *(f32x4*)p = g0; *(f32x4*)(p + FF) = u0; }
                    }
                    if (n == 0) keep[ai][m] = (v2u){0u, 0u};
                    if (valid) { const f32x4 gc = bg + wg[0] * g2 + wg[1] * g1 + wg[2] * g0, uc = bu + wu[0] * u2 + wu[1] * u1 + wu[2] * u0;
                        v2u o; o.x = cvtpk(silu_f(gc[0]) * uc[0], silu_f(gc[1]) * uc[1]); o.y = cvtpk(silu_f(gc[2]) * uc[2], silu_f(gc[3]) * uc[3]);
                        if (n == 0) keep[ai][m] = o;
                        else { v4u o4; o4.x = keep[ai][m].x; o4.y = keep[ai][m].y; o4.z = o.x; o4.w = o.y; *(v4u*)(G + (size_t)grow * FF + ch0) = o4; } }
                }
            }
    }
    __device__ __forceinline__ void hook(f32x4 (&)[2][2][4][2], const pg8::Unit& u, int wr, int wc, int fr, int fq) const {
        if (wr == 0) { const int tid_ = wc * 64 + fq * 16 + fr, q = tid_ >> 5, c4 = tid_ & 31;
            const float* src = (q < 3 ? fcw + q * FF2 : (q < 6 ? fcw + (q - 3) * FF2 + FF : (q == 6 ? fcb : fcb + FF))) + 128 * u.pn + 4 * c4;
            __builtin_amdgcn_global_load_lds((const unsigned*)src, (LAS unsigned*)(wtab + wc * 256), 16, 0, 0); }
    }
};

struct InOrder {
    pg8::StaticOrder S;
    __device__ void init(int G_, int c_) { S.init(67 * 256, NIN, G_, c_); }
    __device__ bool next(int i, pg8::Unit& u) const { if (!S.next(i, u)) return false; u.arow = u.pm < 65 ? 253 * u.pm - 3 : MP + 256 * (u.pm - 65); return true; }
    __device__ __forceinline__ void a_ready(const pg8::Unit&) const {}
    __device__ __forceinline__ void done(const pg8::Unit&) const {}
};
__device__ __forceinline__ float dpp_shr3(float old, float src) { return __builtin_bit_cast(float, __builtin_amdgcn_update_dpp(__builtin_bit_cast(int, old), __builtin_bit_cast(int, src), 0x113, 0xf, 0xf, false)); }
__device__ __forceinline__ float dpp_ror3(float src) { return __builtin_bit_cast(float, __builtin_amdgcn_update_dpp(0, __builtin_bit_cast(int, src), 0x123, 0xf, 0xf, false)); }
struct EpiInProj3 {
    static constexpr bool PERM = true, AFTER_DRAIN = false, INIT_ACC = false, KSCALE = false; static constexpr int HOOK_T = -1;
    bf16 *QB, *KB, *VB, *SZ, *XBCC, *XBC; const float *qn, *kn; float* out; int layer; const LAS float* ssqx; LAS float* exch; const float* cw; const float* cb; const float* stc; LAS float* wtab;
    __device__ __forceinline__ void kv_out(int row, int g, int kv, int slot, int e0, f32x4 v0, f32x4 v1) const {
        const int keep = 128 << (2 * g);
        float* p = nullptr;
        if (row < MP) { const int b = row >> 12, t = row & 4095;
            if (t >= SEQ - keep) { const size_t base = g == 0 ? O_KVP0 : (g == 1 ? O_KVP1 : O_KVP2);
                p = out + base + ((((size_t)(layer * NBP + b) * keep + (t - (SEQ - keep))) * 2 + kv) * 4 + slot) * 64 + e0; } }
        else { const int rs = row - MP, b = rs >> 2, t = rs & 3; const size_t base = g == 0 ? O_KVS0 : (g == 1 ? O_KVS1 : O_KVS2);
            p = out + base + ((((size_t)(layer * NBS + b) * TS + t) * 2 + kv) * 4 + slot) * 64 + e0; }
        if (p) { *(f32x4*)p = v0; *(f32x4*)(p + 4) = v1; }
    }
    __device__ __forceinline__ void operator()(const f32x4 (&acc)[2][2][4][2], const pg8::Unit& u, int wr, int wc, int fr, int fq) const {
        asm volatile("" : "+v"(fr), "+v"(fq));
        const int pn = u.pn; int rloc = wr * 64 + fr, ct = 64 * wc + 8 * fq; const bool samp = u.arow >= MP;
        float rr8[2][4]; if (pn < 13) row_rstd8(ssqx, u.idx, rloc, rr8);
        if (pn < 6) {
            const bool isq = pn < 3; const float* gn = isq ? +qn : +kn;
            f32x4 g[2][2];
#pragma unroll
            for (int bj = 0; bj < 2; ++bj)
#pragma unroll
                for (int n = 0; n < 2; ++n) g[bj][n] = *(const f32x4*)(gn + 32 * bj + 8 * fq + 4 * n);
            const float post = isq ? QSCALE : 1.f; bf16* dst = isq ? +QB : +KB; const int c0 = (isq ? pn : pn - 3) * 256 + ct;
#pragma unroll
            for (int ai = 0; ai < 2; ++ai)
#pragma unroll
                for (int m = 0; m < 4; ++m) { const int r = rloc + ai * 128 + m * 16, row = u.arow + r; const bool valid = samp || (r >= 3 && row < MP); float ss = 0.f; const float rr = rr8[ai][m];
#pragma unroll
                    for (int bj = 0; bj < 2; ++bj)
#pragma unroll
                        for (int n = 0; n < 2; ++n) { const f32x4 x = acc[ai][bj][m][n]; ss += (x[0] * x[0] + x[1] * x[1]) + (x[2] * x[2] + x[3] * x[3]); }
                    ss += __shfl_xor(ss, 16); ss += __shfl_xor(ss, 32);
                    const float rs = rr * rsqrtf(ss * (rr * rr) * (1.f / 64.f) + EPS);
                    if (valid) {
#pragma unroll
                    for (int bj = 0; bj < 2; ++bj) { const f32x4 v0 = acc[ai][bj][m][0] * rs * g[bj][0], v1 = acc[ai][bj][m][1] * rs * g[bj][1];
                        v4u w; w.x = cvtpk(v0[0] * post, v0[1] * post); w.y = cvtpk(v0[2] * post, v0[3] * post); w.z = cvtpk(v1[0] * post, v1[1] * post); w.w = cvtpk(v1[2] * post, v1[3] * post);
                        *(v4u*)(dst + (size_t)row * NQ + c0 + 32 * bj) = w;
                        if (!isq) kv_out(row, pn - 3, 0, wc, 32 * bj + 8 * fq, v0, v1); } } }
        } else if (pn < 9) {
            const int c0 = (pn - 6) * 256 + ct;
#pragma unroll
            for (int ai = 0; ai < 2; ++ai)
#pragma unroll
                for (int m = 0; m < 4; ++m) { const int r = rloc + ai * 128 + m * 16, row = u.arow + r; const bool valid = samp || (r >= 3 && row < MP); const float rr = rr8[ai][m];
                    if (valid) {
#pragma unroll
                    for (int bj = 0; bj < 2; ++bj) { const f32x4 v0 = acc[ai][bj][m][0] * rr, v1 = acc[ai][bj][m][1] * rr;
                        v4u w; w.x = cvtpk(v0[0], v0[1]); w.y = cvtpk(v0[2], v0[3]); w.z = cvtpk(v1[0], v1[1]); w.w = cvtpk(v1[2], v1[3]);
                        *(v4u*)(VB + (size_t)row * NQ + c0 + 32 * bj) = w;
                        kv_out(row, pn - 6, 1, wc, 32 * bj + 8 * fq, v0, v1); } } }
        } else if (pn < 13) {
            const int c0 = (pn - 9) * 256 + ct;
#pragma unroll
            for (int ai = 0; ai < 2; ++ai)
#pragma unroll
                for (int m = 0; m < 4; ++m) { const int r = rloc + ai * 128 + m * 16, row = u.arow + r; const bool valid = samp || (r >= 3 && row < MP); const float rr = rr8[ai][m];
                    if (valid) {
#pragma unroll
                    for (int bj = 0; bj < 2; ++bj) { const f32x4 v0 = acc[ai][bj][m][0] * rr, v1 = acc[ai][bj][m][1] * rr;
                        v4u w; w.x = cvtpk(silu_f(v0[0]), silu_f(v0[1])); w.y = cvtpk(silu_f(v0[2]), silu_f(v0[3])); w.z = cvtpk(silu_f(v1[0]), silu_f(v1[1])); w.w = cvtpk(silu_f(v1[2]), silu_f(v1[3]));
                        *(v4u*)(SZ + (size_t)row * DM + c0 + 32 * bj) = w; } } }
        } else if (samp) {
            const int c0 = (pn - 13) * 256 + ct;
#pragma unroll
            for (int ai = 0; ai < 2; ++ai)
#pragma unroll
                for (int m = 0; m < 4; ++m) { const int r = rloc + ai * 128 + m * 16, row = u.arow + r; const float rr = ssqx[u.idx * 256 + r];
                    const int rs = row - MP, b = rs >> 2, t = rs & 3; float* p = (t >= 1) ? out + O_CONVS + ((size_t)(layer * NBS + b) * 3 + (t - 1)) * XBCW + c0 : nullptr;
#pragma unroll
                    for (int bj = 0; bj < 2; ++bj) { const f32x4 v0 = acc[ai][bj][m][0] * rr, v1 = acc[ai][bj][m][1] * rr;
                        v4u w; w.x = cvtpk(v0[0], v0[1]); w.y = cvtpk(v0[2], v0[3]); w.z = cvtpk(v1[0], v1[1]); w.w = cvtpk(v1[2], v1[3]);
                        *(v4u*)(XBC + (size_t)row * XBCW + c0 + 32 * bj) = w;
                        if (p) { *(f32x4*)(p + 32 * bj) = v0; *(f32x4*)(p + 32 * bj + 4) = v1; } } }
        } else {
            const int c0 = (pn - 13) * 256 + ct;
            if (fr >= 13) {
#pragma unroll
                for (int ai = 0; ai < 2; ++ai)
#pragma unroll
                    for (int bj = 0; bj < 2; ++bj)
#pragma unroll
                        for (int n = 0; n < 2; ++n) *(LAS f32x4*)(exch + ((((wr * 4 + wc) * 2 + ai) * 3 + (fr - 13)) * 64 + fq * 16 + bj * 8 + n * 4)) = acc[ai][bj][3][n] * ssqx[u.idx * 256 + rloc + 128 * ai + 48];
            }
            { const int tid_ = (wr * 4 + wc) * 64 + fq * 16 + fr;
                if (tid_ < 320) { const int q = tid_ >> 6, c4 = tid_ & 63; const float* src = (q < 4 ? cw + q * XBCW : cb) + (pn - 13) * 256 + 4 * c4;
                    *(LAS f32x4*)(wtab + q * 256 + 4 * c4) = *(const f32x4*)src; } }
            asm volatile("s_waitcnt vmcnt(0) lgkmcnt(0)" ::: "memory"); __builtin_amdgcn_s_barrier(); asm volatile("" ::: "memory");
#pragma unroll
            for (int bj = 0; bj < 2; ++bj) { v2u keep[2][4];
                xpass<0>(acc, u, wr, wc, fr, fq, rloc, c0 + 32 * bj, bj, keep);
                xpass<1>(acc, u, wr, wc, fr, fq, rloc, c0 + 32 * bj, bj, keep); }
        }
    }
    template <int n> __device__ __forceinline__ void xpass(const f32x4 (&acc)[2][2][4][2], const pg8::Unit& u, int wr, int wc, int fr, int fq, const int rloc, const int ch8, const int bj, v2u (&keep)[2][4]) const {
        const int ch = ch8 + 4 * n;
        f32x4 w[4], bb; const int tl = ch & 255;
#pragma unroll
        for (int tp = 0; tp < 4; ++tp) w[tp] = *(const LAS f32x4*)(wtab + tp * 256 + tl);
        bb = *(const LAS f32x4*)(wtab + 4 * 256 + tl);
#pragma unroll
        for (int ai = 0; ai < 2; ++ai) {
            const int blk = 2 * ai + wr;
            f32x4 b13 = (f32x4){0.f, 0.f, 0.f, 0.f}, b14 = b13, b15 = b13;
            if (blk > 0) { const int sa = (blk - 1) >> 1, sw = (blk - 1) & 1; const LAS float* s = exch + (((sw * 4 + wc) * 2 + sa) * 3) * 64 + fq * 16 + bj * 8 + n * 4;
                b13 = *(const LAS f32x4*)(s); b14 = *(const LAS f32x4*)(s + 64); b15 = *(const LAS f32x4*)(s + 128); }
            f32x4 px = b15;
#pragma unroll
            for (int m = 0; m < 4; ++m) {
                const float rrm = ssqx[u.idx * 256 + rloc + 128 * ai + 16 * m];
                const int r = rloc + 128 * ai + 16 * m; int grow = u.arow + r; asm volatile("" : "+v"(grow));
                const int t = grow & 4095; const bool valid = (r >= 3) && (grow < MP);
                const f32x4 x0 = acc[ai][bj][m][n] * rrm; f32x4 x1, x2, x3;
#pragma unroll
                for (int i = 0; i < 4; ++i) { const float a1 = m ? dpp_ror1(px[i]) : b15[i], a2 = m ? dpp_ror2(px[i]) : ((fr == 0) ? b14[i] : b15[i]), a3 = m ? dpp_ror3(px[i]) : ((fr == 0) ? b13[i] : ((fr == 1) ? b14[i] : b15[i]));
                    x1[i] = dpp_shr1(a1, x0[i]); x2[i] = dpp_shr2(a2, x0[i]); x3[i] = dpp_shr3(a3, x0[i]); }
                px = x0;
                if (t < 3) { x3 = (f32x4){0.f, 0.f, 0.f, 0.f}; if (t < 2) { x2 = x3; if (t < 1) x1 = x3; } }
                if (n == 0) keep[ai][m] = (v2u){0u, 0u};
                if (valid) { if (t >= SEQ - 3) *(f32x4*)(out + O_CONVP + ((size_t)(layer * NBP + (grow >> 12)) * 3 + (t - (SEQ - 3))) * XBCW + ch) = x0;
                    const f32x4 y = bb + w[0] * x3 + w[1] * x2 + w[2] * x1 + w[3] * x0;
                    v2u o; o.x = cvtpk(silu_f(y[0]), silu_f(y[1])); o.y = cvtpk(silu_f(y[2]), silu_f(y[3]));
                    if (n == 0) keep[ai][m] = o;
                    else { v4u o4; o4.x = keep[ai][m].x; o4.y = keep[ai][m].y; o4.z = o.x; o4.w = o.y; *(v4u*)(XBCC + (size_t)grow * XBCW + ch8) = o4; } }
            }
        }
    }
    __device__ __forceinline__ void hook(f32x4 (&)[2][2][4][2], const pg8::Unit&, int, int, int, int) const {}
};

struct EpiOutProj {
    static constexpr bool PERM = true, AFTER_DRAIN = false, INIT_ACC = true, KSCALE = true; static constexpr int HOOK_T = -1;
    const LAS float* rstd; const LAS float* ftab; bf16* xb; float* ssqx;
    __device__ __forceinline__ void init(f32x4 (&acc)[2][2][4][2], const pg8::Unit& u, int wr, int wc, int fr, int fq) const {
        const int rbase = u.pm * 256 + wr * 64 + fr, col0 = u.pn * 256 + wc * 32 + 8 * fq;
#pragma unroll
        for (int ai = 0; ai < 2; ++ai)
#pragma unroll
            for (int m = 0; m < 4; ++m) { const int row = rbase + ai * 128 + m * 16; const bf16* bp = xb + (size_t)row * DM; const float sc = 1.f / rstd[wr * 64 + fr + 128 * ai + 16 * m];
#pragma unroll
                for (int bj = 0; bj < 2; ++bj) { const v4u w = *(const v4u*)(bp + col0 + 128 * bj);
                    acc[ai][bj][m][0] = (f32x4){bflo(w.x), bfhi(w.x), bflo(w.y), bfhi(w.y)} * sc; acc[ai][bj][m][1] = (f32x4){bflo(w.z), bfhi(w.z), bflo(w.w), bfhi(w.w)} * sc; } }
    }
    __device__ __forceinline__ void kscale(f32x4 (&acc)[2][2][4][2], const pg8::Unit&, const int ai, const int k, int wr, int wc, int fr, int fq) const {
        if (k >= 16 && k < 28) { const LAS float* f = ftab + (k - 16) * 256 + wr * 64 + fr + 128 * ai;
#pragma unroll
            for (int m = 0; m < 4; ++m) { const float s = f[16 * m];
#pragma unroll
                for (int bj = 0; bj < 2; ++bj)
#pragma unroll
                    for (int n = 0; n < 2; ++n) acc[ai][bj][m][n] = acc[ai][bj][m][n] * s; } }
    }
    __device__ __forceinline__ void operator()(const f32x4 (&acc)[2][2][4][2], const pg8::Unit& u, int wr, int wc, int fr, int fq) const {
        const int rbase = u.pm * 256 + wr * 64 + fr, col0 = u.pn * 256 + wc * 32 + 8 * fq;
#pragma unroll
        for (int ai = 0; ai < 2; ++ai)
#pragma unroll
            for (int m = 0; m < 4; ++m) { const int row = rbase + ai * 128 + m * 16; const float fin = ftab[12 * 256 + wr * 64 + fr + 128 * ai + 16 * m];
                float ss = 0.f;
#pragma unroll
                for (int bj = 0; bj < 2; ++bj) { const int c = col0 + 128 * bj;
                    const f32x4 o0 = acc[ai][bj][m][0] * fin, o1 = acc[ai][bj][m][1] * fin;
                    ss += ((o0[0] * o0[0] + o0[1] * o0[1]) + (o0[2] * o0[2] + o0[3] * o0[3])) + ((o1[0] * o1[0] + o1[1] * o1[1]) + (o1[2] * o1[2] + o1[3] * o1[3]));
                    v4u w; w.x = cvtpk(o0[0], o0[1]); w.y = cvtpk(o0[2], o0[3]); w.z = cvtpk(o1[0], o1[1]); w.w = cvtpk(o1[2], o1[3]);
                    *(v4u*)(xb + (size_t)row * DM + c) = w; }
                ss += __shfl_xor(ss, 16); ss += __shfl_xor(ss, 32);
                if (fq == 0) ssqx[(size_t)row * 16 + 4 * u.pn + wc] = ss; }
    }
    __device__ __forceinline__ void hook(f32x4 (&)[2][2][4][2], const pg8::Unit&, int, int, int, int) const {}
};
template <class Sched> __device__ __forceinline__ void prefill_outproj(LAS float* rstd, LAS float* ftab, const Sched& S, const float* ssqp, const float* lse, int tid) {
    pg8::Unit u;
    if (S.next(0, u) && tid < 256) { const size_t row = (size_t)u.arow + tid;
        const float rs = rstd16(ssqp + row * 16); rstd[tid] = rs;
        const f32x4* lp = (const f32x4*)(lse + row * 12); const f32x4 l0 = lp[0], l1 = lp[1], l2 = lp[2];
        float al[12];
#pragma unroll
        for (int s = 0; s < 4; ++s) { const float a = l0[s], b = l1[s], c = l2[s], mx = fmaxf(a, fmaxf(b, c)); const float e0 = __expf(a - mx), e1 = __expf(b - mx), e2 = __expf(c - mx), inv = 1.f / (e0 + e1 + e2);
            al[s] = fmaxf(e0 * inv, 1e-30f); al[4 + s] = fmaxf(e1 * inv, 1e-30f); al[8 + s] = fmaxf(e2 * inv, 1e-30f); }
        ftab[tid] = rs / al[0];
#pragma unroll
        for (int h = 1; h < 12; ++h) ftab[h * 256 + tid] = al[h - 1] / al[h];
        ftab[12 * 256 + tid] = al[11]; }
    __syncthreads();
}

struct Args { const float* in[24]; float* out; unsigned char* ws; int ph_lo, ph_hi; };
struct Frame {
    LAS unsigned char* lds;
    volatile LAS unsigned* MISC;
    gu32* ctl;
    int tid, lane, wave, vcu, G;
    const Args* a;
};
enum { I_XP = 0, I_XS, I_KV0, I_KV1, I_KV2, I_SSM, I_CONV, I_FFNC, I_NMIX, I_WIN, I_QN, I_KN, I_CW, I_CB, I_DTB, I_ALOG, I_DSKIP, I_SNORM, I_WOUT, I_NFFN, I_WUP, I_FCW, I_FCB, I_WDN };

struct P0Item { const float* W; int ldw, sk0, sn0; bf16* WT; int ldk, dk0, dn0; const float* kscale; };
__device__ __forceinline__ void p0_decode(Frame& F, int it, P0Item& I) {
    constexpr int I_IN = 16 * (NIN / 32), I_OUT = 28 * (DM / 32), I_UP = 16 * (FF2 / 32), I_DN = 44 * (DM / 32), PER_L = I_IN + I_OUT + I_UP + I_DN;
    const int L = it / PER_L; int r = it % PER_L;
    if (r < I_IN) { const int nb = r % (NIN / 32), kb = r / (NIN / 32), n0 = nb * 32, pn = n0 >> 8, rr = n0 & 255, bj = rr >> 7, wc = (rr & 127) >> 5;
        I = P0Item{F.a->in[I_WIN] + (size_t)L * DM * INW, INW, kb * 64, 256 * pn + 64 * wc + 32 * bj, ((bf16*)(F.a->ws + WS_WIN)) + (size_t)L * NIN * DM, DM, kb * 64, n0, F.a->in[I_NMIX] + L * DM + kb * 64}; return; }
    r -= I_IN;
    if (r < I_OUT) { const int nb = r % (DM / 32), kb = r / (DM / 32), dk0 = kb * 64, sk0 = dk0 < 1024 ? 768 + dk0 : dk0 - 1024;
        I = P0Item{F.a->in[I_WOUT] + (size_t)L * MIXW * DM, DM, sk0, nb * 32, ((bf16*)(F.a->ws + WS_WOUT)) + (size_t)L * DM * MIXW, MIXW, dk0, nb * 32, dk0 < 1024 ? F.a->in[I_SNORM] + L * DM + dk0 : nullptr}; return; }
    r -= I_OUT;
    if (r < I_UP) { const int nb = r % (FF2 / 32), kb = r / (FF2 / 32), n0 = nb * 32, pn = n0 >> 8, rr = n0 & 255, bj = rr >> 7, r2 = rr & 127;
        I = P0Item{F.a->in[I_WUP] + (size_t)L * DM * FF2, FF2, kb * 64, bj * FF + 128 * pn + r2, ((bf16*)(F.a->ws + WS_WUP)) + (size_t)L * FF2 * DM, DM, kb * 64, n0, F.a->in[I_NFFN] + L * DM + kb * 64}; return; }
    r -= I_UP;
    { const int nb = r % (DM / 32), kb = r / (DM / 32);
        I = P0Item{F.a->in[I_WDN] + (size_t)L * FF * DM, DM, kb * 64, nb * 32, ((bf16*)(F.a->ws + WS_WDN)) + (size_t)L * DM * FF, FF, kb * 64, nb * 32, nullptr}; }
}
__device__ __forceinline__ void p0_load(const P0Item& I, f32x4 (&v)[8], int lane) {
    const int c4 = lane & 7, kr = lane >> 3;
#pragma unroll
    for (int i = 0; i < 8; ++i) v[i] = __builtin_nontemporal_load((const f32x4*)(I.W + (size_t)(I.sk0 + 8 * i + kr) * I.ldw + I.sn0 + 4 * c4));
}
__device__ __forceinline__ void p0_store(const P0Item& I, const f32x4 (&v)[8], LAS float* scr, int lane) {
    constexpr int TP = 36;
    const int c4 = lane & 7, kr = lane >> 3;
#pragma unroll
    for (int i = 0; i < 8; ++i) { const int k = 8 * i + kr; f32x4 x = v[i]; if (I.kscale) x = x * I.kscale[k];
        *(LAS f32x4*)(scr + k * TP + 4 * (c4 ^ i)) = x; }
    LDS_WAIT(); asm volatile("" ::: "memory");
    const int kc = lane & 7, nr = lane >> 3;
#pragma unroll
    for (int j = 0; j < 4; ++j) { const int n = nr + 8 * j; const LAS float* s = scr + (8 * kc) * TP + (n ^ (kc << 2));
        v4u o; o.x = cvtpk(s[0 * TP], s[1 * TP]); o.y = cvtpk(s[2 * TP], s[3 * TP]); o.z = cvtpk(s[4 * TP], s[5 * TP]); o.w = cvtpk(s[6 * TP], s[7 * TP]);
        *(GAS v4u*)(I.WT + (size_t)(I.dn0 + n) * I.ldk + I.dk0 + 8 * kc) = o; }
    LDS_WAIT(); asm volatile("" ::: "memory");
}
__device__ __forceinline__ void p0_prologue(Frame& F) {
    LAS float* scr = (LAS float*)(F.lds + RING_OFF + F.wave * 16384);
    const int gwv = F.vcu * NWAVES + F.wave, NGW = F.G * NWAVES;
    constexpr int NIT = 2 * (16 * (NIN / 32) + 28 * (DM / 32) + 16 * (FF2 / 32) + 44 * (DM / 32));
    P0Item cur, nxt; f32x4 va[8], vb[8];
    int it = gwv; if (it >= NIT) return;
    p0_decode(F, it, cur); p0_load(cur, va, F.lane);
#pragma unroll 1
    for (;;) {
        const int i1 = it + NGW; const bool h1 = i1 < NIT;
        if (h1) { p0_decode(F, i1, nxt); p0_load(nxt, vb, F.lane); }
        p0_store(cur, va, scr, F.lane);
        if (!h1) break;
        const int i2 = i1 + NGW; const bool h2 = i2 < NIT;
        if (h2) { p0_decode(F, i2, cur); p0_load(cur, va, F.lane); }
        p0_store(nxt, vb, scr, F.lane);
        if (!h2) break;
        it = i2;
    }
}

__device__ __forceinline__ void p0_prep(Frame& F) {
    const int gt = F.vcu * NWAVES * 64 + F.tid, nthr = F.G * NWAVES * 64;
    for (int i = gt; i < 2 * 16 * DM; i += nthr) { const int L = i >> 14, j = (i >> 10) & 15, k = i & 1023;
        ((bf16*)(F.a->ws + WS_WDT))[i] = (bf16)f2bf(F.a->in[I_WIN][((size_t)L * DM + k) * INW + NIN + j] * F.a->in[I_NMIX][L * DM + k]); }
    const int gwv = F.vcu * NWAVES + F.wave, NGW = F.G * NWAVES, lane = F.lane;
    for (int row0 = gwv; row0 < MT; row0 += 4 * NGW) {
        f32x4 v[4][4];
#pragma unroll
        for (int k = 0; k < 4; ++k) { const int row = row0 + k * NGW; const int rc = row < MT ? row : 0;
            const float* xr = rc < MP ? F.a->in[I_XP] + (size_t)rc * DM : F.a->in[I_XS] + (size_t)(rc - MP) * DM;
#pragma unroll
            for (int j = 0; j < 4; ++j) v[k][j] = __builtin_nontemporal_load((const f32x4*)(xr + 4 * lane + 256 * j)); }
#pragma unroll
        for (int k = 0; k < 4; ++k) { const int row = row0 + k * NGW; if (row >= MT) break;
#pragma unroll
            for (int j = 0; j < 4; ++j) { const f32x4 x = v[k][j];
                float s = (x[0] * x[0] + x[1] * x[1]) + (x[2] * x[2] + x[3] * x[3]);
                s = red16(s);
                v2u o; o.x = cvtpk(x[0], x[1]); o.y = cvtpk(x[2], x[3]);
                *(v2u*)(((bf16*)(F.a->ws + WS_XN)) + (size_t)row * DM + 4 * lane + 256 * j) = o;
                if ((lane & 15) == 0) ((float*)(F.a->ws + WS_SSQX))[(size_t)row * 16 + 4 * j + (lane >> 4)] = s; } }
    }
}
__device__ __forceinline__ void dt_phase(Frame& F, int L) {
    const int gwv = F.vcu * NWAVES + F.wave, NGW = F.G * NWAVES, lane = F.lane, fr = lane & 15, fq = lane >> 4;
    const bf16* W = ((const bf16*)(F.a->ws + WS_WDT)) + (size_t)L * 16 * DM + (size_t)fr * DM + 8 * fq;
    const f32x4 bias = *(const f32x4*)(F.a->in[I_DTB] + L * 16 + 4 * fq);
    for (int blk = gwv; blk < MT / 16; blk += NGW) {
        const bf16* X = ((const bf16*)(F.a->ws + WS_XN)) + (size_t)(16 * blk + fr) * DM + 8 * fq;
        f32x4 acc = (f32x4){0.f, 0.f, 0.f, 0.f};
#pragma unroll 16
        for (int s = 0; s < 32; ++s) acc = mfma16(*(const bf16x8*)(W + 32 * s), *(const bf16x8*)(X + 32 * s), acc);
        const size_t row = (size_t)16 * blk + fr; const float rr = rstd16(((const float*)(F.a->ws + WS_SSQX)) + row * 16);
        f32x4 o; o[0] = softplus_f(acc[0] * rr + bias[0]); o[1] = softplus_f(acc[1] * rr + bias[1]); o[2] = softplus_f(acc[2] * rr + bias[2]); o[3] = softplus_f(acc[3] * rr + bias[3]);
        *(f32x4*)(((float*)(F.a->ws + WS_DT)) + row * 16 + 4 * fq) = o;
    }
}

constexpr int AT_PITCH = 144, AT_K = 0, AT_V = 256 * AT_PITCH, AT_BYTES = AT_V + 272 * AT_PITCH;
struct AttnRegs { v4u kr[4], vr[4]; bf16x8 q[2]; };
__device__ __forceinline__ void attn_prompt_load(Frame& F, int v, AttnRegs& R, int tid) {
    const int b = v / 384, hd = (v / 32) % 12, blk = v & 31;
    const int g = hd >> 2, d = 1 << (2 * g), nb = 32 >> (2 * g), r = blk / nb, n = blk % nb;
    const int lane = tid & 63, w = tid >> 6, fr = lane & 15, fq = lane >> 4;
    const bf16* KBp = (const bf16*)(F.a->ws + WS_KB); const bf16* VBp = (const bf16*)(F.a->ws + WS_VB); const bf16* QBp = (const bf16*)(F.a->ws + WS_QB);
#pragma unroll
    for (int i = 0; i < 4; ++i) { const int c = tid + 512 * i, j = c >> 3, ch = c & 7; const int np = n - 1 + (j >> 7);
        R.kr[i] = (v4u){0u, 0u, 0u, 0u}; R.vr[i] = (v4u){0u, 0u, 0u, 0u};
        if (np >= 0) { const size_t row = (size_t)b * SEQ + (size_t)(np * 128 + (j & 127)) * d + r; R.kr[i] = *(const v4u*)(KBp + row * NQ + hd * 64 + ch * 8); R.vr[i] = *(const v4u*)(VBp + row * NQ + hd * 64 + ch * 8); } }
    const int iq = 16 * w + fr; const size_t qrow = (size_t)b * SEQ + (size_t)(n * 128 + iq) * d + r;
#pragma unroll
    for (int ks = 0; ks < 2; ++ks) R.q[ks] = *(const bf16x8*)(QBp + qrow * NQ + hd * 64 + 32 * ks + 8 * fq);
}
constexpr int SA_B = 8;
struct SaTask { f32x4 q, o; float m, l, slope2; const float* cache; int t, dil, Lc, nnew, jb, g, hs; size_t row; bool on, pend; f32x4 kk[SA_B], vv[SA_B]; };
__device__ __forceinline__ void sa_begin(Frame& F, int L, int v, bool on, SaTask& T) {
    T.on = on; T.pend = false; T.jb = 0; if (!on) return;
    const int b = v / 12, g = (v >> 2) % 3, t = v & 3, lane = F.lane;
    T.g = g; T.t = t; T.dil = 1 << (2 * g); T.Lc = 128 << (2 * g); T.hs = lane >> 4; T.row = (size_t)MP + b * TS + t;
    const float* const ck0 = F.a->in[I_KV0]; const float* const ck1 = F.a->in[I_KV1]; const float* const ck2 = F.a->in[I_KV2];
    T.cache = (g == 0 ? ck0 : (g == 1 ? ck1 : ck2)) + ((size_t)(L * NBS + b) * T.Lc) * 512;
    T.slope2 = exp2f(-8.f * (float)(4 * g + T.hs + 1) / 12.f) * LOG2E * (float)T.dil;
    const bf16* QBp = (const bf16*)(F.a->ws + WS_QB); const bf16* KBp = (const bf16*)(F.a->ws + WS_KB); const bf16* VBp = (const bf16*)(F.a->ws + WS_VB);
    { const v2u w = *(const v2u*)(QBp + T.row * NQ + 256 * g + 4 * lane); T.q = (f32x4){bflo(w.x), bfhi(w.x), bflo(w.y), bfhi(w.y)}; }
    T.m = -1e30f; T.l = 0.f; T.o = (f32x4){0.f, 0.f, 0.f, 0.f};
    T.nnew = (g == 0) ? t + 1 : 1;
    v2u kw[4], vw[4];
#pragma unroll
    for (int j = 0; j < 4; ++j) { const size_t kr = (size_t)MP + b * TS + (j < T.nnew ? t - j : t); kw[j] = *(const v2u*)(KBp + kr * NQ + 256 * g + 4 * lane); vw[j] = *(const v2u*)(VBp + kr * NQ + 256 * g + 4 * lane); }
#pragma unroll
    for (int j = 0; j < 4; ++j) { float sc = (T.q[0] * bflo(kw[j].x) + T.q[1] * bfhi(kw[j].x)) + (T.q[2] * bflo(kw[j].y) + T.q[3] * bfhi(kw[j].y));
        sc = red16(sc);
        sc = (j < T.nnew) ? sc - T.slope2 * (float)j : -1e30f;
        const float mn = fmaxf(T.m, sc), scale = exp2f(T.m - mn), p = exp2f(sc - mn);
        T.l = T.l * scale + p; T.o = T.o * scale + (f32x4){bflo(vw[j].x), bfhi(vw[j].x), bflo(vw[j].y), bfhi(vw[j].y)} * p; T.m = mn; }
}
__device__ __forceinline__ void sa_issue(Frame& F, SaTask& T) {
    const int lane = F.lane;
#pragma unroll
    for (int u = 0; u < SA_B; ++u) { const int j = T.jb + u + T.nnew; int cr = T.Lc + T.t - j * T.dil; cr = cr < 0 ? 0 : cr;
        const float* p = T.cache + (size_t)cr * 512 + 4 * lane; T.kk[u] = __builtin_nontemporal_load((const f32x4*)p); T.vv[u] = __builtin_nontemporal_load((const f32x4*)(p + 256)); }
    T.pend = true;
}
__device__ __forceinline__ void sa_consume(SaTask& T) {
    float sc[SA_B]; float mb = -1e30f;
#pragma unroll
    for (int u = 0; u < SA_B; ++u) { const int j = T.jb + u + T.nnew; float x = (T.q[0] * T.kk[u][0] + T.q[1] * T.kk[u][1]) + (T.q[2] * T.kk[u][2] + T.q[3] * T.kk[u][3]);
        x = red16(x);
        x = (j <= 128) ? x - T.slope2 * (float)j : -1e30f; sc[u] = x; mb = fmaxf(mb, x); }
    const float mn = fmaxf(T.m, mb), scale = exp2f(T.m - mn); T.l *= scale; T.o = T.o * scale;
#pragma unroll
    for (int u = 0; u < SA_B; ++u) { const float p = exp2f(sc[u] - mn); T.l += p; T.o = T.o + T.vv[u] * p; }
    T.m = mn; T.jb += SA_B; T.pend = false;
}
__device__ __forceinline__ void sa_step(Frame& F, SaTask& T) { if (T.on) { if (T.pend) sa_consume(T); if (T.jb < 128) sa_issue(F, T); } }
__device__ __forceinline__ void sa_finish(Frame& F, SaTask& T) {
    if (!T.on) return;
#pragma unroll 1
    while (T.pend || T.jb < 128) { if (T.pend) sa_consume(T); if (T.jb < 128) sa_issue(F, T); }
    const int lane = F.lane; const float inv = 1.f / T.l;
    v2u ow; ow.x = cvtpk(T.o[0] * inv, T.o[1] * inv); ow.y = cvtpk(T.o[2] * inv, T.o[3] * inv);
    *(v2u*)(((bf16*)(F.a->ws + WS_ATTO)) + T.row * NQ + 256 * T.g + 4 * lane) = ow;
    if ((lane & 15) == 0) ((float*)(F.a->ws + WS_LSE))[T.row * 12 + 4 * T.g + T.hs] = (T.m + log2f(T.l)) * LN2;
}
__device__ __forceinline__ void attn_prompt_units(Frame& F, int first, int stride, int total, SaTask& T) {
    LAS char* Ks = (LAS char*)(F.lds + RING_OFF + AT_K); LAS char* Vs = (LAS char*)(F.lds + RING_OFF + AT_V);
    const int tid = F.tid, lane = F.lane, w = F.wave, fr = lane & 15, fq = lane >> 4;
    if (first >= total) return;
    if (tid < 128) { const int j = 256 + (tid >> 3), ch = tid & 7; *(LAS v4u*)(Vs + j * AT_PITCH + ch * 16) = (v4u){0u, 0u, 0u, 0u}; }
    AttnRegs R; attn_prompt_load(F, first, R, tid);
#pragma unroll 1
    for (int v = first; v < total; v += stride) {
        const int b = v / 384, hd = (v / 32) % 12, blk = v & 31;
        const int g = hd >> 2, d = 1 << (2 * g), nb = 32 >> (2 * g), r = blk / nb, n = blk % nb;
#pragma unroll
        for (int i = 0; i < 4; ++i) { const int c = tid + 512 * i, j = c >> 3, ch = c & 7; *(LAS v4u*)(Ks + j * AT_PITCH + ch * 16) = R.kr[i]; *(LAS v4u*)(Vs + j * AT_PITCH + ch * 16) = R.vr[i]; }
        bf16x8 qf[2]; qf[0] = R.q[0]; qf[1] = R.q[1];
        __syncthreads();
        if (v + stride < total) { int tl = tid; asm volatile("" : "+v"(tl)); attn_prompt_load(F, v + stride, R, tl); }
        sa_step(F, T);
        const int iq = 16 * w + fr; const size_t qrow = (size_t)b * SEQ + (size_t)(n * 128 + iq) * d + r;
        const float slope2 = exp2f(-8.f * (float)(hd + 1) / 12.f) * LOG2E * (float)d;
        int ibase = fr - 4 * fq + 128; asm volatile("" : "+v"(ibase));
        const float sb = slope2 * (float)ibase; const int dead = (n == 0) ? 8 - w : 0;
        float mx = -1e30f;
#pragma unroll
        for (int tt = 0; tt < 9; ++tt) { f32x4 a;
#pragma unroll
            for (int e = 0; e < 4; ++e) a[e] = fmaf(slope2, (float)(16 * tt + e), tt < dead ? -1e30f : -sb);
#pragma unroll
            for (int ks = 0; ks < 2; ++ks) { const bf16x8 kf = *(const LAS bf16x8*)(Ks + (16 * (w + tt) + fr) * AT_PITCH + (32 * ks + 8 * fq) * 2); a = mfma16(kf, qf[ks], a); }
            if (tt == 0 || tt == 8) {
#pragma unroll
                for (int e = 0; e < 4; ++e) { const bool valid = (unsigned)(ibase - (16 * tt + e)) <= 128u; mx = fmaxf(mx, valid ? a[e] : -1e30f); } }
            else {
#pragma unroll
                for (int e = 0; e < 4; ++e) mx = fmaxf(mx, a[e]); } }
        mx = fmaxf(mx, __shfl_xor(mx, 16)); mx = fmaxf(mx, __shfl_xor(mx, 32));
        const float sm = sb + mx;
        float l = 0.f; f32x4 o[4];
#pragma unroll
        for (int dt = 0; dt < 4; ++dt) o[dt] = (f32x4){0.f, 0.f, 0.f, 0.f};
#pragma unroll
        for (int s5 = 0; s5 < 5; ++s5) {
            f32x4 pp[2];
#pragma unroll
            for (int u = 0; u < 2; ++u) { const int tt = 2 * s5 + u; f32x4 a = (f32x4){0.f, 0.f, 0.f, 0.f};
                if (tt < 9) {
#pragma unroll
                    for (int e = 0; e < 4; ++e) a[e] = fmaf(slope2, (float)(16 * tt + e), tt < dead ? -1e30f : -sm);
#pragma unroll
                    for (int ks = 0; ks < 2; ++ks) { const bf16x8 kf = *(const LAS bf16x8*)(Ks + (16 * (w + tt) + fr) * AT_PITCH + (32 * ks + 8 * fq) * 2); a = mfma16(kf, qf[ks], a); }
                    if (tt == 0 || tt == 8) {
#pragma unroll
                        for (int e = 0; e < 4; ++e) { const bool valid = (unsigned)(ibase - (16 * tt + e)) <= 128u; const float p = valid ? exp2f(a[e]) : 0.f; a[e] = p; l += p; } }
                    else {
#pragma unroll
                        for (int e = 0; e < 4; ++e) { const float p = exp2f(a[e]); a[e] = p; l += p; } } }
                pp[u] = a; }
            bf16x8 pf; { v4u t; t.x = cvtpk(pp[0][0], pp[0][1]); t.y = cvtpk(pp[0][2], pp[0][3]); t.z = cvtpk(pp[1][0], pp[1][1]); t.w = cvtpk(pp[1][2], pp[1][3]); pf = __builtin_bit_cast(bf16x8, t); }
            const int k0 = 16 * (w + 2 * s5) + 4 * fq + ((lane & 15) >> 2);
#pragma unroll
            for (int dt = 0; dt < 4; ++dt) { const LAS char* p0 = Vs + k0 * AT_PITCH + (16 * dt + 4 * (lane & 3)) * 2; o[dt] = mfma16(tr2(p0, p0 + 16 * AT_PITCH), pf, o[dt]); }
        }
        l += __shfl_xor(l, 16); l += __shfl_xor(l, 32);
        const float inv = 1.f / l;
#pragma unroll
        for (int dt = 0; dt < 4; ++dt) { v2u t; t.x = cvtpk(o[dt][0] * inv, o[dt][1] * inv); t.y = cvtpk(o[dt][2] * inv, o[dt][3] * inv); *(v2u*)(((bf16*)(F.a->ws + WS_MIX)) + qrow * MIXW + 1024 + hd * 64 + 16 * dt + 4 * fq) = t; }
        if (fq == 0) ((float*)(F.a->ws + WS_LSE))[qrow * 12 + hd] = (mx + log2f(l)) * LN2;
        sa_step(F, T);
        __syncthreads();
    }
}

__device__ __forceinline__ void attn_sample_task(Frame& F, int L, int b, int g, int t) {
    const int lane = F.lane, dil = 1 << (2 * g), Lc = 128 << (2 * g), hs = lane >> 4;
    const size_t row = (size_t)MP + b * TS + t;
    const float* const ck0 = F.a->in[I_KV0]; const float* const ck1 = F.a->in[I_KV1]; const float* const ck2 = F.a->in[I_KV2];
    const float* cache = (g == 0 ? ck0 : (g == 1 ? ck1 : ck2)) + ((size_t)(L * NBS + b) * Lc) * 512;
    const float slope2 = exp2f(-8.f * (float)(4 * g + hs + 1) / 12.f) * LOG2E * (float)dil;
    f32x4 q; { const v2u w = *(const v2u*)(((bf16*)(F.a->ws + WS_QB)) + row * NQ + 256 * g + 4 * lane); q = (f32x4){bflo(w.x), bfhi(w.x), bflo(w.y), bfhi(w.y)}; }
    float m = -1e30f, l = 0.f; f32x4 o = (f32x4){0.f, 0.f, 0.f, 0.f};
    const int nnew = (g == 0) ? t + 1 : 1;
    for (int j = 0; j < nnew; ++j) { const size_t kr = (size_t)MP + b * TS + (t - j);
        const v2u kw = *(const v2u*)(((bf16*)(F.a->ws + WS_KB)) + kr * NQ + 256 * g + 4 * lane), vw = *(const v2u*)(((bf16*)(F.a->ws + WS_VB)) + kr * NQ + 256 * g + 4 * lane);
        float sc = (q[0] * bflo(kw.x) + q[1] * bfhi(kw.x)) + (q[2] * bflo(kw.y) + q[3] * bfhi(kw.y));
        sc = red16(sc);
        sc -= slope2 * (float)j;
        const float mn = fmaxf(m, sc), scale = exp2f(m - mn), p = exp2f(sc - mn);
        l = l * scale + p; o = o * scale + (f32x4){bflo(vw.x), bfhi(vw.x), bflo(vw.y), bfhi(vw.y)} * p; m = mn; }
#define SA_LOAD(kk, vv, jb) do { _Pragma("unroll") for (int u = 0; u < 8; ++u) { const int j = (jb) + u + nnew; int cr = Lc + t - j * dil; cr = cr < 0 ? 0 : cr; \
        const float* p = cache + (size_t)cr * 512 + 4 * lane; kk[u] = __builtin_nontemporal_load((const f32x4*)p); vv[u] = __builtin_nontemporal_load((const f32x4*)(p + 256)); } } while (0)
#define SA_COMP(kk, vv, jb) do { float sc[8]; float mb = -1e30f; \
        _Pragma("unroll") for (int u = 0; u < 8; ++u) { const int j = (jb) + u + nnew; float x = (q[0] * kk[u][0] + q[1] * kk[u][1]) + (q[2] * kk[u][2] + q[3] * kk[u][3]); \
            x = red16(x); \
            x = (j <= 128) ? x - slope2 * (float)j : -1e30f; sc[u] = x; mb = fmaxf(mb, x); } \
        const float mn = fmaxf(m, mb), scale = exp2f(m - mn); l *= scale; o = o * scale; \
        _Pragma("unroll") for (int u = 0; u < 8; ++u) { const float p = exp2f(sc[u] - mn); l += p; o = o + vv[u] * p; } \
        m = mn; } while (0)
    { f32x4 kA[8], vA[8], kB[8], vB[8];
        SA_LOAD(kA, vA, 0);
#pragma unroll 1
        for (int jb = 0; jb < 128; jb += 16) {
            SA_LOAD(kB, vB, jb + 8);
            SA_COMP(kA, vA, jb);
            if (jb + 16 < 128) SA_LOAD(kA, vA, jb + 16);
            SA_COMP(kB, vB, jb + 8);
        } }
#undef SA_LOAD
#undef SA_COMP
    const float inv = 1.f / l;
    v2u ow; ow.x = cvtpk(o[0] * inv, o[1] * inv); ow.y = cvtpk(o[2] * inv, o[3] * inv);
    *(v2u*)(((bf16*)(F.a->ws + WS_ATTO)) + row * NQ + 256 * g + 4 * lane) = ow;
    if ((lane & 15) == 0) ((float*)(F.a->ws + WS_LSE))[row * 12 + 4 * g + hs] = (m + log2f(l)) * LN2;
}

template <int NR> __device__ __forceinline__ void alpha_rows(Frame& F, int row0, int rstride) {
    const int lane = F.lane; const float* LSEp = (const float*)(F.a->ws + WS_LSE); const bf16* AO = (const bf16*)(F.a->ws + WS_ATTO); bf16* MX = (bf16*)(F.a->ws + WS_MIX);
    float al[NR][2]; v4u x[NR][2];
#pragma unroll
    for (int k = 0; k < NR; ++k) { const int row = row0 + k * rstride; const bool rv = row < MT; const float* ls = LSEp + (size_t)(rv ? row : 0) * 12;
#pragma unroll
        for (int rep = 0; rep < 2; ++rep) { const int c = lane + 64 * rep, cc = c < 96 ? c : 0, hd = cc >> 3, slot = hd & 3; const float l0 = ls[slot], l1 = ls[4 + slot], l2 = ls[8 + slot], mx = fmaxf(l0, fmaxf(l1, l2));
            const float e0 = __expf(l0 - mx), e1 = __expf(l1 - mx), e2 = __expf(l2 - mx); al[k][rep] = (hd < 4 ? e0 : (hd < 8 ? e1 : e2)) / (e0 + e1 + e2);
            x[k][rep] = *(const v4u*)(AO + (size_t)(rv ? row : 0) * NQ + 8 * cc); } }
#pragma unroll
    for (int k = 0; k < NR; ++k) { const int row = row0 + k * rstride;
#pragma unroll
        for (int rep = 0; rep < 2; ++rep) { const int c = lane + 64 * rep; const float a_ = al[k][rep]; const v4u v = x[k][rep]; v4u y;
            y.x = cvtpk(bflo(v.x) * a_, bfhi(v.x) * a_); y.y = cvtpk(bflo(v.y) * a_, bfhi(v.y) * a_); y.z = cvtpk(bflo(v.z) * a_, bfhi(v.z) * a_); y.w = cvtpk(bflo(v.w) * a_, bfhi(v.w) * a_);
            if (c < 96 && row < MT) *(v4u*)(MX + (size_t)row * MIXW + 1024 + 8 * c) = y; } }
}

constexpr int S1_BP = 272, S1_XP = 528, S1_B = 0, S1_X = 128 * S1_BP, S1_W = S1_X + 128 * S1_XP, S1_BYTES = S1_W + 8 * 128 * 4;
static_assert(S1_BYTES <= RING_BYTES, "ssd1 lds");
__device__ __forceinline__ void ssd1_ld(const bf16* XBC, size_t row0, int dj, bool ok, int ch0, float (&x)[8]) {
    v4u v = (v4u){0u, 0u, 0u, 0u}; if (ok) v = *(const v4u*)(XBC + (size_t)((long)row0 + dj) * XBCW + ch0);
    x[0] = bflo(v.x); x[1] = bfhi(v.x); x[2] = bflo(v.y); x[3] = bfhi(v.y); x[4] = bflo(v.z); x[5] = bfhi(v.z); x[6] = bflo(v.w); x[7] = bfhi(v.w);
}
__device__ __forceinline__ void ssd1_conv_item(Frame& F, int L, int b, int c, int ch0, int j0, int mode  , int lcol  , int hh  ) {
    const float* cw = F.a->in[I_CW] + (size_t)L * 4 * XBCW + ch0; const float* cb = F.a->in[I_CB] + (size_t)L * XBCW + ch0;
    float w[4][8], bias[8];
#pragma unroll
    for (int tp = 0; tp < 4; ++tp) { const f32x4 a = *(const f32x4*)(cw + tp * XBCW), bq = *(const f32x4*)(cw + tp * XBCW + 4);
        w[tp][0] = a[0]; w[tp][1] = a[1]; w[tp][2] = a[2]; w[tp][3] = a[3]; w[tp][4] = bq[0]; w[tp][5] = bq[1]; w[tp][6] = bq[2]; w[tp][7] = bq[3]; }
    { const f32x4 a = *(const f32x4*)cb, bq = *(const f32x4*)(cb + 4); bias[0] = a[0]; bias[1] = a[1]; bias[2] = a[2]; bias[3] = a[3]; bias[4] = bq[0]; bias[5] = bq[1]; bias[6] = bq[2]; bias[7] = bq[3]; }
    const size_t row0 = (size_t)b * SEQ + c * 128 + j0;
    float x3[8], x2[8], x1[8], x0[8];
    ssd1_ld(((bf16*)(F.a->ws + WS_XBC)), row0, -3, c > 0 || j0 - 3 >= 0, ch0, x3); ssd1_ld(((bf16*)(F.a->ws + WS_XBC)), row0, -2, c > 0 || j0 - 2 >= 0, ch0, x2); ssd1_ld(((bf16*)(F.a->ws + WS_XBC)), row0, -1, c > 0 || j0 - 1 >= 0, ch0, x1);
    LAS char* Bs = (LAS char*)(F.lds + RING_OFF + S1_B); LAS char* Xs = (LAS char*)(F.lds + RING_OFF + S1_X); const LAS float* Ws = (const LAS float*)(F.lds + RING_OFF + S1_W);
#pragma unroll 8
    for (int j = 0; j < 16; ++j) {
        ssd1_ld(((bf16*)(F.a->ws + WS_XBC)), row0, j, true, ch0, x0); float y[8];
#pragma unroll
        for (int e = 0; e < 8; ++e) y[e] = silu_f(bias[e] + w[0][e] * x3[e] + w[1][e] * x2[e] + w[2][e] * x1[e] + w[3][e] * x0[e]);
        v4u o; o.x = cvtpk(y[0], y[1]); o.y = cvtpk(y[2], y[3]); o.z = cvtpk(y[4], y[5]); o.w = cvtpk(y[6], y[7]);
        *(v4u*)(((bf16*)(F.a->ws + WS_XBCC)) + (row0 + j) * XBCW + ch0) = o;
        if (mode == 0) *(LAS v4u*)(Bs + (j0 + j) * S1_BP + lcol * 2) = o;
        else if (mode == 2) { const float wt = Ws[hh * 128 + j0 + j]; v4u q; q.x = cvtpk(y[0] * wt, y[1] * wt); q.y = cvtpk(y[2] * wt, y[3] * wt); q.z = cvtpk(y[4] * wt, y[5] * wt); q.w = cvtpk(y[6] * wt, y[7] * wt);
            *(LAS v4u*)(Xs + (j0 + j) * S1_XP + lcol * 2) = q; }
#pragma unroll
        for (int e = 0; e < 8; ++e) { x3[e] = x2[e]; x2[e] = x1[e]; x1[e] = x0[e]; }
    }
}
__device__ __forceinline__ void ssd1_unit(Frame& F, int L, int b, int c, int g) {
    const int tid = F.tid, lane = F.lane, w = F.wave, fr = lane & 15, fq = lane >> 4;
    LAS char* Bs = (LAS char*)(F.lds + RING_OFF + S1_B); LAS char* Xs = (LAS char*)(F.lds + RING_OFF + S1_X); LAS float* Ws = (LAS float*)(F.lds + RING_OFF + S1_W);
    const size_t row0 = (size_t)b * SEQ + c * 128;
    const bf16* XC = (const bf16*)(F.a->ws + WS_XBCC);
    v4u braw[4], xraw[8];
#pragma unroll
    for (int i = 0; i < 4; ++i) { const int q = tid + 512 * i, r = q >> 4, ch = q & 15; braw[i] = *(const v4u*)(XC + (row0 + r) * XBCW + 1024 + 128 * g + ch * 8); }
#pragma unroll
    for (int i = 0; i < 8; ++i) { const int q = tid + 512 * i, r = q >> 5, ch = q & 31; xraw[i] = *(const v4u*)(XC + (row0 + r) * XBCW + 512 * g + ch * 8); }
    { const int h = 8 * g + w; const float a = -__expf(F.a->in[I_ALOG][L * 16 + h]);
        const float d0 = ((float*)(F.a->ws + WS_DT))[(row0 + 2 * lane) * 16 + h], d1 = ((float*)(F.a->ws + WS_DT))[(row0 + 2 * lane + 1) * 16 + h];
        const float x0 = d0 * a, x1 = d1 * a; float sc = x0 + x1;
#pragma unroll
        for (int o = 1; o < 64; o <<= 1) { const float t = __shfl_up(sc, o); if (lane >= o) sc += t; }
        const float ac1 = sc, ac0 = sc - x1, tot = __shfl(sc, 63);
        ((float*)(F.a->ws + WS_ACUM))[(row0 + 2 * lane) * 16 + h] = ac0; ((float*)(F.a->ws + WS_ACUM))[(row0 + 2 * lane + 1) * 16 + h] = ac1;
        Ws[w * 128 + 2 * lane] = d0 * __expf(tot - ac0); Ws[w * 128 + 2 * lane + 1] = d1 * __expf(tot - ac1);
        if (lane == 0) ((float*)(F.a->ws + WS_CDEC))[(b * NCH + c) * 16 + h] = __expf(tot); }
#pragma unroll
    for (int i = 0; i < 4; ++i) { const int q = tid + 512 * i, r = q >> 4, ch = q & 15; *(LAS v4u*)(Bs + r * S1_BP + ch * 16) = braw[i]; }
    __syncthreads();
#pragma unroll 1
    for (int pass = 0; pass < 2; ++pass) {
#pragma unroll
        for (int i = 0; i < 8; ++i) { const int q = tid + 512 * i, r = q >> 5, ch = q & 31; const v4u v = xraw[i]; const float wt = Ws[(4 * pass + (ch >> 3)) * 128 + r];
            v4u o; o.x = cvtpk(bflo(v.x) * wt, bfhi(v.x) * wt); o.y = cvtpk(bflo(v.y) * wt, bfhi(v.y) * wt); o.z = cvtpk(bflo(v.z) * wt, bfhi(v.z) * wt); o.w = cvtpk(bflo(v.w) * wt, bfhi(v.w) * wt);
            *(LAS v4u*)(Xs + r * S1_XP + ch * 16) = o; }
        __syncthreads();
        if (pass == 0) {
#pragma unroll
            for (int i = 0; i < 8; ++i) { const int q = tid + 512 * i, r = q >> 5, ch = q & 31; xraw[i] = *(const v4u*)(XC + (row0 + r) * XBCW + 512 * g + 256 + ch * 8); } }
        { const int hh4 = w >> 1, nh = w & 1, h = 8 * g + 4 * pass + hh4;
            f32x4 acc[4][4];
#pragma unroll
            for (int pt = 0; pt < 4; ++pt)
#pragma unroll
                for (int nt = 0; nt < 4; ++nt) acc[pt][nt] = (f32x4){0.f, 0.f, 0.f, 0.f};
#pragma unroll
            for (int ks = 0; ks < 4; ++ks) { const int tok = 32 * ks + 8 * fq + ((lane & 15) >> 2);
                bf16x8 af[4], bfr[4];
#pragma unroll
                for (int nt = 0; nt < 4; ++nt) { const LAS char* p = Bs + tok * S1_BP + (64 * nh + 16 * nt + 4 * (lane & 3)) * 2; af[nt] = tr2(p, p + 4 * S1_BP); }
#pragma unroll
                for (int pt = 0; pt < 4; ++pt) { const LAS char* p = Xs + tok * S1_XP + (64 * hh4 + 16 * pt + 4 * (lane & 3)) * 2; bfr[pt] = tr2(p, p + 4 * S1_XP); }
#pragma unroll
                for (int pt = 0; pt < 4; ++pt)
#pragma unroll
                    for (int nt = 0; nt < 4; ++nt) acc[pt][nt] = mfma16(af[nt], bfr[pt], acc[pt][nt]); }
            bf16* sp = ((bf16*)(F.a->ws + WS_ST)) + ((size_t)(b * NCH + c) * 16 + h) * 8192;
#pragma unroll
            for (int pt = 0; pt < 4; ++pt)
#pragma unroll
                for (int pr = 0; pr < 2; ++pr) { v2u e0, e1; e0.x = cvtpk(acc[pt][2 * pr][0], acc[pt][2 * pr][1]); e0.y = cvtpk(acc[pt][2 * pr][2], acc[pt][2 * pr][3]);
                    e1.x = cvtpk(acc[pt][2 * pr + 1][0], acc[pt][2 * pr + 1][1]); e1.y = cvtpk(acc[pt][2 * pr + 1][2], acc[pt][2 * pr + 1][3]);
                    store_pair16(sp + (16 * pt + fr) * 128 + 64 * nh, e0, e1, pr, fq); } }
        __syncthreads();
    }
}

__device__ __forceinline__ void ssd_scan_phase(Frame& F, int L) {
    const int nthr = F.G * NWAVES * 64;
    for (int idx = F.vcu * NWAVES * 64 + F.tid; idx < NBP * 16 * 2048; idx += nthr) {
        const int e4 = idx & 2047, bh = __builtin_amdgcn_readfirstlane(idx >> 11), b = bh >> 4, h = bh & 15;
        f32x4 h0 = (f32x4){0.f, 0.f, 0.f, 0.f};
        v2u s[NCH]; float dc[NCH];
#pragma unroll
        for (int u = 0; u < NCH; ++u) { const size_t o = ((size_t)(b * NCH + u) * 16 + h); s[u] = *(const v2u*)(((const bf16*)(F.a->ws + WS_ST)) + o * 8192 + 4 * e4); dc[u] = ((float*)(F.a->ws + WS_CDEC))[o]; }
        __builtin_amdgcn_sched_barrier(0);
#pragma unroll
        for (int u = 0; u < NCH; ++u) { const size_t o = ((size_t)(b * NCH + u) * 16 + h);
            v2u t; t.x = cvtpk(h0[0], h0[1]); t.y = cvtpk(h0[2], h0[3]); *(v2u*)(((bf16*)(F.a->ws + WS_HPV)) + o * 8192 + 4 * e4) = t;
            h0 = h0 * dc[u] + (f32x4){bflo(s[u].x), bfhi(s[u].x), bflo(s[u].y), bfhi(s[u].y)}; }
        float* op = F.a->out + O_SSMP + ((size_t)(L * NBP + b) * 16 + h) * 8192 + 4 * e4; *(f32x4*)op = h0;
    }
}

constexpr int S3_P = 272, S3_XP = 528, S3_C = 0, S3_CB = 128 * S3_P, S3_X = S3_CB + 128 * S3_P  , S3_BYTES = S3_X + 128 * S3_XP;
static_assert(S3_BYTES <= RING_BYTES && 128 * S3_P <= 128 * S3_XP, "ssd3 lds");
__device__ __forceinline__ void ssd3_unit(Frame& F, int L, int b, int c, int g) {
    int lane = F.lane; asm volatile("" : "+v"(lane));
    const int w = F.wave, tid = w * 64 + lane, fr = lane & 15, fq = lane >> 4;
    LAS char* Cs = (LAS char*)(F.lds + RING_OFF + S3_C); LAS char* Bs = (LAS char*)(F.lds + RING_OFF + S3_X); LAS char* CBs = (LAS char*)(F.lds + RING_OFF + S3_CB); LAS char* Xs = (LAS char*)(F.lds + RING_OFF + S3_X);
    LAS float* acS = (LAS float*)(F.lds + EXCH_OFF); LAS float* dtS = acS + 1024;
    const size_t row0 = (size_t)b * SEQ + c * 128;
    const bf16* XC = (const bf16*)(F.a->ws + WS_XBCC);
#pragma unroll
    for (int i = 0; i < 4; ++i) { const int q = tid + 512 * i, r = q >> 4, ch = q & 15;
        *(LAS v4u*)(Cs + r * S3_P + ch * 16) = *(const v4u*)(XC + (row0 + r) * XBCW + 1280 + 128 * g + ch * 8);
        *(LAS v4u*)(Bs + r * S3_P + ch * 16) = *(const v4u*)(XC + (row0 + r) * XBCW + 1024 + 128 * g + ch * 8); }
    v4u xr[8];
#pragma unroll
    for (int i = 0; i < 8; ++i) { const int q = tid + 512 * i, r = q >> 5, ch = q & 31; xr[i] = *(const v4u*)(XC + (row0 + r) * XBCW + (8 * g) * 64 + ch * 8); }
#pragma unroll
    for (int i = 0; i < 2; ++i) { const int q = tid + 512 * i, r = q >> 3, hh = q & 7; acS[hh * 128 + r] = ((float*)(F.a->ws + WS_ACUM))[(row0 + r) * 16 + 8 * g + hh]; dtS[hh * 128 + r] = ((float*)(F.a->ws + WS_DT))[(row0 + r) * 16 + 8 * g + hh]; }
    __syncthreads();
#pragma unroll
    for (int it = 0; it < 8; ++it) if (it >= w) { f32x4 a = (f32x4){0.f, 0.f, 0.f, 0.f};
#pragma unroll
        for (int ks = 0; ks < 4; ++ks) { const bf16x8 bf = *(const LAS bf16x8*)(Bs + (16 * w + fr) * S3_P + (32 * ks + 8 * fq) * 2), cf = *(const LAS bf16x8*)(Cs + (16 * it + fr) * S3_P + (32 * ks + 8 * fq) * 2);
            a = mfma16(bf, cf, a); }
        v2u t; t.x = cvtpk(a[0], a[1]); t.y = cvtpk(a[2], a[3]); *(LAS v2u*)(CBs + (16 * it + fr) * S3_P + (16 * w + 4 * fq) * 2) = t; }
    __syncthreads();
#pragma unroll 1
    for (int hp = 0; hp < 2; ++hp) {
        int tl = tid; asm volatile("" : "+v"(tl));
#pragma unroll
        for (int i = 0; i < 8; ++i) { const int q = tl + 512 * i, r = q >> 5, ch = q & 31; *(LAS v4u*)(Xs + r * S3_XP + ch * 16) = xr[i]; }
        __syncthreads();
        if (hp == 0) {
#pragma unroll
            for (int i = 0; i < 8; ++i) { const int q = tl + 512 * i, r = q >> 5, ch = q & 31; xr[i] = *(const v4u*)(XC + (row0 + r) * XBCW + (8 * g + 4) * 64 + ch * 8); } }
        { const int hh4 = w >> 1, ih = w & 1, hl = 4 * hp + hh4, h = 8 * g + hl;
            const bf16* hp_ = ((bf16*)(F.a->ws + WS_HPV)) + ((size_t)(b * NCH + c) * 16 + h) * 8192;
            bf16x8 hf[4][4];
#pragma unroll
            for (int ks = 0; ks < 4; ++ks)
#pragma unroll
                for (int pt = 0; pt < 4; ++pt) hf[ks][pt] = *(const bf16x8*)(hp_ + (16 * pt + fr) * 128 + 32 * ks + 8 * fq);
            const float dsk = F.a->in[I_DSKIP][L * 16 + h];
            const bf16* szp = ((const bf16*)(F.a->ws + WS_SZ)) + row0 * DM + h * 64 + 4 * fq;
            v2u zwn[4];
#pragma unroll
            for (int pt = 0; pt < 4; ++pt) zwn[pt] = *(const v2u*)(szp + (size_t)(16 * ih + fr) * DM + 16 * pt);
#pragma unroll 1
            for (int i2 = 0; i2 < 4; ++i2) { const int it = 2 * i2 + ((i2 & 1) ? 1 - ih : ih), il = 16 * it + fr;
                v2u zwc[4];
#pragma unroll
                for (int pt = 0; pt < 4; ++pt) zwc[pt] = zwn[pt];
                if (i2 < 3) { const int itn = 2 * (i2 + 1) + (((i2 + 1) & 1) ? 1 - ih : ih);
#pragma unroll
                    for (int pt = 0; pt < 4; ++pt) zwn[pt] = *(const v2u*)(szp + (size_t)(16 * itn + fr) * DM + 16 * pt); }
                const float ai = acS[hl * 128 + il];
                f32x4 y1[4], y2[4];
#pragma unroll
                for (int pt = 0; pt < 4; ++pt) { y1[pt] = (f32x4){0.f, 0.f, 0.f, 0.f}; y2[pt] = (f32x4){0.f, 0.f, 0.f, 0.f}; }
#pragma unroll
                for (int ks = 0; ks < 4; ++ks) if (2 * ks <= it) {
                    const v4u cbw = *(const LAS v4u*)(CBs + (16 * it + fr) * S3_P + (32 * ks + 8 * fq) * 2);
                    const int j0 = 32 * ks + 8 * fq;
                    const f32x4 a0 = *(const LAS f32x4*)(acS + hl * 128 + j0), a1 = *(const LAS f32x4*)(acS + hl * 128 + j0 + 4), d0 = *(const LAS f32x4*)(dtS + hl * 128 + j0), d1 = *(const LAS f32x4*)(dtS + hl * 128 + j0 + 4);
                    float gv[8]; gv[0] = bflo(cbw.x); gv[1] = bfhi(cbw.x); gv[2] = bflo(cbw.y); gv[3] = bfhi(cbw.y); gv[4] = bflo(cbw.z); gv[5] = bfhi(cbw.z); gv[6] = bflo(cbw.w); gv[7] = bfhi(cbw.w);
#pragma unroll
                    for (int e = 0; e < 8; ++e) { const float aj = e < 4 ? a0[e & 3] : a1[e & 3], dj = e < 4 ? d0[e & 3] : d1[e & 3];
                        const float ex = __expf(fminf(ai - aj, 0.f)) * dj * gv[e]; gv[e] = (j0 + e <= il) ? ex : 0.f; }
                    v4u gw; gw.x = cvtpk(gv[0], gv[1]); gw.y = cvtpk(gv[2], gv[3]); gw.z = cvtpk(gv[4], gv[5]); gw.w = cvtpk(gv[6], gv[7]);
                    const bf16x8 gf = __builtin_bit_cast(bf16x8, gw);
                    const int tok = 32 * ks + 8 * fq + ((lane & 15) >> 2);
#pragma unroll
                    for (int pt = 0; pt < 4; ++pt) { const LAS char* p = Xs + tok * S3_XP + (64 * hh4 + 16 * pt + 4 * (lane & 3)) * 2; y1[pt] = mfma16(tr2(p, p + 4 * S3_XP), gf, y1[pt]); }
                    asm volatile("" ::: "memory");
                }
#pragma unroll
                for (int ks = 0; ks < 4; ++ks) { const bf16x8 cf = *(const LAS bf16x8*)(Cs + (16 * it + fr) * S3_P + (32 * ks + 8 * fq) * 2);
#pragma unroll
                    for (int pt = 0; pt < 4; ++pt) y2[pt] = mfma16(hf[ks][pt], cf, y2[pt]); }
                const float ei = __expf(ai); const size_t row = row0 + il; float ss = 0.f;
#pragma unroll
                for (int pt = 0; pt < 4; ++pt) { const int col = 16 * pt + 4 * fq;
                    const v2u xw = *(const LAS v2u*)(Xs + il * S3_XP + (64 * hh4 + col) * 2), zw = zwc[pt];
                    const float x0 = bflo(xw.x), x1 = bfhi(xw.x), x2 = bflo(xw.y), x3 = bfhi(xw.y);
                    const float v0 = (y1[pt][0] + ei * y2[pt][0] + dsk * x0) * bflo(zw.x), v1 = (y1[pt][1] + ei * y2[pt][1] + dsk * x1) * bfhi(zw.x),
                                v2 = (y1[pt][2] + ei * y2[pt][2] + dsk * x2) * bflo(zw.y), v3 = (y1[pt][3] + ei * y2[pt][3] + dsk * x3) * bfhi(zw.y);
                    ss += (v0 * v0 + v1 * v1) + (v2 * v2 + v3 * v3);
                    v2u o; o.x = cvtpk(v0, v1); o.y = cvtpk(v2, v3); *(v2u*)(((bf16*)(F.a->ws + WS_MIX)) + row * MIXW + h * 64 + col) = o; }
                ss += __shfl_xor(ss, 16); ss += __shfl_xor(ss, 32);
                if (fq == 0) ((float*)(F.a->ws + WS_SSQP))[row * 16 + h] = ss; }
        }
        __syncthreads();
    }
}

__device__ __forceinline__ void ssd_sample_task(Frame& F, int L, int b, int h) {
    int lane = F.lane; asm volatile("" : "+v"(lane));
    const int g = h >> 3;
    LAS float* scr = (LAS float*)(F.lds + RING_OFF + F.wave * 8192);
    LAS float* xsS = scr; LAS float* BS = scr + 256; LAS float* CS = scr + 768; LAS float* yI = scr + 1280;
    const size_t row0 = (size_t)MP + b * TS;
    const int plo = lane >> 4, nc = lane & 15;
    const float* h0 = F.a->in[I_SSM] + ((size_t)(L * NBS + b) * 16 + h) * 8192; float* hout = F.a->out + O_SSMS + ((size_t)(L * NBS + b) * 16 + h) * 8192;
    f32x4 pha[8], phb[8];
#pragma unroll
    for (int k = 0; k < 8; ++k) { const int p = plo + 4 * k; pha[k] = __builtin_nontemporal_load((const f32x4*)(h0 + p * 128 + 8 * nc)); phb[k] = __builtin_nontemporal_load((const f32x4*)(h0 + p * 128 + 8 * nc + 4)); }
#pragma unroll
    for (int q = 0; q < 5; ++q) {
        const int ch = q == 0 ? h * 64 + lane : (q < 3 ? 1024 + 128 * g + lane + 64 * (q - 1) : 1280 + 128 * g + lane + 64 * (q - 3));
        const float* sc = F.a->in[I_CONV] + ((size_t)(L * NBS + b) * 3) * XBCW + ch;
        float x[7]; x[0] = sc[0]; x[1] = sc[XBCW]; x[2] = sc[2 * XBCW];
#pragma unroll
        for (int t = 0; t < 4; ++t) x[3 + t] = bf2f(((bf16*)(F.a->ws + WS_XBC))[(row0 + t) * XBCW + ch]);
        const float* cw = F.a->in[I_CW] + (size_t)L * 4 * XBCW + ch; const float w0 = cw[0], w1 = cw[XBCW], w2 = cw[2 * XBCW], w3 = cw[3 * XBCW], bb = F.a->in[I_CB][L * XBCW + ch];
#pragma unroll
        for (int t = 0; t < 4; ++t) { const float y = silu_f(bb + w0 * x[t] + w1 * x[t + 1] + w2 * x[t + 2] + w3 * x[t + 3]);
            if (q == 0) xsS[t * 64 + lane] = y; else if (q < 3) BS[t * 128 + lane + 64 * (q - 1)] = y; else CS[t * 128 + lane + 64 * (q - 3)] = y; }
    }
    const float a = -__expf(F.a->in[I_ALOG][L * 16 + h]), dsk = F.a->in[I_DSKIP][L * 16 + h];
    float dt[4], ac[4];
#pragma unroll
    for (int t = 0; t < 4; ++t) { dt[t] = ((float*)(F.a->ws + WS_DT))[(row0 + t) * 16 + h]; ac[t] = dt[t] * a + (t ? ac[t - 1] : 0.f); }
    LDS_WAIT(); asm volatile("" ::: "memory");
    float cb[4][4];
#pragma unroll
    for (int i = 0; i < 4; ++i)
#pragma unroll
        for (int j = 0; j < 4; ++j) cb[i][j] = 0.f;
#pragma unroll
    for (int i = 0; i < 4; ++i)
#pragma unroll
        for (int j = 0; j <= i; ++j) cb[i][j] = wave_sum(CS[i * 128 + lane] * BS[j * 128 + lane] + CS[i * 128 + lane + 64] * BS[j * 128 + lane + 64]);
    float Cv[4][8], Bv[4][8];
#pragma unroll
    for (int t = 0; t < 4; ++t)
#pragma unroll
        for (int e = 0; e < 8; ++e) { Cv[t][e] = CS[t * 128 + 8 * nc + e]; Bv[t][e] = BS[t * 128 + 8 * nc + e]; }
    const float dec = __expf(ac[3]); float wj[4];
#pragma unroll
    for (int j = 0; j < 4; ++j) wj[j] = dt[j] * __expf(ac[3] - ac[j]);
    unsigned short zq[4];
#pragma unroll
    for (int t = 0; t < 4; ++t) zq[t] = ((const unsigned short*)(F.a->ws + WS_SZ))[(row0 + t) * DM + h * 64 + lane];
#pragma unroll
    for (int k = 0; k < 16; ++k) { const int p = plo + 4 * k;
        const f32x4 ha = pha[k & 7], hb = phb[k & 7];
        float hv[8] = {ha[0], ha[1], ha[2], ha[3], hb[0], hb[1], hb[2], hb[3]};
        if (k < 8) { pha[k] = __builtin_nontemporal_load((const f32x4*)(h0 + (p + 32) * 128 + 8 * nc)); phb[k] = __builtin_nontemporal_load((const f32x4*)(h0 + (p + 32) * 128 + 8 * nc + 4)); }
        float it_[4];
#pragma unroll
        for (int t = 0; t < 4; ++t) { float s = 0.f;
#pragma unroll
            for (int e = 0; e < 8; ++e) s += Cv[t][e] * hv[e];
            s = red16(s); it_[t] = s; }
        float cj[4];
#pragma unroll
        for (int j = 0; j < 4; ++j) cj[j] = wj[j] * xsS[j * 64 + p];
#pragma unroll
        for (int e = 0; e < 8; ++e) hv[e] = hv[e] * dec + ((cj[0] * Bv[0][e] + cj[1] * Bv[1][e]) + (cj[2] * Bv[2][e] + cj[3] * Bv[3][e]));
        __builtin_nontemporal_store((f32x4){hv[0], hv[1], hv[2], hv[3]}, (f32x4*)(hout + p * 128 + 8 * nc)); __builtin_nontemporal_store((f32x4){hv[4], hv[5], hv[6], hv[7]}, (f32x4*)(hout + p * 128 + 8 * nc + 4));
        if (nc == 0) {
#pragma unroll
            for (int t = 0; t < 4; ++t) yI[t * 64 + p] = it_[t]; }
        asm volatile("" ::: "memory");
    }
    LDS_WAIT(); asm volatile("" ::: "memory");
#pragma unroll
    for (int i = 0; i < 4; ++i) { float y = __expf(ac[i]) * yI[i * 64 + lane] + dsk * xsS[i * 64 + lane];
#pragma unroll
        for (int j = 0; j <= i; ++j) y += cb[i][j] * __expf(ac[i] - ac[j]) * dt[j] * xsS[j * 64 + lane];
        y *= bf2f(zq[i]);
        ((bf16*)(F.a->ws + WS_MIX))[(row0 + i) * MIXW + h * 64 + lane] = (bf16)f2bf(y);
        const float ss = wave_sum(y * y);
        if (lane == 0) ((float*)(F.a->ws + WS_SSQP))[(row0 + i) * 16 + h] = ss; }
    LDS_WAIT(); asm volatile("" ::: "memory");
}

__device__ __forceinline__ void convgate_item(Frame& F, int L, const bf16* urow0  , int ntok, bool has_prev_rows  , const float* prev  , int ch0, bf16* grow0) {
    const int pn = ch0 >> 7, ucol = 256 * pn + (ch0 & 127);
    const float* fw = F.a->in[I_FCW] + (size_t)L * 3 * FF2; const float* fb = F.a->in[I_FCB] + (size_t)L * FF2;
    float wg[3][8], wu[3][8], bg[8], bu[8];
#pragma unroll
    for (int tp = 0; tp < 3; ++tp) { const f32x4 a = *(const f32x4*)(fw + tp * FF2 + ch0), b = *(const f32x4*)(fw + tp * FF2 + ch0 + 4), c = *(const f32x4*)(fw + tp * FF2 + FF + ch0), d = *(const f32x4*)(fw + tp * FF2 + FF + ch0 + 4);
        wg[tp][0] = a[0]; wg[tp][1] = a[1]; wg[tp][2] = a[2]; wg[tp][3] = a[3]; wg[tp][4] = b[0]; wg[tp][5] = b[1]; wg[tp][6] = b[2]; wg[tp][7] = b[3];
        wu[tp][0] = c[0]; wu[tp][1] = c[1]; wu[tp][2] = c[2]; wu[tp][3] = c[3]; wu[tp][4] = d[0]; wu[tp][5] = d[1]; wu[tp][6] = d[2]; wu[tp][7] = d[3]; }
    { const f32x4 a = *(const f32x4*)(fb + ch0), b = *(const f32x4*)(fb + ch0 + 4), c = *(const f32x4*)(fb + FF + ch0), d = *(const f32x4*)(fb + FF + ch0 + 4);
        bg[0] = a[0]; bg[1] = a[1]; bg[2] = a[2]; bg[3] = a[3]; bg[4] = b[0]; bg[5] = b[1]; bg[6] = b[2]; bg[7] = b[3]; bu[0] = c[0]; bu[1] = c[1]; bu[2] = c[2]; bu[3] = c[3]; bu[4] = d[0]; bu[5] = d[1]; bu[6] = d[2]; bu[7] = d[3]; }
    float g2[8], g1[8], g0[8], u2[8], u1[8], u0[8];
#pragma unroll
    for (int e = 0; e < 8; ++e) { g2[e] = 0.f; g1[e] = 0.f; u2[e] = 0.f; u1[e] = 0.f; }
    if (has_prev_rows) {
        const v4u a = *(const v4u*)(urow0 - 2 * FF2 + ucol), b = *(const v4u*)(urow0 - FF2 + ucol), c = *(const v4u*)(urow0 - 2 * FF2 + ucol + 128), d = *(const v4u*)(urow0 - FF2 + ucol + 128);
        g2[0] = bflo(a.x); g2[1] = bfhi(a.x); g2[2] = bflo(a.y); g2[3] = bfhi(a.y); g2[4] = bflo(a.z); g2[5] = bfhi(a.z); g2[6] = bflo(a.w); g2[7] = bfhi(a.w);
        g1[0] = bflo(b.x); g1[1] = bfhi(b.x); g1[2] = bflo(b.y); g1[3] = bfhi(b.y); g1[4] = bflo(b.z); g1[5] = bfhi(b.z); g1[6] = bflo(b.w); g1[7] = bfhi(b.w);
        u2[0] = bflo(c.x); u2[1] = bfhi(c.x); u2[2] = bflo(c.y); u2[3] = bfhi(c.y); u2[4] = bflo(c.z); u2[5] = bfhi(c.z); u2[6] = bflo(c.w); u2[7] = bfhi(c.w);
        u1[0] = bflo(d.x); u1[1] = bfhi(d.x); u1[2] = bflo(d.y); u1[3] = bfhi(d.y); u1[4] = bflo(d.z); u1[5] = bfhi(d.z); u1[6] = bflo(d.w); u1[7] = bfhi(d.w);
    } else if (prev) {
#pragma unroll
        for (int e = 0; e < 8; ++e) { g2[e] = prev[ch0 + e]; g1[e] = prev[FF2 + ch0 + e]; u2[e] = prev[FF + ch0 + e]; u1[e] = prev[FF2 + FF + ch0 + e]; }
    }
#pragma unroll 4
    for (int t = 0; t < ntok; ++t) {
        const v4u a = *(const v4u*)(urow0 + (size_t)t * FF2 + ucol), c = *(const v4u*)(urow0 + (size_t)t * FF2 + ucol + 128);
        g0[0] = bflo(a.x); g0[1] = bfhi(a.x); g0[2] = bflo(a.y); g0[3] = bfhi(a.y); g0[4] = bflo(a.z); g0[5] = bfhi(a.z); g0[6] = bflo(a.w); g0[7] = bfhi(a.w);
        u0[0] = bflo(c.x); u0[1] = bfhi(c.x); u0[2] = bflo(c.y); u0[3] = bfhi(c.y); u0[4] = bflo(c.z); u0[5] = bfhi(c.z); u0[6] = bflo(c.w); u0[7] = bfhi(c.w);
        float r[8];
#pragma unroll
        for (int e = 0; e < 8; ++e) { const float gt = bg[e] + wg[0][e] * g2[e] + wg[1][e] * g1[e] + wg[2][e] * g0[e], up = bu[e] + wu[0][e] * u2[e] + wu[1][e] * u1[e] + wu[2][e] * u0[e];
            r[e] = silu_f(gt) * up; g2[e] = g1[e]; g1[e] = g0[e]; u2[e] = u1[e]; u1[e] = u0[e]; }
        v4u o; o.x = cvtpk(r[0], r[1]); o.y = cvtpk(r[2], r[3]); o.z = cvtpk(r[4], r[5]); o.w = cvtpk(r[6], r[7]);
        *(v4u*)(grow0 + (size_t)t * FF + ch0) = o;
    }
}
__device__ __forceinline__ void convgate_phase(Frame& F, int L) {
    const int nthr = F.G * NWAVES * 64, gt = F.vcu * NWAVES * 64 + F.tid;
    constexpr int NCG = FF / 8, NP = (MP / 16) * NCG, NS = NBS * NCG;
    for (int it = gt; it < NP + NS; it += nthr) {
        if (it < NP) { const int cg = it % NCG, rb = it / NCG; const size_t row = (size_t)rb * 16;
            convgate_item(F, L, ((bf16*)(F.a->ws + WS_U)) + row * FF2, 16, (row & 4095) != 0, nullptr, cg * 8, ((bf16*)(F.a->ws + WS_G)) + row * FF);
        } else { const int q = it - NP, cg = q % NCG, b = q / NCG; const size_t row = (size_t)MP + b * TS;
            convgate_item(F, L, ((bf16*)(F.a->ws + WS_U)) + row * FF2, 4, false, F.a->in[I_FFNC] + (size_t)(L * NBS + b) * 2 * FF2, cg * 8, ((bf16*)(F.a->ws + WS_G)) + row * FF); }
    }
}

template <bool HOOK> __device__ __forceinline__ void sample_gemm(Frame& F, const bf16* A, const bf16* Bt, const int K, const float* base, float* outp, const float* ssqp, bf16* xb, float* ssqx) {
    const int lane = F.lane, w = F.wave, fr = lane & 15, fq = lane >> 4, nsteps = K / 32;
    LAS float* slab = (LAS float*)(F.lds + RING_OFF) + w * (HOOK ? 4096 : 2048);
    for (int tile = F.vcu; tile < 256; tile += F.G) {
        const int rb = tile >> 4, cb = tile & 15;
        f32x4 acc0[2][4], acc1[2][4];
#pragma unroll
        for (int mt = 0; mt < 2; ++mt)
#pragma unroll
            for (int nt = 0; nt < 4; ++nt) { acc0[mt][nt] = (f32x4){0.f, 0.f, 0.f, 0.f}; acc1[mt][nt] = (f32x4){0.f, 0.f, 0.f, 0.f}; }
        const bf16* ap = A + (size_t)(MP + 32 * rb + fr) * K + 8 * fq; const bf16* bp = Bt + (size_t)(64 * cb + fr) * K + 8 * fq;
        const int idx_ = F.tid * 4, m_ = idx_ >> 6, n_ = idx_ & 63; const size_t row_ = (size_t)MP + 32 * rb + m_;
        const v2u o_bw = *(const v2u*)(xb + row_ * DM + 64 * cb + n_); const f32x4 o_base = (f32x4){bflo(o_bw.x), bfhi(o_bw.x), bflo(o_bw.y), bfhi(o_bw.y)};
        f32x4 sq4[4]; if (HOOK) { const f32x4* sp = (const f32x4*)(ssqp + row_ * 16); sq4[0] = sp[0]; sq4[1] = sp[1]; sq4[2] = sp[2]; sq4[3] = sp[3]; }
#pragma unroll 6
        for (int s = w; s < nsteps; s += 8) {
            bf16x8 af[2], bf[4];
#pragma unroll
            for (int mt = 0; mt < 2; ++mt) af[mt] = *(const bf16x8*)(ap + (size_t)(16 * mt) * K + 32 * s);
#pragma unroll
            for (int nt = 0; nt < 4; ++nt) bf[nt] = *(const bf16x8*)(bp + (size_t)(16 * nt) * K + 32 * s);
            if (HOOK && s >= 32) {
#pragma unroll
                for (int mt = 0; mt < 2; ++mt)
#pragma unroll
                    for (int nt = 0; nt < 4; ++nt) acc1[mt][nt] = mfma16(bf[nt], af[mt], acc1[mt][nt]);
            } else {
#pragma unroll
                for (int mt = 0; mt < 2; ++mt)
#pragma unroll
                    for (int nt = 0; nt < 4; ++nt) acc0[mt][nt] = mfma16(bf[nt], af[mt], acc0[mt][nt]);
            }
        }
#pragma unroll
        for (int mt = 0; mt < 2; ++mt)
#pragma unroll
            for (int nt = 0; nt < 4; ++nt) { *(LAS f32x4*)(slab + (16 * mt + fr) * 64 + 16 * nt + 4 * fq) = acc0[mt][nt]; if (HOOK) *(LAS f32x4*)(slab + 2048 + (16 * mt + fr) * 64 + 16 * nt + 4 * fq) = acc1[mt][nt]; }
        __syncthreads();
        { const int idx = F.tid * 4, m = idx >> 6, n = idx & 63; const size_t row = (size_t)MP + 32 * rb + m;
            const LAS float* r0 = (const LAS float*)(F.lds + RING_OFF) + idx;
            f32x4 s0 = (f32x4){0.f, 0.f, 0.f, 0.f}, s1 = (f32x4){0.f, 0.f, 0.f, 0.f};
#pragma unroll
            for (int ww = 0; ww < 8; ++ww) { s0 = s0 + *(const LAS f32x4*)(r0 + ww * (HOOK ? 4096 : 2048)); if (HOOK) s1 = s1 + *(const LAS f32x4*)(r0 + ww * 4096 + 2048); }
            f32x4 o = o_base;
            if (HOOK) { const f32x4 a = sq4[0], b = sq4[1], c = sq4[2], d = sq4[3];
                const float sq = ((a[0] + a[1]) + (a[2] + a[3])) + ((b[0] + b[1]) + (b[2] + b[3])) + ((c[0] + c[1]) + (c[2] + c[3])) + ((d[0] + d[1]) + (d[2] + d[3]));
                o = o + s0 * rsqrtf(sq * (1.f / 1024.f) + EPS) + s1; }
            else o = o + s0;
            if (outp) *(f32x4*)(outp + row * DM + 64 * cb + n) = o;
            if (ssqx) { v2u xw; xw.x = cvtpk(o[0], o[1]); xw.y = cvtpk(o[2], o[3]); *(v2u*)(xb + row * DM + 64 * cb + n) = xw;
                float ss = (o[0] * o[0] + o[1] * o[1]) + (o[2] * o[2] + o[3] * o[3]);
                ss = red16(ss);
                if ((lane & 15) == 0) ssqx[row * 16 + cb] = ss; } }
        __syncthreads();
    }
}

#ifndef PH_MASK
#define PH_MASK 0xFFFFu
#endif
#ifndef SUB_MASK
#define SUB_MASK 0xFu
#endif
#define SUBK(k) (((SUB_MASK) >> (k)) & 1u)
#ifndef SUBREP_MASK
#define SUBREP_MASK 0u
#endif
#define RPT(k) for (int rp_ = 0; rp_ <= (int)(((SUBREP_MASK) >> (k)) & 1u); ++rp_)
#define PHK(k) (((PH_MASK) >> (k)) & 1u)
#ifndef REP_MASK
#define REP_MASK 0u
#endif
#define REPK(k) ((int)(((REP_MASK) >> (k)) & 1u))
constexpr int N_PHASES = 21;
#if MK_ONE_LAUNCH
#define GRID_BAR() xcd_barrier(bar)
#else
#define GRID_BAR() do { if (F.tid == 0) __hip_atomic_store(F.ctl + CW_TMO, 0xBADBA0u, RLX_AGENT); } while (0)
#endif
#define IN(k) (lo <= (k) && (k) < hi)
#define SEAM(k) do { if (IN(k) && IN((k) + 1)) GRID_BAR(); } while (0)
#define gw (F.vcu * NWAVES + F.wave)
template <int L> __device__ __forceinline__ void layer_body(Frame& F, const XcdBarrier& bar, const int lo, const int hi) {
    const int NGW = F.G * NWAVES;
        const int pb = 1 + 10 * L;
#define RELAUNDER() do { int l_; asm volatile("v_mbcnt_lo_u32_b32 %0, -1, 0\n\tv_mbcnt_hi_u32_b32 %0, -1, %0" : "=v"(l_)); F.lane = l_; F.tid = F.wave * 64 + l_; } while (0)
        const float* xP = L == 0 ? F.a->in[I_XP] : ((float*)(F.a->ws + WS_X2)); const float* xS = L == 0 ? F.a->in[I_XS] : ((float*)(F.a->ws + WS_X2)) + (size_t)MP * DM;
        float* xout = L == 0 ? +((float*)(F.a->ws + WS_X2)) : +F.a->out;
        RELAUNDER();
        RELAUNDER();
        if (PHK(2) && IN(pb + 1)) { for (int rep_ = 0; rep_ <= REPK(2); ++rep_) { if (rep_) GRID_BAR();
            pg8::Gemm g{((bf16*)(F.a->ws + WS_XN)), ((bf16*)(F.a->ws + WS_WIN)) + (size_t)L * NIN * DM, 67 * 256, NIN, DM}; InOrder S; S.init(F.G, (int)blockIdx.x);
            EpiInProj3 E{((bf16*)(F.a->ws + WS_QB)), ((bf16*)(F.a->ws + WS_KB)), ((bf16*)(F.a->ws + WS_VB)), ((bf16*)(F.a->ws + WS_SZ)), ((bf16*)(F.a->ws + WS_XBCC)), ((bf16*)(F.a->ws + WS_XBC)), F.a->in[I_QN] + L * 64, F.a->in[I_KN] + L * 64, F.a->out, L, (const LAS float*)(F.lds + RSTD_OFF),
                         (LAS float*)(F.lds + EXCH_OFF), F.a->in[I_CW] + (size_t)L * 4 * XBCW, F.a->in[I_CB] + (size_t)L * XBCW, F.a->in[I_CONV] + (size_t)L * NBS * 3 * XBCW, (LAS float*)(F.lds + WTAB_OFF)};
            pg8::gemm_phase<EpiInProj3, InOrder, true, true>(F.lds + RING_OFF, g, S, E, F.tid, PreRstd<InOrder>{(LAS float*)(F.lds + RSTD_OFF), S, ((const float*)(F.a->ws + WS_SSQX)), F.tid});
            RELAUNDER(); dt_phase(F, L);
            } SEAM(pb + 1);
        }
        RELAUNDER();
        if (PHK(3) && IN(pb + 2)) { for (int rep_ = 0; rep_ <= REPK(3); ++rep_) { if (rep_) GRID_BAR();
            if (SUBK(0)) RPT(0) for (int u = F.vcu; u < 256; u += F.G) ssd1_unit(F, L, u >> 6, (u >> 1) & 31, u & 1);
            RELAUNDER();
            { SaTask T; const int v0 = F.vcu * 6 + F.wave; sa_begin(F, L, v0, SUBK(3) && F.wave < 6 && v0 < 1536, T);
                if (SUBK(1)) RPT(1) attn_prompt_units(F, F.vcu % F.G, F.G, 1536, T);
                sa_finish(F, T);
                if (SUBK(3) && F.wave < 6) for (int v = v0 + F.G * 6; v < 1536; v += F.G * 6) attn_sample_task(F, L, v / 12, (v >> 2) % 3, v & 3); }
            RELAUNDER();
            } SEAM(pb + 2);
        }
        RELAUNDER();
        if (PHK(4) && IN(pb + 3)) { for (int rep_ = 0; rep_ <= REPK(4); ++rep_) { if (rep_) GRID_BAR(); ssd_scan_phase(F, L); } SEAM(pb + 3); }
        RELAUNDER();
        if (PHK(5) && IN(pb + 4)) { for (int rep_ = 0; rep_ <= REPK(5); ++rep_) { if (rep_) GRID_BAR();
#pragma unroll 1
            for (int ps = 0; ps < 2; ++ps) {
                if ((ps == 0) == ((F.vcu & 1) != 0)) { RPT(2) for (int t = gw; t < 2048; t += NGW) ssd_sample_task(F, L, t >> 4, t & 15); __syncthreads(); }
                else { RPT(4) for (int u = F.vcu; u < 256; u += F.G) ssd3_unit(F, L, u >> 6, (u >> 1) & 31, u & 1);
                       RPT(5) for (int row = MP + gw; row < MT; row += 4 * NGW) alpha_rows<4>(F, row, NGW); }
                RELAUNDER();
            }
            } SEAM(pb + 4);
        }
        RELAUNDER();
        if (PHK(6) && IN(pb + 5)) { {
            pg8::Gemm g{((bf16*)(F.a->ws + WS_MIX)), ((bf16*)(F.a->ws + WS_WOUT)) + (size_t)L * DM * MIXW, MP, DM, MIXW}; pg8::StaticOrder S; S.init(MP, DM, F.G, (int)blockIdx.x);
            EpiOutProj E{(const LAS float*)(F.lds + RSTD_OFF), (const LAS float*)(F.lds + EXCH_OFF), ((bf16*)(F.a->ws + WS_XN)), ((float*)(F.a->ws + WS_SSQX))};
            prefill_outproj((LAS float*)(F.lds + RSTD_OFF), (LAS float*)(F.lds + EXCH_OFF), S, ((const float*)(F.a->ws + WS_SSQP)), ((const float*)(F.a->ws + WS_LSE)), F.tid);
            pg8::gemm_phase<EpiOutProj, pg8::StaticOrder, true, true>(F.lds + RING_OFF, g, S, E, F.tid);
            }
            { RELAUNDER(); sample_gemm<true>(F, ((bf16*)(F.a->ws + WS_MIX)), ((bf16*)(F.a->ws + WS_WOUT)) + (size_t)L * DM * MIXW, MIXW, nullptr, nullptr, ((float*)(F.a->ws + WS_SSQP)), ((bf16*)(F.a->ws + WS_XN)), ((float*)(F.a->ws + WS_SSQX))); }
            SEAM(pb + 5);
        }
        RELAUNDER();
        RELAUNDER();
        if (PHK(8) && IN(pb + 7)) { for (int rep_ = 0; rep_ <= REPK(8); ++rep_) { if (rep_) GRID_BAR();
            pg8::Gemm g{((bf16*)(F.a->ws + WS_XN)), ((bf16*)(F.a->ws + WS_WUP)) + (size_t)L * FF2 * DM, 67 * 256, FF2, DM}; UpOrder S; S.init(F.G, (int)blockIdx.x);
            EpiUpConv E{((bf16*)(F.a->ws + WS_G)), F.a->out, L, (const LAS float*)(F.lds + RSTD_OFF), (LAS float*)(F.lds + EXCH_OFF), F.a->in[I_FCW] + (size_t)L * 3 * FF2, F.a->in[I_FCB] + (size_t)L * FF2, F.a->in[I_FFNC] + (size_t)L * NBS * 2 * FF2, (LAS float*)(F.lds + WTAB_OFF)};
            prefill_rstd((LAS float*)(F.lds + RSTD_OFF), S, ((const float*)(F.a->ws + WS_SSQX)), F.tid);
            pg8::gemm_phase<EpiUpConv, UpOrder, true, true>(F.lds + RING_OFF, g, S, E, F.tid);
            } SEAM(pb + 7);
        }
        RELAUNDER();
        RELAUNDER();
        if (PHK(10) && IN(pb + 9)) { {
            pg8::Gemm g{((bf16*)(F.a->ws + WS_G)), ((bf16*)(F.a->ws + WS_WDN)) + (size_t)L * DM * FF, MP, DM, FF}; pg8::StaticOrder S; S.init(MP, DM, F.G, (int)blockIdx.x);
            EpiResid<-1> E{L == 1 ? +F.a->out : (float*)nullptr, nullptr, ((bf16*)(F.a->ws + WS_XN)), L == 1 ? (float*)nullptr : ((float*)(F.a->ws + WS_SSQX))};
            pg8::gemm_phase<EpiResid<-1>, pg8::StaticOrder, true, true>(F.lds + RING_OFF, g, S, E, F.tid);
#if (((REP_MASK) >> 10) & 1u)
            GRID_BAR(); pg8::gemm_phase<EpiResid<-1>, pg8::StaticOrder, true, true>(F.lds + RING_OFF, g, S, E, F.tid);
#endif
            }
            { RELAUNDER(); sample_gemm<false>(F, ((bf16*)(F.a->ws + WS_G)), ((bf16*)(F.a->ws + WS_WDN)) + (size_t)L * DM * FF, FF, nullptr, L == 1 ? +F.a->out : (float*)nullptr, nullptr, ((bf16*)(F.a->ws + WS_XN)), L == 1 ? (float*)nullptr : ((float*)(F.a->ws + WS_SSQX))); }
            SEAM(pb + 9);
        }
}
__global__ void __launch_bounds__(NWAVES * 64, 2) mk_fwd(Args args) {
    extern __shared__ __attribute__((aligned(16))) unsigned char lds[];
    Frame F;
    F.lds = (LAS unsigned char*)lds;
    F.MISC = (volatile LAS unsigned*)(F.lds + MISC_OFF);
    F.tid = threadIdx.x; F.lane = F.tid & 63; F.wave = __builtin_amdgcn_readfirstlane(F.tid >> 6);
    F.G = gridDim.x; { const int bx = blockIdx.x; F.vcu = (F.G % 8 == 0) ? (bx % 8) * (F.G / 8) + bx / 8 : bx; }
    F.ctl = (gu32*)(args.ws + WS_CTL);
    F.a = &args;
    for (int u = F.tid; u < (LDS_BYTES - LDSCTL_OFF) / 4; u += NWAVES * 64) ((LAS unsigned*)(F.lds + LDSCTL_OFF))[u] = 0u;
    __syncthreads();
    XcdBarrier bar; bar.bar = (unsigned*)(F.ctl + CW_BAR); bar.x = 0; bar.st = nullptr;
#if MK_ONE_LAUNCH
    bar = xcd_barrier_post((unsigned*)(F.ctl + CW_BAR), F.MISC + 8);
#else
#endif
    const int lo = args.ph_lo, hi = args.ph_hi;

    if (PHK(0) && IN(0)) { for (int rep_ = 0; rep_ <= REPK(0); ++rep_) { if (rep_) GRID_BAR(); p0_prologue(F); p0_prep(F); } SEAM(0); }

    layer_body<0>(F, bar, lo, hi);
    layer_body<1>(F, bar, lo, hi);
#ifdef DEBUG_DUMP
    if (lo == 99) {
        float* o = F.a->out;
        const size_t nthr = (size_t)F.G * NWAVES * 64, gt = (size_t)F.vcu * NWAVES * 64 + F.tid;
        for (size_t i = gt; i < (size_t)MP * 1024; i += nthr) o[i] = DUMP_A;
        for (size_t i = gt; i < (size_t)MS * 1024; i += nthr) o[(size_t)MP * 1024 + i] = DUMP_B;
    }
#endif
#undef IN
#undef SEAM
#undef gw
#undef RELAUNDER
}

extern "C" void kernel_launch(void* const* d_in, const int* in_sizes, int n_in, void* d_out, int out_size, void* d_ws, size_t ws_size, hipStream_t stream) {
    static int grid = 0;
    if (grid == 0) {
        if (n_in != 24 || (size_t)out_size != O_END || ws_size < WS_END) { fprintf(stderr, "kernel_launch: unexpected shapes: n_in %d out %d ws %zu (need %zu)\n", n_in, out_size, ws_size, (size_t)WS_END); grid = -1; return; }
        int dev = 0, cus = 0, per_cu = 0;
        if (hipGetDevice(&dev) != hipSuccess || hipDeviceGetAttribute(&cus, hipDeviceAttributeMultiprocessorCount, dev) != hipSuccess) { grid = -1; return; }
        if (hipFuncSetAttribute((const void*)mk_fwd, hipFuncAttributeMaxDynamicSharedMemorySize, LDS_BYTES) != hipSuccess) { fprintf(stderr, "kernel_launch: hipFuncSetAttribute failed\n"); grid = -1; return; }
        if (hipOccupancyMaxActiveBlocksPerMultiprocessor(&per_cu, (const void*)mk_fwd, NWAVES * 64, LDS_BYTES) != hipSuccess || per_cu < 1) { fprintf(stderr, "kernel_launch: occupancy query says %d\n", per_cu); }
        (void)hipGetLastError();
        if (cus < 256) { fprintf(stderr, "kernel_launch: built for a 256-CU device (one GEMM unit per workgroup in the N = 1024 projections); found %d CUs; nothing launched\n", cus); grid = -1; return; }
        grid = 256;
    }
    if (grid < 0) return;
    if (hipMemsetAsync((char*)d_ws + WS_CTL, 0, CTL_ZERO_BYTES, stream) != hipSuccess) return;
    Args a{};
    for (int i = 0; i < 24; ++i) a.in[i] = (const float*)d_in[i];
    a.out = (float*)d_out; a.ws = (unsigned char*)d_ws;
#if MK_ONE_LAUNCH
    a.ph_lo = 0; a.ph_hi = N_PHASES;
    hipLaunchKernelGGL(mk_fwd, dim3(grid), dim3(NWAVES * 64), LDS_BYTES, stream, a);
#else
#ifndef LASTPH
#define LASTPH N_PHASES
#endif
    for (int p = 0; p < LASTPH; ++p) { a.ph_lo = p; a.ph_hi = p + 1; hipLaunchKernelGGL(mk_fwd, dim3(grid), dim3(NWAVES * 64), LDS_BYTES, stream, a); }
#ifdef DEBUG_DUMP
    a.ph_lo = 99; a.ph_hi = 100; hipLaunchKernelGGL(mk_fwd, dim3(grid), dim3(NWAVES * 64), LDS_BYTES, stream, a);
#endif
#endif
}
```
